# Optimizing an MI355X kernel written in HIP

```python
import math
import jax, jax.numpy as jnp
from jax import lax
import numpy as np

D_MODEL = 1024
BATCH = 8
SEQ = 2048
DEPTH = 1
DEC_BATCH = 128
DEC_SEQ = 1
PAST_LEN = 16384
PAGE_SIZE = 128

A_HEADS = 4
A_DK = 128
A_DV = 128
A_KWIDTH = A_HEADS * A_DK
A_WIDTH = A_HEADS * A_DV
CONV_WIDTH = 4
CONV_CH = 2 * A_KWIDTH + A_WIDTH
DELTA_CHUNK = 64
B_GROUPS = 4
B_WIDTH = D_MODEL // 2
B_CHUNK = 128
MEM_LEN = 256
C_HEADS = 4
C_DH = 128
C_WIDTH = C_HEADS * C_DH
N_BRANCH = 3
EPS = 1e-6
SPLIT_SIZES = (A_KWIDTH, A_KWIDTH, A_WIDTH, A_HEADS, A_HEADS, A_WIDTH,
               B_WIDTH, B_WIDTH, B_WIDTH, C_WIDTH, C_WIDTH, N_BRANCH * D_MODEL)
IN_COLS = sum(SPLIT_SIZES)

kernel_name = "hybrid_delta_chunkmlp_memxattn_step"


def _split_points():
    pts, acc = [], 0
    for s in SPLIT_SIZES[:-1]:
        acc += s
        pts.append(acc)
    return pts


def rmsnorm(x, g):
    xf = x.astype(jnp.float32)
    y = xf * lax.rsqrt(jnp.mean(xf * xf, axis=-1, keepdims=True) + EPS)
    return (y * g.astype(jnp.float32)).astype(x.dtype)


def layernorm(x, g, b):
    xf = x.astype(jnp.float32)
    mu = jnp.mean(xf, axis=-1, keepdims=True)
    xc = xf - mu
    y = xc * lax.rsqrt(jnp.mean(xc * xc, axis=-1, keepdims=True) + EPS)
    return (y * g.astype(jnp.float32) + b.astype(jnp.float32)).astype(x.dtype)


def l2norm(x):
    return x * lax.rsqrt(jnp.sum(x * x, axis=-1, keepdims=True) + EPS)


def causal_conv(buf, x, w):
    T = x.shape[1]
    xp = jnp.concatenate([buf.astype(x.dtype), x], axis=1)
    y = xp[:, 0:T] * w[0]
    for j in range(1, CONV_WIDTH):
        y = y + xp[:, j:j + T] * w[j]
    return jax.nn.silu(y), xp[:, -(CONV_WIDTH - 1):]


def gated_delta_chunked(q, k, v, beta, g, S0):
    B, T, H, _ = q.shape
    C = DELTA_CHUNK
    Tp = -(-T // C) * C
    N = Tp // C
    pad = Tp - T

    def padt(a):
        return jnp.pad(a, [(0, 0), (0, pad)] + [(0, 0)] * (a.ndim - 2))

    def chunk4(a):
        return padt(a).reshape(B, N, C, H, a.shape[-1]).transpose(1, 0, 3, 2, 4)

    def chunk3(a):
        return padt(a).reshape(B, N, C, H).transpose(1, 0, 3, 2)

    q, k, v = chunk4(q), chunk4(k), chunk4(v)
    beta, g = chunk3(beta), chunk3(g)
    gc = jnp.cumsum(g, axis=-1)
    idx = jnp.arange(C)
    causal = idx[:, None] >= idx[None, :]
    strict = idx[:, None] > idx[None, :]
    decay = jnp.exp(jnp.where(causal, gc[..., :, None] - gc[..., None, :], -jnp.inf))
    k_beta = k * beta[..., None]
    L = jnp.where(strict, jnp.einsum('nbhid,nbhjd->nbhij', k_beta, k) * decay, 0.0)
    eye = jnp.eye(C, dtype=q.dtype)
    Tinv = lax.linalg.triangular_solve(eye + L, jnp.broadcast_to(eye, L.shape),
                                       left_side=True, lower=True)
    u = jnp.einsum('nbhij,nbhjv->nbhiv', Tinv, v * beta[..., None])
    w = jnp.einsum('nbhij,nbhjk->nbhik', Tinv, k_beta * jnp.exp(gc)[..., None])
    attn = jnp.where(causal, jnp.einsum('nbhid,nbhjd->nbhij', q, k) * decay, 0.0)
    q_dec = q * jnp.exp(gc)[..., None]
    k_dec = k * jnp.exp(gc[..., -1:] - gc)[..., None]
    g_last = jnp.exp(gc[..., -1])

    def step(S, xs):
        u_i, w_i, attn_i, qd_i, kd_i, gl_i = xs
        v_new = u_i - jnp.einsum('bhck,bhkv->bhcv', w_i, S)
        o = jnp.einsum('bhck,bhkv->bhcv', qd_i, S) + jnp.einsum('bhij,bhjv->bhiv', attn_i, v_new)
        S = S * gl_i[..., None, None] + jnp.einsum('bhck,bhcv->bhkv', kd_i, v_new)
        return S, o

    S, o = lax.scan(step, S0, (u, w, attn, q_dec, k_dec, g_last))
    o = o.transpose(1, 0, 3, 2, 4).reshape(B, Tp, H, v.shape[-1])[:, :T]
    return o, S


def delta_branch(q, k, v, beta_logit, alpha, gate, S0, conv_buf, conv_w, a_log, dt_bias, a_norm_g):
    B, T, _ = q.shape
    f32 = jnp.float32
    qkv, new_buf = causal_conv(conv_buf, jnp.concatenate([q, k, v], axis=-1), conv_w)
    q, k, v = jnp.split(qkv, [A_KWIDTH, 2 * A_KWIDTH], axis=-1)
    q = l2norm(q.reshape(B, T, A_HEADS, A_DK).astype(f32)) * (A_DK ** -0.5)
    k = l2norm(k.reshape(B, T, A_HEADS, A_DK).astype(f32))
    v = v.reshape(B, T, A_HEADS, A_DV).astype(f32)
    beta = jax.nn.sigmoid(beta_logit.astype(f32))
    g = -jnp.exp(a_log.astype(f32)) * jax.nn.softplus(alpha.astype(f32) + dt_bias.astype(f32))
    o, S = gated_delta_chunked(q, k, v, beta, g, S0.astype(f32))
    o = rmsnorm(o, a_norm_g) * jax.nn.silu(gate.reshape(B, T, A_HEADS, A_DV).astype(f32))
    return o.reshape(B, T, A_WIDTH).astype(gate.dtype), S.astype(S0.dtype), new_buf


def chunk_mlp_branch(u, v, gate, ln_v_g, ln_v_b, w_spatial, b_spatial):
    B, T, _ = u.shape
    vn = layernorm(v, ln_v_g, ln_v_b)
    Tp = -(-T // B_CHUNK) * B_CHUNK
    N = Tp // B_CHUNK
    vp = jnp.pad(vn, ((0, 0), (0, Tp - T), (0, 0))).reshape(B, N, B_CHUNK, B_GROUPS, B_WIDTH // B_GROUPS)
    idx = jnp.arange(B_CHUNK)
    ws = jnp.where(idx[:, None] >= idx[None, :], w_spatial, 0.0)
    s = jnp.einsum('gts,bnsgc->bntgc', ws, vp) + b_spatial.T[None, None, :, :, None]
    s = s.reshape(B, Tp, B_WIDTH)[:, :T]
    return u * s * jax.nn.silu(gate), vn


def memory_kv(mem, mem_norm_g, w_mem_kv):
    B, M, _ = mem.shape
    kv = rmsnorm(mem, mem_norm_g) @ w_mem_kv
    k, v = jnp.split(kv, [C_WIDTH], axis=-1)
    return k.reshape(B, M, C_HEADS, C_DH), v.reshape(B, M, C_HEADS, C_DH)


def memory_branch(q, gate, mem_k, mem_v):
    B, T, _ = q.shape
    f32 = jnp.float32
    qh = q.reshape(B, T, C_HEADS, C_DH).astype(f32)
    s = jnp.einsum('bthd,bmhd->bhtm', qh, mem_k.astype(f32)) * (C_DH ** -0.5)
    p = jax.nn.softmax(s, axis=-1)
    o = jnp.einsum('bhtm,bmhd->bthd', p, mem_v.astype(f32)).reshape(B, T, C_WIDTH)
    return (o * jax.nn.silu(gate.astype(f32))).astype(q.dtype)


def mixer_layer(x, mem_k, mem_v, S0, conv_buf, norm_g, w_in, conv_w, a_log, dt_bias, a_norm_g,
                ln_v_g, ln_v_b, w_spatial, b_spatial, w_br_a, w_br_b, w_br_c, b_gate, w_out):
    B, T, _ = x.shape
    h = rmsnorm(x, norm_g)
    proj = h @ w_in
    (aq, ak, av, abeta, aalpha, agate, bu, bv, bgate, cq, cgate, mg) = jnp.split(proj, _split_points(), axis=-1)
    ya, S, buf = delta_branch(aq, ak, av, abeta, aalpha, agate, S0, conv_buf, conv_w, a_log, dt_bias, a_norm_g)
    yb, vn = chunk_mlp_branch(bu, bv, bgate, ln_v_g, ln_v_b, w_spatial, b_spatial)
    yc = memory_branch(cq, cgate, mem_k, mem_v)
    gates = jax.nn.sigmoid((mg.reshape(B, T, N_BRANCH, D_MODEL) + b_gate).astype(jnp.float32)).astype(x.dtype)
    merged = gates[:, :, 0] * (ya @ w_br_a) + gates[:, :, 1] * (yb @ w_br_b) + gates[:, :, 2] * (yc @ w_br_c)
    return x + merged @ w_out, S, buf, vn


def setup_inputs(seed: int = 0) -> dict:
    key = jax.random.key(seed)
    ks = list(jax.random.split(key, 32))
    f32 = jnp.float32

    def nrm(i, shape, s=1.0):
        return jax.random.normal(ks[i], shape, f32) * s

    dt = jnp.exp(jax.random.uniform(ks[10], (DEPTH, A_HEADS), f32)
                 * (math.log(0.1) - math.log(0.001)) + math.log(0.001))
    return {
        "x_prompt": nrm(0, (BATCH, SEQ, D_MODEL)),
        "x_sample": nrm(1, (DEC_BATCH, DEC_SEQ, D_MODEL)),
        "cache_mem_k": nrm(2, (DEPTH, DEC_BATCH, MEM_LEN, C_HEADS, C_DH)),
        "cache_mem_v": nrm(3, (DEPTH, DEC_BATCH, MEM_LEN, C_HEADS, C_DH)),
        "state_delta": nrm(4, (DEPTH, DEC_BATCH, A_HEADS, A_DK, A_DV), 0.1),
        "state_conv": nrm(5, (DEPTH, DEC_BATCH, CONV_WIDTH - 1, CONV_CH)),
        "mem_prompt": nrm(6, (BATCH, MEM_LEN, D_MODEL)),
        "norm_g": 1.0 + nrm(7, (DEPTH, D_MODEL), 0.02),
        "w_in": nrm(8, (DEPTH, D_MODEL, IN_COLS), D_MODEL ** -0.5),
        "conv_w": nrm(9, (DEPTH, CONV_WIDTH, CONV_CH), 0.5),
        "a_log": jnp.log(jax.random.uniform(ks[11], (DEPTH, A_HEADS), f32, 1.0, 16.0)),
        "dt_bias": dt + jnp.log(-jnp.expm1(-dt)),
        "a_norm_g": 1.0 + nrm(12, (DEPTH, A_DV), 0.02),
        "ln_v_g": 1.0 + nrm(13, (DEPTH, B_WIDTH), 0.02),
        "ln_v_b": nrm(14, (DEPTH, B_WIDTH), 0.02),
        "w_spatial": nrm(15, (DEPTH, B_GROUPS, B_CHUNK, B_CHUNK), 0.5 * B_CHUNK ** -0.5),
        "b_spatial": 1.0 + nrm(16, (DEPTH, B_GROUPS, B_CHUNK), 0.02),
        "mem_norm_g": 1.0 + nrm(17, (DEPTH, D_MODEL), 0.02),
        "w_mem_kv": nrm(18, (DEPTH, D_MODEL, 2 * C_WIDTH), D_MODEL ** -0.5),
        "w_br_a": nrm(19, (DEPTH, A_WIDTH, D_MODEL), A_WIDTH ** -0.5),
        "w_br_b": nrm(20, (DEPTH, B_WIDTH, D_MODEL), B_WIDTH ** -0.5),
        "w_br_c": nrm(21, (DEPTH, C_WIDTH, D_MODEL), C_WIDTH ** -0.5),
        "b_gate": nrm(22, (DEPTH, N_BRANCH, D_MODEL), 0.02),
        "w_out": nrm(23, (DEPTH, D_MODEL, D_MODEL), D_MODEL ** -0.5),
        "final_norm_g": 1.0 + nrm(24, (D_MODEL,), 0.02),
    }


def reference(x_prompt, x_sample, cache_mem_k, cache_mem_v, state_delta, state_conv, mem_prompt,
              norm_g, w_in, conv_w, a_log, dt_bias, a_norm_g, ln_v_g, ln_v_b, w_spatial, b_spatial,
              mem_norm_g, w_mem_kv, w_br_a, w_br_b, w_br_c, b_gate, w_out, final_norm_g):
    hp, hs = x_prompt, x_sample
    bp = x_prompt.shape[0]
    sd_p, sc_p, mk_p, mv_p, sd_s, sc_s, cv_s = [], [], [], [], [], [], []
    for l in range(DEPTH):
        lw = (norm_g[l], w_in[l], conv_w[l], a_log[l], dt_bias[l], a_norm_g[l], ln_v_g[l], ln_v_b[l],
              w_spatial[l], b_spatial[l], w_br_a[l], w_br_b[l], w_br_c[l], b_gate[l], w_out[l])
        mk, mv = memory_kv(mem_prompt, mem_norm_g[l], w_mem_kv[l])
        s0 = jnp.zeros((bp, A_HEADS, A_DK, A_DV), x_prompt.dtype)
        c0 = jnp.zeros((bp, CONV_WIDTH - 1, CONV_CH), x_prompt.dtype)
        hp, s_p, c_p, _ = mixer_layer(hp, mk, mv, s0, c0, *lw)
        hs, s_s, c_s, v_s = mixer_layer(hs, cache_mem_k[l], cache_mem_v[l], state_delta[l], state_conv[l], *lw)
        sd_p.append(s_p)
        sc_p.append(c_p)
        mk_p.append(mk)
        mv_p.append(mv)
        sd_s.append(s_s)
        sc_s.append(c_s)
        cv_s.append(v_s)
    y_prompt = rmsnorm(hp, final_norm_g)
    y_sample = rmsnorm(hs, final_norm_g)
    return (y_prompt, y_sample, jnp.stack(sd_p), jnp.stack(sc_p), jnp.stack(mk_p), jnp.stack(mv_p),
            jnp.stack(sd_s), jnp.stack(sc_s), jnp.stack(cv_s))
```

```cpp
#include <hip/hip_runtime.h>
#include <hip/hip_cooperative_groups.h>
#include <cstdio>
namespace cg = cooperative_groups;

#define LAS __attribute__((address_space(3)))
#define GAS __attribute__((address_space(1)))
typedef unsigned short bf16_t;
typedef short bf16x8 __attribute__((ext_vector_type(8)));
typedef short bf16x4 __attribute__((ext_vector_type(4)));
typedef float f32x4 __attribute__((ext_vector_type(4)));
typedef unsigned u32x4 __attribute__((ext_vector_type(4)));
typedef unsigned u32x2 __attribute__((ext_vector_type(2)));

constexpr int NP = 16384, NS = 128, MROWS = 16640, HM0 = 16640, LDA = 2560, PLD = 4608;
constexpr int C_AQ = 0, C_AK = 512, C_AV = 1024, C_AGATE = 1536, C_BU = 2048, C_BV = 2560, C_BGATE = 3072, C_CQ = 3584, C_CGATE = 4096;
constexpr int A_H = 0, A_YA = 1024, A_YB = 1536, A_YC = 2048;
constexpr float EPS = 1e-6f;
constexpr size_t OFF_W1T = 0;
constexpr size_t OFF_WG3 = 11534336;
constexpr size_t OFF_WOUT = 20971520;
constexpr size_t OFF_ACT = 23068672;
constexpr size_t OFF_PROJ = 118751232;
constexpr size_t OFF_ATTN = 272105472;
constexpr size_t OFF_MEMKV = 280494080;
constexpr size_t OFF_BETAG = 284688384;
constexpr size_t OFF_ROWSQ = 285216768;
constexpr size_t OFF_GL = 285283328;
constexpr size_t OFF_CNT = 285287424;
constexpr size_t WS_END = 285287680;
constexpr size_t SCR_PER_WG = 393216;
constexpr size_t OFF_MERGED = OFF_PROJ + 256 * SCR_PER_WG;
constexpr size_t DO_U = 0, DO_W = 16777216, DO_QD = 33554432, DO_KDT = 50331648;
constexpr size_t O_YS = 16777216, O_SDP = 16908288, O_SCP = 17432576, O_MKP = 17469440, O_MVP = 18518016, O_SDS = 19566592, O_SCS = 27955200, O_CVS = 28545024;
constexpr int LDS_BYTES = 143360;
constexpr int LDS_ITEM = 143344;

struct Params {
    const float *x_prompt, *x_sample, *cache_k, *cache_v, *state_delta, *state_conv, *mem_prompt, *norm_g, *w_in, *conv_w, *a_log, *dt_bias, *a_norm_g,
        *ln_v_g, *ln_v_b, *w_spatial, *b_spatial, *mem_norm_g, *w_mem_kv, *w_br_a, *w_br_b, *w_br_c, *b_gate, *w_out, *final_norm_g;
    float* out;
    unsigned char* ws;
    int ph_lo, ph_hi, mask, pad_;
};

typedef __bf16 bf16v2_t __attribute__((ext_vector_type(2)));
__device__ __forceinline__ unsigned cvt_pk_bf16(float lo, float hi) { bf16v2_t v; v[0] = (__bf16)lo; v[1] = (__bf16)hi; return __builtin_bit_cast(unsigned, v); }
__device__ __forceinline__ bf16_t f2bf(float f) { return (bf16_t)(cvt_pk_bf16(f, 0.f) & 0xffffu); }
__device__ __forceinline__ float bf2f(bf16_t b) { return __uint_as_float(((unsigned)b) << 16); }
__device__ __forceinline__ float bflo(unsigned u) { return __uint_as_float(u << 16); }
__device__ __forceinline__ float bfhi(unsigned u) { return __uint_as_float(u & 0xffff0000u); }
__device__ __forceinline__ float sigmoidf_(float x) { return __builtin_amdgcn_rcpf(1.f + __expf(-x)); }
__device__ __forceinline__ float siluf_(float x) { return x * __builtin_amdgcn_rcpf(1.f + __expf(-x)); }
__device__ __forceinline__ float wave_sum(float v) {
#pragma unroll
    for (int o = 32; o >= 1; o >>= 1) v += __shfl_xor(v, o);
    return v;
}
__device__ __forceinline__ int opaque_zero() { int z; asm volatile("v_mov_b32 %0, 0" : "=v"(z)); return z; }
__device__ __forceinline__ f32x4 mfma16(bf16x8 a, bf16x8 b, f32x4 c) { return __builtin_amdgcn_mfma_f32_16x16x32_bf16(a, b, c, 0, 0, 0); }
__device__ __forceinline__ bf16x8 ldg8(const bf16_t* p) { return *(const bf16x8*)p; }
__device__ __forceinline__ bf16x8 lds8(LAS unsigned char* l, int off) { return *(const LAS bf16x8*)(l + off); }
__device__ __forceinline__ u32x4 pack8(f32x4 a, f32x4 b) { u32x4 r; r[0] = cvt_pk_bf16(a[0], a[1]); r[1] = cvt_pk_bf16(a[2], a[3]); r[2] = cvt_pk_bf16(b[0], b[1]); r[3] = cvt_pk_bf16(b[2], b[3]); return r; }

__device__ __forceinline__ void grid_sync_all(cg::grid_group& grid) {
    asm volatile("s_waitcnt vmcnt(0)" ::: "memory");
    grid.sync();
    if (threadIdx.x < 64) { __builtin_amdgcn_fence(__ATOMIC_ACQUIRE, "agent"); asm volatile("s_waitcnt vmcnt(0)" ::: "memory"); }
    __syncthreads();
}

namespace pg8 {
constexpr int BM = 256, BK = 64, HALF = 128, HTB = HALF * BK * 2, STAGE_BYTES = 8 * HTB;
__device__ __forceinline__ int lds_byte(int r, int c) { const int st = (r >> 4) * 2 + (c >> 5), rr = r & 15, cc = c & 31, ob = rr * 64 + cc * 2; return st * 1024 + (ob ^ (((ob >> 9) & 1) << 5)); }
__device__ __forceinline__ void stage_rc(int b, int& R, int& C) { const int st = b / 1024, sb = b % 1024, swz = sb ^ (((sb >> 9) & 1) << 5); R = (st >> 1) * 16 + swz / 64; C = (st & 1) * 32 + (swz % 64) / 2; }
__device__ __forceinline__ int perm32(int rho) { const int n = rho >> 4, i = rho & 15; return 8 * (i >> 2) + 4 * n + (i & 3); }
struct Unit { int pm, pn, sub; };

template <class Epi, class Sched>
__device__ __forceinline__ void gemm_phase(LAS unsigned char* lds, const int lda, const int ldb, const Sched& S, const Epi& E) {
    const int tid = threadIdx.x, wid = __builtin_amdgcn_readfirstlane(tid >> 6), lane = tid & 63, wr = wid >> 2, wc = wid & 3, fr = lane & 15, fq = lane >> 4;
    unsigned voffA[2], voffB[2];
#pragma unroll
    for (int i = 0; i < 2; ++i) { int R, C; stage_rc(tid * 16 + i * 8192, R, C); const int Rb = (R & ~31) + perm32(R & 31);
        voffA[i] = (unsigned)(R * lda + C) * 2u; voffB[i] = (unsigned)(Rb * ldb + C) * 2u; }
    const size_t kstep = (size_t)(BK * 2);
    const size_t hstepA = (size_t)HALF * lda * 2, hstepB = (size_t)HALF * ldb * 2;
    const unsigned ldsw = (unsigned)wid * 1024u;
    const int aoff = lds_byte(wr * 64 + fr, fq * 8), boff = lds_byte(wc * 32 + fr, fq * 8);
#define PG8_SA(b, h) (((b) * 2 + (h)) * HTB)
#define PG8_SB(b, h) ((4 + (b) * 2 + (h)) * HTB)
#define PG8_STAGE(bufoff, gbase, voff) do { _Pragma("unroll") for (int _i = 0; _i < 2; ++_i) \
        __builtin_amdgcn_global_load_lds((const unsigned*)((const char*)(gbase) + (voff)[_i]), (LAS unsigned*)(lds + (bufoff) + ldsw + _i * 8192), 16, 0, 0); } while (0)
#define PG8_LDA(dst, b, h) do { _Pragma("unroll") for (int m = 0; m < 4; ++m) _Pragma("unroll") for (int k = 0; k < 2; ++k) dst[m][k] = *(const LAS bf16x8*)(lds + PG8_SA(b, h) + aoff + m * 2048 + k * 1024); } while (0)
#define PG8_LDB(dst, b, h) do { _Pragma("unroll") for (int n = 0; n < 2; ++n) _Pragma("unroll") for (int k = 0; k < 2; ++k) dst[n][k] = *(const LAS bf16x8*)(lds + PG8_SB(b, h) + boff + n * 2048 + k * 1024); } while (0)
#define PG8_MMA(ai, bj, At, Bt) do { __builtin_amdgcn_s_setprio(1); _Pragma("unroll") for (int m = 0; m < 4; ++m) _Pragma("unroll") for (int n = 0; n < 2; ++n) _Pragma("unroll") for (int k = 0; k < 2; ++k) \
        acc[ai][bj][m][n] = __builtin_amdgcn_mfma_f32_16x16x32_bf16(Bt[n][k], At[m][k], acc[ai][bj][m][n], 0, 0, 0); __builtin_amdgcn_s_setprio(0); } while (0)
#define PG8_WAIT_V(n) asm volatile("s_waitcnt vmcnt(" #n ")" ::: "memory")
#define PG8_WAIT_L(n) asm volatile("s_waitcnt lgkmcnt(" #n ")" ::: "memory")
#define PG8_BAR __builtin_amdgcn_s_barrier()
#define PG8_SCHED __builtin_amdgcn_sched_barrier(0)
    Unit cur, nxt; int ui = 0;
    if (!S.next(0, cur)) return;
    f32x4 acc[2][2][4][2];
    bf16x8 At[4][2], B0[2][2], B1[2][2];
    const char* cA; const char* cB; int nt;
    S.ptrs(cur, cA, cB, nt);
    PG8_STAGE(PG8_SB(0, 0), cB, voffB); PG8_STAGE(PG8_SA(0, 0), cA, voffA); PG8_STAGE(PG8_SB(0, 1), cB + hstepB, voffB); PG8_STAGE(PG8_SA(0, 1), cA + hstepA, voffA);
    if (wr == 1) PG8_BAR;
    PG8_WAIT_V(4); PG8_BAR;
    PG8_STAGE(PG8_SB(1, 0), cB + kstep, voffB); PG8_STAGE(PG8_SA(1, 0), cA + kstep, voffA); PG8_STAGE(PG8_SB(1, 1), cB + hstepB + kstep, voffB);
    PG8_WAIT_V(6); PG8_BAR;
    PG8_SCHED;
#pragma unroll
    for (int a = 0; a < 2; ++a)
#pragma unroll
        for (int b = 0; b < 2; ++b)
#pragma unroll
            for (int m = 0; m < 4; ++m)
#pragma unroll
                for (int n = 0; n < 2; ++n) acc[a][b][m][n] = (f32x4){0.f, 0.f, 0.f, 0.f};
    for (;;) {
        const bool has_next = S.next(ui + 1, nxt);
        const char* nA = cA; const char* nB = cB; int nnt = nt;
        if (has_next) S.ptrs(nxt, nA, nB, nnt);
        for (int t = 0; t < nt; t += 2) {
            const bool last = (t == nt - 2);
            const char* a1 = cA + (size_t)(t + 1) * kstep;
            const char* a2 = last ? nA : cA + (size_t)(t + 2) * kstep; const char* b2 = last ? nB : cB + (size_t)(t + 2) * kstep;
            const char* a3 = a2 + kstep; const char* b3 = b2 + kstep;
            PG8_LDB(B0, 0, 0); PG8_SCHED; PG8_LDA(At, 0, 0); PG8_STAGE(PG8_SA(1, 1), a1 + hstepA, voffA);
            PG8_WAIT_L(8); PG8_BAR; PG8_WAIT_L(0); PG8_MMA(0, 0, At, B0); PG8_BAR; PG8_SCHED;
            PG8_LDB(B1, 0, 1); PG8_STAGE(PG8_SB(0, 0), b2, voffB);
            PG8_BAR; PG8_WAIT_L(0); PG8_MMA(0, 1, At, B1); PG8_BAR;
            PG8_LDA(At, 0, 1); PG8_STAGE(PG8_SA(0, 0), a2, voffA);
            PG8_BAR; PG8_WAIT_L(0); PG8_MMA(1, 0, At, B0); PG8_BAR; PG8_SCHED;
            PG8_STAGE(PG8_SB(0, 1), b2 + hstepB, voffB);
            PG8_WAIT_V(6); PG8_BAR; PG8_MMA(1, 1, At, B1); PG8_BAR;
            PG8_LDB(B0, 1, 0); PG8_SCHED; PG8_LDA(At, 1, 0); PG8_STAGE(PG8_SA(0, 1), a2 + hstepA, voffA);
            PG8_WAIT_L(8); PG8_BAR; PG8_WAIT_L(0); PG8_MMA(0, 0, At, B0); PG8_BAR; PG8_SCHED;
            PG8_LDB(B1, 1, 1); PG8_STAGE(PG8_SB(1, 0), b3, voffB);
            PG8_BAR; PG8_WAIT_L(0); PG8_MMA(0, 1, At, B1); PG8_BAR;
            PG8_LDA(At, 1, 1); PG8_STAGE(PG8_SA(1, 0), a3, voffA);
            PG8_BAR; PG8_WAIT_L(0); PG8_MMA(1, 0, At, B0); PG8_BAR; PG8_SCHED;
            PG8_STAGE(PG8_SB(1, 1), b3 + hstepB, voffB);
            PG8_WAIT_V(6); PG8_BAR; PG8_MMA(1, 1, At, B1); PG8_BAR;
        }
        __builtin_amdgcn_sched_barrier(0);
        E(acc, cur, wr, wc, fr, fq);
        __builtin_amdgcn_sched_barrier(0);
        if (!has_next) break;
        const float kf = S.keep(cur) ? 1.f : 0.f;
#pragma unroll
        for (int a = 0; a < 2; ++a)
#pragma unroll
            for (int b = 0; b < 2; ++b)
#pragma unroll
                for (int m = 0; m < 4; ++m)
#pragma unroll
                    for (int n = 0; n < 2; ++n) { if constexpr (Sched::HAS_KEEP) acc[a][b][m][n] *= kf; else acc[a][b][m][n] = (f32x4){0.f, 0.f, 0.f, 0.f}; }
        cur = nxt; cA = nA; cB = nB; nt = nnt; ++ui;
    }
    PG8_WAIT_V(0);
    if (wr == 0) PG8_BAR;
    PG8_BAR;
    if constexpr (Epi::HAS_POST) E.post(acc, cur, wr, wc, fr, fq);
#undef PG8_SA
#undef PG8_SB
#undef PG8_STAGE
#undef PG8_LDA
#undef PG8_LDB
#undef PG8_MMA
#undef PG8_WAIT_V
#undef PG8_WAIT_L
#undef PG8_BAR
#undef PG8_SCHED
}
}

struct SchedG1 {
    const char* A; const char* B; int G, c;
    __device__ __forceinline__ bool next(int i, pg8::Unit& u) const {
        const int L = i * G + c; if (L >= 1202) return false;
        if (L < 1170) {
            const int nM = 65, nN = 18, nwg = 1170;
            int wgid = L; { const int q = nwg / 8, r = nwg % 8, xcd = wgid % 8, off = wgid / 8; wgid = (xcd < r ? xcd * (q + 1) : r * (q + 1) + (xcd - r) * q) + off; }
            const int nig = 8 * nN, gid = wgid / nig, fm = gid * 8, gsz = (nM - fm) < 8 ? (nM - fm) : 8;
            u.pm = fm + ((wgid % nig) % gsz); u.pn = (wgid % nig) / gsz;
        } else { const int l2 = L - 1170; u.pm = 65 + (l2 >> 2); u.pn = 18 + (l2 & 3); }
        u.sub = 0; return true;
    }
    __device__ __forceinline__ void ptrs(const pg8::Unit& u, const char*& a, const char*& b, int& nt) const {
        a = A + (size_t)u.pm * 256 * LDA * 2; b = B + (size_t)u.pn * 256 * 1024 * 2; nt = 16;
    }
    static constexpr bool HAS_KEEP = false;
    __device__ __forceinline__ bool keep(const pg8::Unit&) const { return false; }
};
struct EpiG1 {
    static constexpr bool HAS_POST = false;
    bf16_t* proj; bf16_t* memkv; float* out;
    __device__ __forceinline__ void operator()(f32x4 (&acc)[2][2][4][2], const pg8::Unit& u, int wr, int wc, int fr, int fq) const {
        const int row0 = u.pm * 256 + wr * 64 + fr, col0 = u.pn * 256 + wc * 32 + 8 * fq;
        if (u.pn < 18) {
#pragma unroll
            for (int ai = 0; ai < 2; ++ai)
#pragma unroll
                for (int m = 0; m < 4; ++m) { bf16_t* rp = proj + (size_t)(row0 + ai * 128 + m * 16) * PLD + col0;
#pragma unroll
                    for (int bj = 0; bj < 2; ++bj) *(u32x4*)(rp + bj * 128) = pack8(acc[ai][bj][m][0], acc[ai][bj][m][1]); }
        } else {
            const int rr0 = row0 - HM0, cc0 = col0 - 4608;
#pragma unroll
            for (int ai = 0; ai < 2; ++ai)
#pragma unroll
                for (int m = 0; m < 4; ++m) { const int rr = rr0 + ai * 128 + m * 16;
#pragma unroll
                    for (int bj = 0; bj < 2; ++bj) { const int cc = cc0 + bj * 128;
                        *(u32x4*)(memkv + (size_t)rr * 1024 + cc) = pack8(acc[ai][bj][m][0], acc[ai][bj][m][1]);
                        float* op = out + (cc < 512 ? O_MKP + (size_t)rr * 512 + cc : O_MVP + (size_t)rr * 512 + (cc - 512));
                        *(f32x4*)op = acc[ai][bj][m][0]; *(f32x4*)(op + 4) = acc[ai][bj][m][1]; } }
        }
    }
};

struct SchedG3 {
    const char* A; const char* B; int G, c;
    __device__ __forceinline__ bool next(int i, pg8::Unit& u) const {
        const int r = i / 6, T = r * G + c; if (T >= 256) return false;
        const int xcd = T & 7, idx = T >> 3; u.pm = xcd * 8 + (idx >> 2); u.pn = idx & 3; u.sub = i - r * 6; return true;
    }
    __device__ __forceinline__ void ptrs(const pg8::Unit& u, const char*& a, const char*& b, int& nt) const {
        const int br = u.sub >= 3 ? u.sub - 3 : u.sub;
        const char* a0 = A + (size_t)u.pm * 256 * LDA * 2; const char* b0 = B + ((size_t)br * 1024 + (size_t)u.pn * 256) * 1536 * 2;
        if (u.sub >= 3) { a = a0 + (A_YA + br * 512) * 2; b = b0 + 1024 * 2; nt = 8; } else { a = a0; b = b0; nt = 16; }
    }
    static constexpr bool HAS_KEEP = false;
    __device__ __forceinline__ bool keep(const pg8::Unit&) const { return false; }
};
__device__ __forceinline__ void unpack8(const u32x4 g, f32x4& g0, f32x4& g1) { g0 = (f32x4){bflo(g[0]), bfhi(g[0]), bflo(g[1]), bfhi(g[1])}; g1 = (f32x4){bflo(g[2]), bfhi(g[2]), bflo(g[3]), bfhi(g[3])}; }
struct EpiG3 {
    static constexpr bool HAS_POST = false;
    unsigned char* scr; bf16_t* merged; const float* b_gate;
    __device__ __forceinline__ void operator()(f32x4 (&acc)[2][2][4][2], const pg8::Unit& u, int wr, int wc, int fr, int fq) const {
        const int tid = threadIdx.x + opaque_zero();
        const int row0 = u.pm * 256 + wr * 64 + fr, col0 = u.pn * 256 + wc * 32 + 8 * fq + opaque_zero();
        const bool gate = u.sub < 3; const int br = gate ? u.sub : u.sub - 3;
        GAS u32x4* s0 = (GAS u32x4*)scr + tid * 4;
        const int boff = br * 8192;
        const float* bp = b_gate + br * 1024 + col0;
        bf16_t* mp = merged + (size_t)row0 * 1024 + col0;
#pragma unroll
        for (int ai = 0; ai < 2; ++ai)
#pragma unroll
            for (int bj = 0; bj < 2; ++bj) {
                if (gate) {
                    const f32x4 b0 = *(const f32x4*)(bp + bj * 128), b1 = *(const f32x4*)(bp + bj * 128 + 4);
#pragma unroll
                    for (int m = 0; m < 4; ++m) { f32x4 g0, g1;
#pragma unroll
                        for (int e = 0; e < 4; ++e) { g0[e] = sigmoidf_(acc[ai][bj][m][0][e] + b0[e]); g1[e] = sigmoidf_(acc[ai][bj][m][1][e] + b1[e]); }
                        s0[boff + m] = pack8(g0, g1); }
                } else {
                    u32x4 gn[4], gm[4];
#pragma unroll
                    for (int m = 0; m < 4; ++m) { gn[m] = s0[boff + m]; gm[m] = s0[m]; }
#pragma unroll
                    for (int m = 0; m < 4; ++m) { f32x4 n0, n1, p0, p1; unpack8(gn[m], n0, n1); unpack8(gm[m], p0, p1);
                        f32x4 r0 = acc[ai][bj][m][0] * n0, r1 = acc[ai][bj][m][1] * n1;
                        if (br > 0) { r0 += p0; r1 += p1; }
                        const u32x4 pk = pack8(r0, r1);
                        if (br < 2) s0[m] = pk; else *(u32x4*)(mp + (size_t)(ai * 128 + m * 16) * 1024 + bj * 128) = pk; }
                }
                s0 += 2048; asm volatile("" : "+v"(s0)); __builtin_amdgcn_sched_barrier(0); }
    }
};

struct SchedG4 {
    const char* A; const char* B; int G, c;
    __device__ __forceinline__ bool next(int i, pg8::Unit& u) const {
        const int T = i * G + c; if (T >= 256) return false;
        const int xcd = T & 7, idx = T >> 3; u.pm = xcd * 8 + (idx >> 2); u.pn = idx & 3; u.sub = 0; return true;
    }
    __device__ __forceinline__ void ptrs(const pg8::Unit& u, const char*& a, const char*& b, int& nt) const {
        a = A + (size_t)u.pm * 256 * 1024 * 2; b = B + (size_t)u.pn * 256 * 1024 * 2; nt = 16;
    }
    static constexpr bool HAS_KEEP = false;
    __device__ __forceinline__ bool keep(const pg8::Unit&) const { return false; }
};
struct EpiG4 {
    static constexpr bool HAS_POST = true;
    const float* x; float* out; float* rowsq; const float* fg; cg::grid_group* grid;
    __device__ __forceinline__ void operator()(f32x4 (&acc)[2][2][4][2], const pg8::Unit& u, int wr, int wc, int fr, int fq) const {
        const int row0 = u.pm * 256 + wr * 64 + fr + opaque_zero(), col0 = u.pn * 256 + wc * 32 + 8 * fq;
        const GAS float* xp = (const GAS float*)x + (size_t)row0 * 1024 + col0; float* rq = rowsq + row0;
#pragma unroll
        for (int ai = 0; ai < 2; ++ai) {
#pragma unroll
            for (int m = 0; m < 4; ++m) { float ss = 0.f;
#pragma unroll
                for (int bj = 0; bj < 2; ++bj) {
                    acc[ai][bj][m][0] += *(const GAS f32x4*)(xp + bj * 128); acc[ai][bj][m][1] += *(const GAS f32x4*)(xp + bj * 128 + 4);
#pragma unroll
                    for (int e = 0; e < 4; ++e) ss += acc[ai][bj][m][0][e] * acc[ai][bj][m][0][e] + acc[ai][bj][m][1][e] * acc[ai][bj][m][1][e]; }
                ss += __shfl_xor(ss, 16); ss += __shfl_xor(ss, 32);
                if (fq == 0) unsafeAtomicAdd(rq, ss);
                xp += 16 * 1024; rq += 16;
                if (m & 1) asm volatile("" : "+v"(xp), "+v"(rq)); }
            xp += 64 * 1024; rq += 64; }
    }
    __device__ __forceinline__ void post(f32x4 (&acc)[2][2][4][2], const pg8::Unit& u, int wr, int wc, int fr, int fq) const {
        grid_sync_all(*grid);
        const int row0 = u.pm * 256 + wr * 64 + fr + opaque_zero(), col0 = u.pn * 256 + wc * 32 + 8 * fq;
        GAS float* op = (GAS float*)out + (size_t)row0 * 1024 + col0; const float* rq = rowsq + row0;
        f32x4 g[2][2];
#pragma unroll
        for (int bj = 0; bj < 2; ++bj) { g[bj][0] = *(const f32x4*)(fg + col0 + bj * 128); g[bj][1] = *(const f32x4*)(fg + col0 + bj * 128 + 4); }
#pragma unroll
        for (int ai = 0; ai < 2; ++ai) {
#pragma unroll
            for (int m = 0; m < 4; ++m) {
                const float rs = rsqrtf(__hip_atomic_load(rq, __ATOMIC_RELAXED, __HIP_MEMORY_SCOPE_AGENT) * (1.f / 1024.f) + EPS);
#pragma unroll
                for (int bj = 0; bj < 2; ++bj) { *(GAS f32x4*)(op + bj * 128) = acc[ai][bj][m][0] * rs * g[bj][0]; *(GAS f32x4*)(op + bj * 128 + 4) = acc[ai][bj][m][1] * rs * g[bj][1]; }
                op += 16 * 1024; rq += 16;
                if (m & 1) asm volatile("" : "+v"(op), "+v"(rq)); }
            op += 64 * 1024; rq += 64; }
    }
};

__device__ __forceinline__ void transpose_tile(const Params& p, LAS unsigned char* lds, int t) {
    const float* src; int sld, col0, ntn; bf16_t* dst; int dld;
    bf16_t* W1T = (bf16_t*)(p.ws + OFF_W1T); bf16_t* WG3 = (bf16_t*)(p.ws + OFF_WG3); bf16_t* WOUT = (bf16_t*)(p.ws + OFF_WOUT);
    if (t < 384) { src = p.w_in; sld = 7688; col0 = 0; ntn = 24; dst = W1T; dld = 1024; }
    else if (t < 1152) { t -= 384; src = p.w_in; sld = 7688; col0 = 1544; ntn = 48; dst = W1T + (size_t)1536 * 1024; dld = 1024; }
    else if (t < 1408) { t -= 1152; src = p.w_mem_kv; sld = 1024; col0 = 0; ntn = 16; dst = W1T + (size_t)4608 * 1024; dld = 1024; }
    else if (t < 2176) { t -= 1408; const int i = t >> 8; t &= 255; src = p.w_in; sld = 7688; col0 = 4616 + i * 1024; ntn = 16; dst = WG3 + (size_t)i * 1024 * 1536; dld = 1536; }
    else if (t < 2304) { t -= 2176; src = p.w_br_a; sld = 1024; col0 = 0; ntn = 16; dst = WG3 + 1024; dld = 1536; }
    else if (t < 2432) { t -= 2304; src = p.w_br_b; sld = 1024; col0 = 0; ntn = 16; dst = WG3 + (size_t)1 * 1024 * 1536 + 1024; dld = 1536; }
    else if (t < 2560) { t -= 2432; src = p.w_br_c; sld = 1024; col0 = 0; ntn = 16; dst = WG3 + (size_t)2 * 1024 * 1536 + 1024; dld = 1536; }
    else { t -= 2560; src = p.w_out; sld = 1024; col0 = 0; ntn = 16; dst = WOUT; dld = 1024; }
    const int k0 = (t / ntn) * 64, n0 = (t % ntn) * 64, tid = threadIdx.x;
    LAS float* tile = (LAS float*)lds;
    __syncthreads();
#pragma unroll
    for (int ps = 0; ps < 2; ++ps) { const int r = (tid >> 4) + ps * 32, c4 = (tid & 15) * 4;
        const f32x4 v = *(const f32x4*)(src + (size_t)(k0 + r) * sld + col0 + n0 + c4);
        tile[r * 65 + c4] = v[0]; tile[r * 65 + c4 + 1] = v[1]; tile[r * 65 + c4 + 2] = v[2]; tile[r * 65 + c4 + 3] = v[3]; }
    __syncthreads();
    const int n = tid >> 3, kc = (tid & 7) * 8;
    u32x4 o;
#pragma unroll
    for (int j = 0; j < 4; ++j) o[j] = cvt_pk_bf16(tile[(kc + 2 * j) * 65 + n], tile[(kc + 2 * j + 1) * 65 + n]);
    *(u32x4*)(dst + (size_t)(n0 + n) * dld + k0 + kc) = o;
}

static __device__ __forceinline__ void phase_prep(const Params& p, LAS unsigned char* lds) {
    const int tid = threadIdx.x, wg = blockIdx.x, G = gridDim.x, lane = tid & 63, wave = tid >> 6;
    float* rowsq = (float*)(p.ws + OFF_ROWSQ); unsigned* cnt = (unsigned*)(p.ws + OFF_CNT);
    for (int i = wg * 512 + tid; i < MROWS + 64; i += G * 512) { if (i < MROWS) rowsq[i] = 0.f; else cnt[i - MROWS] = 0u; }
    for (int t = wg; t < 2816; t += G) transpose_tile(p, lds, t);
    __syncthreads();
    LAS float* wb = (LAS float*)lds;
    for (int idx = tid; idx < 8192; idx += 512) { const int k = idx >> 3, j = idx & 7; wb[j * 1024 + k] = p.w_in[(size_t)k * 7688 + 1536 + j]; }
    __syncthreads();
    bf16_t* ACT = (bf16_t*)(p.ws + OFF_ACT); float* betag = (float*)(p.ws + OFF_BETAG);
    for (int row = wg * 8 + wave; row < 18560; row += G * 8) {
        const float* src; const float* gn; size_t drow;
        if (row < NP) { src = p.x_prompt + (size_t)row * 1024; gn = p.norm_g; drow = row; }
        else if (row < NP + NS) { src = p.x_sample + (size_t)(row - NP) * 1024; gn = p.norm_g; drow = row; }
        else { src = p.mem_prompt + (size_t)(row - NP - NS) * 1024; gn = p.mem_norm_g; drow = HM0 + (row - NP - NS); }
        f32x4 v[4]; float ss = 0.f;
#pragma unroll
        for (int q = 0; q < 4; ++q) { v[q] = *(const f32x4*)(src + q * 256 + lane * 4); ss += v[q][0] * v[q][0] + v[q][1] * v[q][1] + v[q][2] * v[q][2] + v[q][3] * v[q][3]; }
        ss = wave_sum(ss);
        const float rstd = rsqrtf(ss * (1.f / 1024.f) + EPS);
#pragma unroll
        for (int q = 0; q < 4; ++q) { const f32x4 g = *(const f32x4*)(gn + q * 256 + lane * 4); v[q] = v[q] * rstd * g;
            u32x2 o; o[0] = cvt_pk_bf16(v[q][0], v[q][1]); o[1] = cvt_pk_bf16(v[q][2], v[q][3]);
            *(u32x2*)(ACT + drow * LDA + q * 256 + lane * 4) = o; }
        if (row < NP + NS) {
            float d[8];
#pragma unroll
            for (int j = 0; j < 8; ++j) { float a = 0.f;
#pragma unroll
                for (int q = 0; q < 4; ++q) { const f32x4 w = *(const LAS f32x4*)(wb + j * 1024 + q * 256 + lane * 4); a += v[q][0] * w[0] + v[q][1] * w[1] + v[q][2] * w[2] + v[q][3] * w[3]; }
                d[j] = wave_sum(a); }
            float dl = d[0];
#pragma unroll
            for (int j = 1; j < 8; ++j) dl = (lane == j) ? d[j] : dl;
            if (lane < 4) betag[(size_t)row * 8 + lane] = sigmoidf_(dl);
            else if (lane < 8) { const int h = lane - 4; const float xx = dl + p.dt_bias[h]; const float sp = xx > 20.f ? xx : log1pf(expf(xx));
                betag[(size_t)row * 8 + lane] = -expf(p.a_log[h]) * sp; }
        }
    }
}

static __device__ __forceinline__ void delta_chunk_item(const Params& p, LAS unsigned char* lds, int ci) {
    const int tid = threadIdx.x, lane = tid & 63, wave = tid >> 6, l16 = lane & 15, quad = lane >> 4;
    const int bh = ci >> 5, n = ci & 31, b = bh >> 2, h = bh & 3;
    const bf16_t* PROJ = (const bf16_t*)(p.ws + OFF_PROJ); const float* betag = (const float*)(p.ws + OFF_BETAG);
    bf16_t* U = (bf16_t*)((unsigned char*)p.out + DO_U) + (size_t)ci * 8192; bf16_t* W = (bf16_t*)((unsigned char*)p.out + DO_W) + (size_t)ci * 8192;
    bf16_t* QD = (bf16_t*)((unsigned char*)p.out + DO_QD) + (size_t)ci * 8192; bf16_t* KDT = (bf16_t*)((unsigned char*)p.out + DO_KDT) + (size_t)ci * 8192;
    bf16_t* ATT = (bf16_t*)(p.ws + OFF_ATTN) + (size_t)ci * 4096; float* GL = (float*)(p.ws + OFF_GL);
    LAS bf16_t* Kb = (LAS bf16_t*)lds; LAS bf16_t* Qb = (LAS bf16_t*)(lds + 17408);
    LAS float* RHS = (LAS float*)(lds + 34816);
    LAS float* Lm = (LAS float*)(lds + 100352);
    LAS float* gcs = (LAS float*)(lds + 116736); LAS float* bts = gcs + 64;
    const int trow0 = b * 2048 + n * 64;
    __syncthreads();
    if (wave == 0) {
        float g = betag[(size_t)(trow0 + lane) * 8 + 4 + h];
#pragma unroll
        for (int o = 1; o < 64; o <<= 1) { const float t = __shfl_up(g, o); if (lane >= o) g += t; }
        gcs[lane] = g; bts[lane] = betag[(size_t)(trow0 + lane) * 8 + h];
        if (lane == 63) GL[ci] = __expf(g);
    }
    __syncthreads();
    {
        const int t = tid >> 3, cc = (tid & 7) * 16;
        const float gct = gcs[t], bet = bts[t], eg = __expf(gct);
#pragma unroll 1
        for (int sec = 0; sec < 3; ++sec) {
            const int col = sec * 512 + h * 128 + cc;
            float y[16];
#pragma unroll
            for (int e = 0; e < 16; ++e) y[e] = 0.f;
#pragma unroll
            for (int j = 0; j < 4; ++j) { const int tl = n * 64 + t - 3 + j;
                if (tl >= 0) { const bf16_t* rp = PROJ + (size_t)(b * 2048 + tl) * PLD + col; const u32x4 x0 = *(const u32x4*)rp, x1 = *(const u32x4*)(rp + 8);
                    const float* wp = p.conv_w + j * 1536 + col;
#pragma unroll
                    for (int e = 0; e < 4; ++e) { const f32x4 w = *(const f32x4*)(wp + e * 4); const unsigned ua = (e < 2 ? x0[2 * e] : x1[2 * e - 4]), ub = (e < 2 ? x0[2 * e + 1] : x1[2 * e - 3]);
                        y[e * 4] += bflo(ua) * w[0]; y[e * 4 + 1] += bfhi(ua) * w[1]; y[e * 4 + 2] += bflo(ub) * w[2]; y[e * 4 + 3] += bfhi(ub) * w[3]; } } }
            float ss = 0.f;
#pragma unroll
            for (int e = 0; e < 16; ++e) { y[e] = siluf_(y[e]); ss += y[e] * y[e]; }
            if (sec < 2) { ss += __shfl_xor(ss, 1); ss += __shfl_xor(ss, 2); ss += __shfl_xor(ss, 4);
                const float sc = rsqrtf(ss + EPS) * (sec == 0 ? 0.08838834764831845f : 1.f);
#pragma unroll
                for (int e = 0; e < 16; ++e) y[e] *= sc; }
            if (sec == 0) {
                u32x4 o0, o1, d0, d1;
#pragma unroll
                for (int e = 0; e < 4; ++e) { o0[e] = cvt_pk_bf16(y[2 * e], y[2 * e + 1]); o1[e] = cvt_pk_bf16(y[8 + 2 * e], y[9 + 2 * e]);
                    d0[e] = cvt_pk_bf16(y[2 * e] * eg, y[2 * e + 1] * eg); d1[e] = cvt_pk_bf16(y[8 + 2 * e] * eg, y[9 + 2 * e] * eg); }
                *(LAS u32x4*)(Qb + t * 136 + cc) = o0; *(LAS u32x4*)(Qb + t * 136 + cc + 8) = o1;
                *(u32x4*)(QD + t * 128 + cc) = d0; *(u32x4*)(QD + t * 128 + cc + 8) = d1;
            } else if (sec == 1) {
                u32x4 o0, o1;
#pragma unroll
                for (int e = 0; e < 4; ++e) { o0[e] = cvt_pk_bf16(y[2 * e], y[2 * e + 1]); o1[e] = cvt_pk_bf16(y[8 + 2 * e], y[9 + 2 * e]); }
                *(LAS u32x4*)(Kb + t * 136 + cc) = o0; *(LAS u32x4*)(Kb + t * 136 + cc + 8) = o1;
                const float s2 = bet * eg;
#pragma unroll
                for (int e = 0; e < 4; ++e) *(LAS f32x4*)(RHS + t * 256 + 128 + cc + e * 4) = (f32x4){y[e * 4] * s2, y[e * 4 + 1] * s2, y[e * 4 + 2] * s2, y[e * 4 + 3] * s2};
            } else {
#pragma unroll
                for (int e = 0; e < 4; ++e) *(LAS f32x4*)(RHS + t * 256 + cc + e * 4) = (f32x4){y[e * 4] * bet, y[e * 4 + 1] * bet, y[e * 4 + 2] * bet, y[e * 4 + 3] * bet};
            }
        }
    }
    __syncthreads();
    {
        const int sel = wave >> 2, it = wave & 3;
        LAS unsigned char* Xb = lds + (sel ? 17408 : 0);
        bf16x8 af[4];
#pragma unroll
        for (int ks = 0; ks < 4; ++ks) af[ks] = lds8(Xb, ((it * 16 + l16) * 136 + ks * 32 + quad * 8) * 2);
#pragma unroll
        for (int jt = 0; jt < 4; ++jt) {
            f32x4 a = {0.f, 0.f, 0.f, 0.f};
            if (jt <= it) {
#pragma unroll
                for (int ks = 0; ks < 4; ++ks) a = mfma16(af[ks], lds8(lds, ((jt * 16 + l16) * 136 + ks * 32 + quad * 8) * 2), a);
            }
            const int j = jt * 16 + l16; const float gj = gcs[j];
#pragma unroll
            for (int r = 0; r < 4; ++r) { const int i = it * 16 + quad * 4 + r;
                const float dec = (i >= j) ? __expf(gcs[i] - gj) : 0.f;
                if (sel == 0) Lm[i * 64 + j] = (i > j) ? bts[i] * a[r] * dec : 0.f;
                else ATT[i * 64 + j] = f2bf((i >= j) ? a[r] * dec : 0.f); }
        }
    }
    {
        const int d = tid >> 2, tq = (tid & 3) * 16; const float gl = gcs[63];
        u32x4 o0, o1;
#pragma unroll
        for (int e = 0; e < 8; ++e) { const int t0 = tq + 2 * e;
            const unsigned v = cvt_pk_bf16(bf2f(Kb[t0 * 136 + d]) * __expf(gl - gcs[t0]), bf2f(Kb[(t0 + 1) * 136 + d]) * __expf(gl - gcs[t0 + 1]));
            if (e < 4) o0[e] = v; else o1[e - 4] = v; }
        *(u32x4*)(KDT + d * 64 + tq) = o0; *(u32x4*)(KDT + d * 64 + tq + 8) = o1;
    }
    __syncthreads();
    if (wave < 4 && (p.mask & 32)) {
        const int col = tid;
        const LAS float* Lz = Lm + opaque_zero();
        float x[64];
#pragma unroll
        for (int i = 0; i < 64; ++i) {
            f32x4 lr[16];
#pragma unroll
            for (int j4 = 0; j4 < (i + 3) / 4; ++j4) lr[j4] = *(const LAS f32x4*)(Lz + i * 64 + j4 * 4);
            const float rcur = RHS[i * 256 + col];
            __builtin_amdgcn_sched_barrier(0);
            float s4[4] = {0.f, 0.f, 0.f, 0.f};
#pragma unroll
            for (int j4 = 0; j4 < (i + 3) / 4; ++j4) {
#pragma unroll
                for (int e = 0; e < 4; ++e) if (j4 * 4 + e < i) s4[e] += lr[j4][e] * x[j4 * 4 + e]; }
            x[i] = rcur - ((s4[0] + s4[1]) + (s4[2] + s4[3]));
            __builtin_amdgcn_sched_barrier(0);
        }
        bf16_t* dst = (col < 128) ? (U + col) : (W + (col - 128));
#pragma unroll
        for (int i = 0; i < 64; ++i) dst[i * 128] = f2bf(x[i]);
    }
}

static __device__ __forceinline__ void phase_delta_pre(const Params& p, LAS unsigned char* lds) {
    const int wg = blockIdx.x, G = gridDim.x, tid = threadIdx.x;
    const bf16_t* PROJ = (const bf16_t*)(p.ws + OFF_PROJ);
    for (int i = wg * 512 + tid; i < 8 * 3 * 1536; i += G * 512) { const int b = i / 4608, r = i % 4608, j = r / 1536, ch = r % 1536;
        p.out[O_SCP + i] = bf2f(PROJ[(size_t)(b * 2048 + 2045 + j) * PLD + ch]); }
    for (int ci = wg; ci < 1024; ci += G) delta_chunk_item(p, lds, ci);
}

struct ScanFr { bf16x8 w[4], qd[4], at[2], kd[2][2]; u32x2 u; };
__device__ __forceinline__ void scan_load(ScanFr& f, const Params& p, int ci, int vb, int vt, int tt, int dtb, int l16, int quad) {
    const bf16_t* U = (const bf16_t*)((const unsigned char*)p.out + DO_U) + (size_t)ci * 8192; const bf16_t* W = (const bf16_t*)((const unsigned char*)p.out + DO_W) + (size_t)ci * 8192;
    const bf16_t* QD = (const bf16_t*)((const unsigned char*)p.out + DO_QD) + (size_t)ci * 8192; const bf16_t* KDT = (const bf16_t*)((const unsigned char*)p.out + DO_KDT) + (size_t)ci * 8192;
    const bf16_t* ATT = (const bf16_t*)(p.ws + OFF_ATTN) + (size_t)ci * 4096;
#pragma unroll
    for (int ks = 0; ks < 4; ++ks) { f.w[ks] = ldg8(W + (tt * 16 + l16) * 128 + ks * 32 + quad * 8); f.qd[ks] = ldg8(QD + (tt * 16 + l16) * 128 + ks * 32 + quad * 8); }
#pragma unroll
    for (int ks = 0; ks < 2; ++ks) { f.at[ks] = ldg8(ATT + (tt * 16 + l16) * 64 + ks * 32 + quad * 8);
#pragma unroll
        for (int d = 0; d < 2; ++d) f.kd[d][ks] = ldg8(KDT + ((dtb + d) * 16 + l16) * 64 + ks * 32 + quad * 8); }
    f.u = *(const u32x2*)(U + (tt * 16 + l16) * 128 + vb * 32 + vt * 16 + quad * 4);
}
static __device__ __forceinline__ void scan_unit(const Params& p, LAS unsigned char* lds, int unit) {
    const int tid = threadIdx.x, lane = tid & 63, wave = tid >> 6, l16 = lane & 15, quad = lane >> 4;
    const int bh = unit >> 2, vb = unit & 3, b = bh >> 2, h = bh & 3;
    const int vt = wave & 1, tt = wave >> 1, dtb = (wave >> 1) * 2;
    LAS bf16_t* STs = (LAS bf16_t*)lds;
    LAS bf16_t* vnT = (LAS bf16_t*)(lds + 8704);
    bf16_t* PROJ = (bf16_t*)(p.ws + OFF_PROJ); const float* GL = (const float*)(p.ws + OFF_GL);
    __syncthreads();
    for (int i = tid; i < 32 * 136 / 2; i += 512) ((LAS unsigned*)STs)[i] = 0u;
    f32x4 accS[2] = {{0.f, 0.f, 0.f, 0.f}, {0.f, 0.f, 0.f, 0.f}};
    const int ci0 = bh * 32;
    const float glv = GL[ci0 + (lane & 31)];
    ScanFr cur, nxt;
    scan_load(cur, p, ci0, vb, vt, tt, dtb, l16, quad);
    nxt = cur;
    __syncthreads();
    for (int n = 0; n < 32; ++n) {
        if (n + 1 < 32) scan_load(nxt, p, ci0 + n + 1, vb, vt, tt, dtb, l16, quad);
        const float gl = __shfl(glv, n);
        f32x4 aW = {0.f, 0.f, 0.f, 0.f}, aQ = {0.f, 0.f, 0.f, 0.f};
#pragma unroll
        for (int ks = 0; ks < 4; ++ks) { const bf16x8 a = lds8(lds, ((vt * 16 + l16) * 136 + ks * 32 + quad * 8) * 2); aW = mfma16(a, cur.w[ks], aW); aQ = mfma16(a, cur.qd[ks], aQ); }
        const float u0 = bflo(cur.u[0]) - aW[0], u1 = bfhi(cur.u[0]) - aW[1], u2 = bflo(cur.u[1]) - aW[2], u3 = bfhi(cur.u[1]) - aW[3];
        vnT[(vt * 16 + quad * 4 + 0) * 72 + tt * 16 + l16] = f2bf(u0); vnT[(vt * 16 + quad * 4 + 1) * 72 + tt * 16 + l16] = f2bf(u1);
        vnT[(vt * 16 + quad * 4 + 2) * 72 + tt * 16 + l16] = f2bf(u2); vnT[(vt * 16 + quad * 4 + 3) * 72 + tt * 16 + l16] = f2bf(u3);
        asm volatile("s_waitcnt lgkmcnt(0)" ::: "memory"); __builtin_amdgcn_s_barrier(); asm volatile("" ::: "memory");
        accS[0] *= gl; accS[1] *= gl;
#pragma unroll
        for (int ks = 0; ks < 2; ++ks) { const bf16x8 a = lds8(lds, 8704 + ((vt * 16 + l16) * 72 + ks * 32 + quad * 8) * 2);
            aQ = mfma16(a, cur.at[ks], aQ); accS[0] = mfma16(a, cur.kd[0][ks], accS[0]); accS[1] = mfma16(a, cur.kd[1][ks], accS[1]); }
        { u32x2 o; o[0] = cvt_pk_bf16(aQ[0], aQ[1]); o[1] = cvt_pk_bf16(aQ[2], aQ[3]);
          *(u32x2*)(PROJ + (size_t)(b * 2048 + n * 64 + tt * 16 + l16) * PLD + C_AQ + h * 128 + vb * 32 + vt * 16 + quad * 4) = o; }
#pragma unroll
        for (int d = 0; d < 2; ++d)
#pragma unroll
            for (int r = 0; r < 4; ++r) STs[(vt * 16 + quad * 4 + r) * 136 + (dtb + d) * 16 + l16] = f2bf(accS[d][r]);
        asm volatile("s_waitcnt lgkmcnt(0)" ::: "memory"); __builtin_amdgcn_s_barrier(); asm volatile("" ::: "memory");
        cur = nxt;
    }
    float* sdp = p.out + O_SDP + (size_t)bh * 16384;
#pragma unroll
    for (int d = 0; d < 2; ++d) *(f32x4*)(sdp + (size_t)((dtb + d) * 16 + l16) * 128 + vb * 32 + vt * 16 + quad * 4) = accS[d];
}

static __device__ __forceinline__ void sample_delta_item(const Params& p, LAS unsigned char* lds, int it) {
    const int tid = threadIdx.x, b = it >> 2, h = it & 3;
    const bf16_t* PROJ = (const bf16_t*)(p.ws + OFF_PROJ); const float* betag = (const float*)(p.ws + OFF_BETAG); bf16_t* ACT = (bf16_t*)(p.ws + OFF_ACT);
    LAS float* qkv = (LAS float*)lds;
    LAS float* red = (LAS float*)(lds + 2048);
    LAS float* fin = (LAS float*)(lds + 2048 + 16384);
    LAS float* sc = (LAS float*)(lds + 2048 + 16384 + 1024);
    const size_t prow = (size_t)(NP + b) * PLD;
    __syncthreads();
    float yv = 0.f;
    if (tid < 384) { const int sec = tid >> 7, c = tid & 127, ch = sec * 512 + h * 128 + c;
        const float b0 = p.state_conv[(size_t)(b * 3 + 0) * 1536 + ch], b1 = p.state_conv[(size_t)(b * 3 + 1) * 1536 + ch], b2 = p.state_conv[(size_t)(b * 3 + 2) * 1536 + ch];
        const float xn = bf2f(PROJ[prow + ch]);
        float y = b0 * p.conv_w[ch] + b1 * p.conv_w[1536 + ch] + b2 * p.conv_w[3072 + ch] + xn * p.conv_w[4608 + ch];
        yv = siluf_(y);
        float* scs = p.out + O_SCS + (size_t)b * 4608;
        scs[ch] = b1; scs[1536 + ch] = b2; scs[3072 + ch] = xn;
    }
    {
        float ss = wave_sum(yv * yv);
        if ((tid & 63) == 0) sc[8 + (tid >> 6)] = ss;
    }
    __syncthreads();
    if (tid < 384) { const int sec = tid >> 7, c = tid & 127;
        float v = yv;
        if (sec == 0) v *= rsqrtf(sc[8] + sc[9] + EPS) * 0.08838834764831845f;
        else if (sec == 1) v *= rsqrtf(sc[10] + sc[11] + EPS);
        qkv[sec * 128 + c] = v; }
    __syncthreads();
    const int dvq = tid & 31, dkg = tid >> 5;
    const float* S0 = p.state_delta + (size_t)it * 16384;
    f32x4 s[8]; f32x4 pk = {0.f, 0.f, 0.f, 0.f}, pq = {0.f, 0.f, 0.f, 0.f};
#pragma unroll
    for (int j = 0; j < 8; ++j) { const int dk = dkg * 8 + j; s[j] = *(const f32x4*)(S0 + (size_t)dk * 128 + dvq * 4); pk += s[j] * qkv[128 + dk]; pq += s[j] * qkv[dk]; }
    *(LAS f32x4*)(red + dkg * 256 + dvq * 4) = pk; *(LAS f32x4*)(red + dkg * 256 + 128 + dvq * 4) = pq;
    {
        float qk = (tid < 128) ? qkv[tid] * qkv[128 + tid] : 0.f; qk = wave_sum(qk);
        if (tid < 128 && (tid & 63) == 0) sc[tid >> 6] = qk;
    }
    __syncthreads();
    const float beta = betag[(size_t)(NP + b) * 8 + h], a = __expf(betag[(size_t)(NP + b) * 8 + 4 + h]);
    if (tid < 128) { float sk = 0.f, sq = 0.f;
#pragma unroll
        for (int g = 0; g < 16; ++g) { sk += red[g * 256 + tid]; sq += red[g * 256 + 128 + tid]; }
        const float vn = beta * (qkv[256 + tid] - a * sk); const float o = a * sq + (sc[0] + sc[1]) * vn;
        fin[tid] = vn; fin[128 + tid] = o;
        const float oo = wave_sum(o * o); if ((tid & 63) == 0) sc[4 + (tid >> 6)] = oo; }
    __syncthreads();
    const f32x4 vn4 = *(const LAS f32x4*)(fin + dvq * 4);
    float* Sn = p.out + O_SDS + (size_t)it * 16384;
#pragma unroll
    for (int j = 0; j < 8; ++j) { const int dk = dkg * 8 + j; *(f32x4*)(Sn + (size_t)dk * 128 + dvq * 4) = s[j] * a + vn4 * qkv[128 + dk]; }
    if (tid < 128) { const float rstd = rsqrtf((sc[4] + sc[5]) * (1.f / 128.f) + EPS);
        const float gt = bf2f(PROJ[prow + C_AGATE + h * 128 + tid]);
        ACT[(size_t)(NP + b) * LDA + A_YA + h * 128 + tid] = f2bf(fin[128 + tid] * rstd * p.a_norm_g[tid] * siluf_(gt)); }
}

static __device__ __forceinline__ void sample_xattn_item(const Params& p, LAS unsigned char* lds, int it) {
    const int tid = threadIdx.x, lane = tid & 63, wave = tid >> 6, b = it >> 2, h = it & 3;
    const bf16_t* PROJ = (const bf16_t*)(p.ws + OFF_PROJ); bf16_t* ACT = (bf16_t*)(p.ws + OFF_ACT);
    LAS float* scr = (LAS float*)lds;
    LAS float* red = (LAS float*)(lds + 1024);
    const int half = lane >> 5, dl = lane & 31;
    const size_t prow = (size_t)(NP + b) * PLD;
    f32x4 q; { const bf16_t* qp = PROJ + prow + C_CQ + h * 128 + dl * 4; const u32x2 u = *(const u32x2*)qp; q = (f32x4){bflo(u[0]), bfhi(u[0]), bflo(u[1]), bfhi(u[1])}; }
    const float* Kp = p.cache_k + ((size_t)(b * 256) * 4 + h) * 128 + dl * 4; const float* Vp = p.cache_v + ((size_t)(b * 256) * 4 + h) * 128 + dl * 4;
    __syncthreads();
    f32x4 kv[16];
#pragma unroll
    for (int i = 0; i < 16; ++i) { const int m = wave * 32 + i * 2 + half; kv[i] = *(const f32x4*)(Kp + (size_t)m * 512); }
#pragma unroll
    for (int i = 0; i < 16; ++i) { float d = kv[i][0] * q[0] + kv[i][1] * q[1] + kv[i][2] * q[2] + kv[i][3] * q[3];
#pragma unroll
        for (int o = 16; o >= 1; o >>= 1) d += __shfl_xor(d, o);
        if (dl == 0) scr[wave * 32 + i * 2 + half] = d * 0.08838834764831845f; }
#pragma unroll
    for (int i = 0; i < 16; ++i) { const int m = wave * 32 + i * 2 + half; kv[i] = *(const f32x4*)(Vp + (size_t)m * 512); }
    __syncthreads();
    float mx = -3.0e38f;
#pragma unroll
    for (int i = 0; i < 4; ++i) mx = fmaxf(mx, scr[lane + 64 * i]);
#pragma unroll
    for (int o = 32; o >= 1; o >>= 1) mx = fmaxf(mx, __shfl_xor(mx, o));
    float sm = 0.f;
#pragma unroll
    for (int i = 0; i < 4; ++i) sm += __expf(scr[lane + 64 * i] - mx);
    sm = wave_sum(sm);
    const float inv = 1.f / sm;
    f32x4 o = {0.f, 0.f, 0.f, 0.f};
#pragma unroll
    for (int i = 0; i < 16; ++i) { const float pr = __expf(scr[wave * 32 + i * 2 + half] - mx) * inv; o += kv[i] * pr; }
    *(LAS f32x4*)(red + (wave * 2 + half) * 128 + dl * 4) = o;
    __syncthreads();
    if (tid < 128) { float s = 0.f;
#pragma unroll
        for (int g = 0; g < 16; ++g) s += red[g * 128 + tid];
        const float gt = bf2f(PROJ[prow + C_CGATE + h * 128 + tid]);
        ACT[(size_t)(NP + b) * LDA + A_YC + h * 128 + tid] = f2bf(s * siluf_(gt)); }
}

static __device__ __forceinline__ void sample_mlp_item(const Params& p, int it) {
    const int tid = threadIdx.x, lane = tid & 63, wave = tid >> 6, b = it * 8 + wave;
    const bf16_t* PROJ = (const bf16_t*)(p.ws + OFF_PROJ); bf16_t* ACT = (bf16_t*)(p.ws + OFF_ACT);
    const size_t prow = (size_t)(NP + b) * PLD; const int c0 = lane * 8;
    const u32x4 xv = *(const u32x4*)(PROJ + prow + C_BV + c0), xu = *(const u32x4*)(PROJ + prow + C_BU + c0), xg = *(const u32x4*)(PROJ + prow + C_BGATE + c0);
    float v[8], s1 = 0.f, s2 = 0.f;
#pragma unroll
    for (int e = 0; e < 4; ++e) { v[2 * e] = bflo(xv[e]); v[2 * e + 1] = bfhi(xv[e]); }
#pragma unroll
    for (int e = 0; e < 8; ++e) s1 += v[e];
    s1 = wave_sum(s1); const float mu = s1 * (1.f / 512.f);
#pragma unroll
    for (int e = 0; e < 8; ++e) { v[e] -= mu; s2 += v[e] * v[e]; }
    s2 = wave_sum(s2); const float rstd = rsqrtf(s2 * (1.f / 512.f) + EPS);
    const int g = c0 >> 7; const float w00 = p.w_spatial[(size_t)g * 16384], bs = p.b_spatial[g * 128];
    float* cvs = p.out + O_CVS + (size_t)b * 512 + c0;
    u32x4 o;
#pragma unroll
    for (int e = 0; e < 4; ++e) { float r[2];
#pragma unroll
        for (int z = 0; z < 2; ++z) { const int c = c0 + 2 * e + z; const float vn = v[2 * e + z] * rstd * p.ln_v_g[c] + p.ln_v_b[c]; cvs[2 * e + z] = vn;
            const float uu = z ? bfhi(xu[e]) : bflo(xu[e]), gg = z ? bfhi(xg[e]) : bflo(xg[e]); r[z] = uu * (w00 * vn + bs) * siluf_(gg); }
        o[e] = cvt_pk_bf16(r[0], r[1]); }
    *(u32x4*)(ACT + (size_t)(NP + b) * LDA + A_YB + c0) = o;
}

static __device__ __forceinline__ void mlp_item(const Params& p, LAS unsigned char* lds, int it) {
    const int tid = threadIdx.x, lane = tid & 63, wave = tid >> 6, l16 = lane & 15, quad = lane >> 4;
    const int row0 = (it >> 4) * 2048 + (it & 15) * 128;
    const bf16_t* PROJ = (const bf16_t*)(p.ws + OFF_PROJ); bf16_t* ACT = (bf16_t*)(p.ws + OFF_ACT);
    LAS bf16_t* vnT = (LAS bf16_t*)lds;
    LAS bf16_t* Wsm = (LAS bf16_t*)(lds + 34816);
    LAS float* st = (LAS float*)(lds + 69632);
    __syncthreads();
    { const int r = tid >> 2, part = tid & 3; const bf16_t* rp = PROJ + (size_t)(row0 + r) * PLD + C_BV + part * 128; float s1 = 0.f, s2 = 0.f;
#pragma unroll
      for (int i = 0; i < 16; ++i) { const u32x4 x = *(const u32x4*)(rp + i * 8);
#pragma unroll
          for (int e = 0; e < 4; ++e) { const float a = bflo(x[e]), c = bfhi(x[e]); s1 += a + c; s2 += a * a + c * c; } }
      s1 += __shfl_xor(s1, 1); s1 += __shfl_xor(s1, 2); s2 += __shfl_xor(s2, 1); s2 += __shfl_xor(s2, 2);
      const float mu = s1 * (1.f / 512.f); const float var = fmaxf(s2 * (1.f / 512.f) - mu * mu, 0.f);
      if (part == 0) { st[r * 2] = mu; st[r * 2 + 1] = rsqrtf(var + EPS); } }
    __syncthreads();
#pragma unroll 1
    for (int g = 0; g < 4; ++g) {
        { const int s = lane + 64 * (wave & 1), cq = (wave >> 1) * 32; const float mu = st[s * 2], rstd = st[s * 2 + 1];
          const bf16_t* rp = PROJ + (size_t)(row0 + s) * PLD + C_BV + g * 128 + cq;
#pragma unroll
          for (int i = 0; i < 4; ++i) { const u32x4 x = *(const u32x4*)(rp + i * 8);
#pragma unroll
              for (int e = 0; e < 4; ++e) { const int c = cq + i * 8 + 2 * e; const int gc = g * 128 + c;
                  vnT[c * 136 + s] = f2bf((bflo(x[e]) - mu) * rstd * p.ln_v_g[gc] + p.ln_v_b[gc]);
                  vnT[(c + 1) * 136 + s] = f2bf((bfhi(x[e]) - mu) * rstd * p.ln_v_g[gc + 1] + p.ln_v_b[gc + 1]); } }
          const int t = tid >> 2, sq = (tid & 3) * 32; const float* wp = p.w_spatial + ((size_t)g * 128 + t) * 128 + sq;
#pragma unroll
          for (int i = 0; i < 4; ++i) { const f32x4 w0 = *(const f32x4*)(wp + i * 8), w1 = *(const f32x4*)(wp + i * 8 + 4); const int s0 = sq + i * 8;
              f32x4 m0, m1;
#pragma unroll
              for (int e = 0; e < 4; ++e) { m0[e] = (s0 + e <= t) ? w0[e] : 0.f; m1[e] = (s0 + 4 + e <= t) ? w1[e] : 0.f; }
              *(LAS u32x4*)(Wsm + t * 136 + s0) = pack8(m0, m1); } }
        __syncthreads();
        f32x4 acc[8];
#pragma unroll
        for (int ct = 0; ct < 8; ++ct) acc[ct] = (f32x4){0.f, 0.f, 0.f, 0.f};
        const int nks = (wave >> 1) + 1;
        for (int ks = 0; ks < nks; ++ks) { const bf16x8 bw = lds8(lds, 34816 + ((wave * 16 + l16) * 136 + ks * 32 + quad * 8) * 2);
#pragma unroll
            for (int ct = 0; ct < 8; ++ct) acc[ct] = mfma16(lds8(lds, ((ct * 16 + l16) * 136 + ks * 32 + quad * 8) * 2), bw, acc[ct]); }
        const int t = wave * 16 + l16; const size_t prow = (size_t)(row0 + t) * PLD; const float bs = p.b_spatial[g * 128 + t];
#pragma unroll
        for (int ct = 0; ct < 8; ++ct) { const int col = g * 128 + ct * 16 + quad * 4;
            const u32x2 xu = *(const u32x2*)(PROJ + prow + C_BU + col), xg = *(const u32x2*)(PROJ + prow + C_BGATE + col);
            u32x2 o; o[0] = cvt_pk_bf16(bflo(xu[0]) * (acc[ct][0] + bs) * siluf_(bflo(xg[0])), bfhi(xu[0]) * (acc[ct][1] + bs) * siluf_(bfhi(xg[0])));
            o[1] = cvt_pk_bf16(bflo(xu[1]) * (acc[ct][2] + bs) * siluf_(bflo(xg[1])), bfhi(xu[1]) * (acc[ct][3] + bs) * siluf_(bfhi(xg[1])));
            *(u32x2*)(ACT + (size_t)(row0 + t) * LDA + A_YB + col) = o; }
        __syncthreads();
    }
}

static __device__ __forceinline__ void xattn_item(const Params& p, LAS unsigned char* lds, int it) {
    const int tid = threadIdx.x, lane = tid & 63, wave = tid >> 6, l16 = lane & 15, quad = lane >> 4;
    const int b = it >> 6, h = (it >> 4) & 3, qt = it & 15;
    const bf16_t* PROJ = (const bf16_t*)(p.ws + OFF_PROJ); bf16_t* ACT = (bf16_t*)(p.ws + OFF_ACT); const bf16_t* MKV = (const bf16_t*)(p.ws + OFF_MEMKV);
    LAS bf16_t* Ks = (LAS bf16_t*)lds;
    LAS bf16_t* Vt = (LAS bf16_t*)(lds + 69632);
    __syncthreads();
#pragma unroll
    for (int i = 0; i < 8; ++i) { const int idx = wave * 8 + i, m = (idx & 3) * 64 + lane, dc = (idx >> 2) * 8; const bf16_t* sp = MKV + (size_t)(b * 256 + m) * 1024 + h * 128 + dc;
        *(LAS u32x4*)(Ks + m * 136 + dc) = *(const u32x4*)sp;
        const u32x4 v = *(const u32x4*)(sp + 512);
#pragma unroll
        for (int e = 0; e < 4; ++e) { Vt[(dc + 2 * e) * 264 + m] = (bf16_t)(v[e] & 0xffffu); Vt[(dc + 2 * e + 1) * 264 + m] = (bf16_t)(v[e] >> 16); } }
    const int q0 = b * 2048 + qt * 128 + wave * 16; const size_t prow = (size_t)(q0 + l16) * PLD;
    bf16x8 qf[4];
#pragma unroll
    for (int ks = 0; ks < 4; ++ks) qf[ks] = ldg8(PROJ + prow + C_CQ + h * 128 + ks * 32 + quad * 8);
    __syncthreads();
    f32x4 s[16];
#pragma unroll
    for (int mt = 0; mt < 16; ++mt) { s[mt] = (f32x4){0.f, 0.f, 0.f, 0.f};
#pragma unroll
        for (int ks = 0; ks < 4; ++ks) s[mt] = mfma16(lds8(lds, ((mt * 16 + l16) * 136 + ks * 32 + quad * 8) * 2), qf[ks], s[mt]); }
    float mx = -3.0e38f;
#pragma unroll
    for (int mt = 0; mt < 16; ++mt)
#pragma unroll
        for (int r = 0; r < 4; ++r) mx = fmaxf(mx, s[mt][r]);
    mx = fmaxf(mx, __shfl_xor(mx, 16)); mx = fmaxf(mx, __shfl_xor(mx, 32));
    const float sc = 0.08838834764831845f * 1.4426950408889634f; float sm = 0.f;
#pragma unroll
    for (int mt = 0; mt < 16; ++mt)
#pragma unroll
        for (int r = 0; r < 4; ++r) { s[mt][r] = exp2f((s[mt][r] - mx) * sc); sm += s[mt][r]; }
    sm += __shfl_xor(sm, 16); sm += __shfl_xor(sm, 32);
    const float inv = 1.f / sm;
    bf16x8 pb[8];
#pragma unroll
    for (int ss = 0; ss < 8; ++ss) { const u32x4 pu = pack8(s[2 * ss], s[2 * ss + 1]); pb[ss] = __builtin_bit_cast(bf16x8, pu); }
#pragma unroll 1
    for (int dt = 0; dt < 8; ++dt) {
        f32x4 o = {0.f, 0.f, 0.f, 0.f};
#pragma unroll
        for (int ss = 0; ss < 8; ++ss) { const bf16x4 v0 = *(const LAS bf16x4*)(Vt + (dt * 16 + l16) * 264 + ss * 32 + quad * 4), v1 = *(const LAS bf16x4*)(Vt + (dt * 16 + l16) * 264 + ss * 32 + 16 + quad * 4);
            o = mfma16(__builtin_shufflevector(v0, v1, 0, 1, 2, 3, 4, 5, 6, 7), pb[ss], o); }
        const int col = h * 128 + dt * 16 + quad * 4; const u32x2 xg = *(const u32x2*)(PROJ + prow + C_CGATE + col);
        u32x2 w; w[0] = cvt_pk_bf16(o[0] * inv * siluf_(bflo(xg[0])), o[1] * inv * siluf_(bfhi(xg[0])));
        w[1] = cvt_pk_bf16(o[2] * inv * siluf_(bflo(xg[1])), o[3] * inv * siluf_(bfhi(xg[1])));
        *(u32x2*)(ACT + (size_t)(q0 + l16) * LDA + A_YC + col) = w;
        __builtin_amdgcn_sched_barrier(0); }
}

static __device__ __forceinline__ void phase_mixers(const Params& p, LAS unsigned char* lds) {
    const int wg = blockIdx.x, G = gridDim.x, tid = threadIdx.x;
    if (p.mask & 1) for (int u = wg; u < 128; u += G) scan_unit(p, lds, u);
    if (G > 128) { for (int it = wg - 128; it >= 0 && it < 128; it += G - 128) mlp_item(p, lds, it); }
    else { for (int it = wg; it < 128; it += G) mlp_item(p, lds, it); }
    unsigned* cnt = (unsigned*)(p.ws + OFF_CNT);
    LAS unsigned* slot = (LAS unsigned*)(lds + LDS_ITEM);
    for (;;) {
        __syncthreads();
        if (tid == 0) *slot = atomicAdd(cnt, 1u);
        __syncthreads();
        const int it = (int)*slot;
        if (it >= 1552) break;
        if (it < 512) xattn_item(p, lds, it);
        else if (it < 1024) sample_delta_item(p, lds, it - 512);
        else if (it < 1536) sample_xattn_item(p, lds, it - 1024);
        else sample_mlp_item(p, it - 1536);
    }
}

static __device__ __forceinline__ void phase_ya(const Params& p) {
    const int tid = threadIdx.x, lane = tid & 63, wave = tid >> 6;
    const bf16_t* PROJ = (const bf16_t*)(p.ws + OFF_PROJ); bf16_t* ACT = (bf16_t*)(p.ws + OFF_ACT);
    const int c0 = lane * 8, d0 = c0 & 127, nw = gridDim.x * 8;
    f32x4 ng0 = *(const f32x4*)(p.a_norm_g + d0), ng1 = *(const f32x4*)(p.a_norm_g + d0 + 4);
    for (int row0 = blockIdx.x * 8 + wave; row0 < NP; row0 += nw * 4) {
        u32x4 xo[4], xg[4];
#pragma unroll
        for (int k = 0; k < 4; ++k) { const int row = row0 + k * nw; if (row < NP) { const size_t prow = (size_t)row * PLD; xo[k] = *(const u32x4*)(PROJ + prow + C_AQ + c0); xg[k] = *(const u32x4*)(PROJ + prow + C_AGATE + c0); } }
#pragma unroll
        for (int k = 0; k < 4; ++k) { const int row = row0 + k * nw; if (row < NP) {
            float v[8], ss = 0.f;
#pragma unroll
            for (int e = 0; e < 4; ++e) { v[2 * e] = bflo(xo[k][e]); v[2 * e + 1] = bfhi(xo[k][e]); ss += v[2 * e] * v[2 * e] + v[2 * e + 1] * v[2 * e + 1]; }
            ss += __shfl_xor(ss, 1); ss += __shfl_xor(ss, 2); ss += __shfl_xor(ss, 4); ss += __shfl_xor(ss, 8);
            const float rstd = rsqrtf(ss * (1.f / 128.f) + EPS);
            u32x4 o;
#pragma unroll
            for (int e = 0; e < 4; ++e) { const float g0 = e < 2 ? ng0[2 * e] : ng1[2 * e - 4], g1 = e < 2 ? ng0[2 * e + 1] : ng1[2 * e - 3];
                o[e] = cvt_pk_bf16(v[2 * e] * rstd * g0 * siluf_(bflo(xg[k][e])), v[2 * e + 1] * rstd * g1 * siluf_(bfhi(xg[k][e]))); }
            *(u32x4*)(ACT + (size_t)row * LDA + A_YA + c0) = o; } }
    }
}

template <int NKS> __device__ __forceinline__ f32x4 small_gemm(const bf16_t* Wt, const bf16_t* A) {
    bf16x8 wv[NKS], av[NKS];
#pragma unroll
    for (int ks = 0; ks < NKS; ++ks) { wv[ks] = ldg8(Wt + ks * 32); av[ks] = ldg8(A + ks * 32); }
    f32x4 acc = {0.f, 0.f, 0.f, 0.f};
#pragma unroll
    for (int ks = 0; ks < NKS; ++ks) acc = mfma16(wv[ks], av[ks], acc);
    return acc;
}
static __device__ __forceinline__ void sample_g3(const Params& p, LAS unsigned char* lds) {
    const int tid = threadIdx.x, lane = tid & 63, wave = tid >> 6, l16 = lane & 15, quad = lane >> 4, c = blockIdx.x;
    const int ct = c >> 2, rt = 2 * (c & 3) + (wave >> 2), kp = wave & 3;
    const bf16_t* ACT = (const bf16_t*)(p.ws + OFF_ACT); const bf16_t* WG3 = (const bf16_t*)(p.ws + OFF_WG3); bf16_t* MERGED = (bf16_t*)(p.ws + OFF_MERGED);
    const int r = NP + rt * 16 + l16 + opaque_zero(), n0 = ct * 16;
    LAS f32x4* red = (LAS f32x4*)lds;
#pragma unroll
    for (int br = 0; br < 3; ++br) {
        const bf16_t* wrow = WG3 + ((size_t)br * 1024 + n0 + l16) * 1536 + quad * 8; const bf16_t* arow = ACT + (size_t)r * LDA + quad * 8;
        red[(wave * 6 + 2 * br) * 64 + lane] = small_gemm<8>(wrow + kp * 256, arow + kp * 256);
        red[(wave * 6 + 2 * br + 1) * 64 + lane] = small_gemm<4>(wrow + 1024 + kp * 128, arow + A_YA + br * 512 + kp * 128);
    }
    __syncthreads();
    if (kp == 0) {
        f32x4 m = {0.f, 0.f, 0.f, 0.f};
#pragma unroll
        for (int br = 0; br < 3; ++br) {
            f32x4 ag = {0.f, 0.f, 0.f, 0.f}, at = {0.f, 0.f, 0.f, 0.f};
#pragma unroll
            for (int k = 0; k < 4; ++k) { ag += red[((wave + k) * 6 + 2 * br) * 64 + lane]; at += red[((wave + k) * 6 + 2 * br + 1) * 64 + lane]; }
            const f32x4 bg = *(const f32x4*)(p.b_gate + br * 1024 + n0 + quad * 4);
#pragma unroll
            for (int e = 0; e < 4; ++e) m[e] += sigmoidf_(ag[e] + bg[e]) * at[e];
        }
        u32x2 o; o[0] = cvt_pk_bf16(m[0], m[1]); o[1] = cvt_pk_bf16(m[2], m[3]);
        *(u32x2*)(MERGED + (size_t)r * 1024 + n0 + quad * 4) = o;
    }
}
static __device__ __forceinline__ void sample_g4(const Params& p, LAS unsigned char* lds) {
    const int tid = threadIdx.x, lane = tid & 63, wave = tid >> 6, l16 = lane & 15, quad = lane >> 4, c = blockIdx.x;
    const int ct = c >> 2, rt = 2 * (c & 3) + (wave >> 2), kp = wave & 3;
    const bf16_t* WOUT = (const bf16_t*)(p.ws + OFF_WOUT); const bf16_t* MERGED = (const bf16_t*)(p.ws + OFF_MERGED); float* rowsq = (float*)(p.ws + OFF_ROWSQ);
    const int rs = rt * 16 + l16 + opaque_zero(), n0 = ct * 16;
    LAS f32x4* red = (LAS f32x4*)lds;
    red[wave * 64 + lane] = small_gemm<8>(WOUT + (size_t)(n0 + l16) * 1024 + quad * 8 + kp * 256, MERGED + (size_t)(NP + rs) * 1024 + quad * 8 + kp * 256);
    __syncthreads();
    if (kp == 0) {
        f32x4 a = red[wave * 64 + lane] + red[(wave + 1) * 64 + lane] + red[(wave + 2) * 64 + lane] + red[(wave + 3) * 64 + lane];
        const f32x4 v = *(const f32x4*)(p.x_sample + (size_t)rs * 1024 + n0 + quad * 4) + a;
        *(f32x4*)(p.out + O_YS + (size_t)rs * 1024 + n0 + quad * 4) = v;
        float ss = v[0] * v[0] + v[1] * v[1] + v[2] * v[2] + v[3] * v[3];
        ss += __shfl_xor(ss, 16); ss += __shfl_xor(ss, 32);
        if (quad == 0) unsafeAtomicAdd(rowsq + NP + rs, ss);
    }
}

static __device__ __forceinline__ void sample_g4_finish(const Params& p) {
    const int tid = threadIdx.x, lane = tid & 63, wave = tid >> 6, l16 = lane & 15, quad = lane >> 4, c = blockIdx.x;
    const int ct = c >> 2, rt = 2 * (c & 3) + (wave >> 2), kp = wave & 3;
    const float* rowsq = (const float*)(p.ws + OFF_ROWSQ);
    if (kp == 0) { const int rs = rt * 16 + l16, n0 = ct * 16; float* op = p.out + O_YS + (size_t)rs * 1024 + n0 + quad * 4;
        const float r = rsqrtf(__hip_atomic_load(rowsq + NP + rs, __ATOMIC_RELAXED, __HIP_MEMORY_SCOPE_AGENT) * (1.f / 1024.f) + EPS);
        *(f32x4*)op = *(const f32x4*)op * r * *(const f32x4*)(p.final_norm_g + n0 + quad * 4); }
}
static __device__ __forceinline__ void phase_final(const Params& p) {
    const float* rowsq = (const float*)(p.ws + OFF_ROWSQ);
    const int total4 = (NP + NS) * 256, stride = gridDim.x * 512;
    for (int base = blockIdx.x * 512 + threadIdx.x; base < total4; base += stride * 8) {
        f32x4 v[8]; float rs[8];
#pragma unroll
        for (int k = 0; k < 8; ++k) { const int i = base + k * stride; if (i < total4) { v[k] = *(const f32x4*)(p.out + (size_t)i * 4); rs[k] = rowsq[i >> 8]; } }
#pragma unroll
        for (int k = 0; k < 8; ++k) { const int i = base + k * stride; if (i < total4) { const f32x4 g = *(const f32x4*)(p.final_norm_g + (i & 255) * 4);
            *(f32x4*)(p.out + (size_t)i * 4) = v[k] * rsqrtf(rs[k] * (1.f / 1024.f) + EPS) * g; } }
    }
}

__global__ void __launch_bounds__(512, 2) fwd_megakernel(Params p) {
    extern __shared__ __attribute__((aligned(16))) unsigned char shm[];
    LAS unsigned char* lds = (LAS unsigned char*)shm;
    cg::grid_group grid = cg::this_grid();
    const int G = gridDim.x, c = blockIdx.x;
#define PH_BEGIN(k) if (p.ph_lo <= (k) && (k) < p.ph_hi) { if ((k) > p.ph_lo) grid_sync_all(grid);
#define PH_END }
#if !defined(ONLY_PH) || ONLY_PH == 0
    PH_BEGIN(0) phase_prep(p, lds); PH_END
#endif
#if !defined(ONLY_PH) || ONLY_PH == 1
    PH_BEGIN(1) { SchedG1 S{(const char*)(p.ws + OFF_ACT), (const char*)(p.ws + OFF_W1T), G, c};
                  EpiG1 E{(bf16_t*)(p.ws + OFF_PROJ), (bf16_t*)(p.ws + OFF_MEMKV), p.out};
                  pg8::gemm_phase(lds, LDA, 1024, S, E); } PH_END
#endif
#if !defined(ONLY_PH) || ONLY_PH == 2
    PH_BEGIN(2) phase_delta_pre(p, lds); PH_END
#endif
#if !defined(ONLY_PH) || ONLY_PH == 3
    PH_BEGIN(3) phase_mixers(p, lds); PH_END
#endif
#if !defined(ONLY_PH) || ONLY_PH == 4
    PH_BEGIN(4) phase_ya(p); PH_END
#endif
#if !defined(ONLY_PH) || ONLY_PH == 5
    PH_BEGIN(5) { SchedG3 S{(const char*)(p.ws + OFF_ACT), (const char*)(p.ws + OFF_WG3), G, c};
                  EpiG3 E{p.ws + OFF_PROJ + (size_t)c * SCR_PER_WG, (bf16_t*)(p.ws + OFF_MERGED), p.b_gate};
                  pg8::gemm_phase(lds, LDA, 1536, S, E);
                  sample_g3(p, lds); } PH_END
#endif
#if !defined(ONLY_PH) || ONLY_PH == 6
    PH_BEGIN(6) { sample_g4(p, lds); __syncthreads();
                  SchedG4 S{(const char*)(p.ws + OFF_MERGED), (const char*)(p.ws + OFF_WOUT), G, c};
                  EpiG4 E{p.x_prompt, p.out, (float*)(p.ws + OFF_ROWSQ), p.final_norm_g, &grid};
                  pg8::gemm_phase(lds, 1024, 1024, S, E);
                  sample_g4_finish(p); } PH_END
#endif
#if !defined(ONLY_PH) || ONLY_PH == 7
#endif
}

extern "C" void kernel_launch(void* const* d_in, const int* in_sizes, int n_in, void* d_out, int out_size, void* d_ws, size_t ws_size, hipStream_t stream) {
    static int grid_blocks = 0;
    if (grid_blocks == 0) {
        if (n_in != 25 || ws_size < WS_END) { fprintf(stderr, "kernel_launch: unexpected n_in %d / ws_size %zu (need %zu)\n", n_in, ws_size, (size_t)WS_END); grid_blocks = -1; return; }
        int dev = 0, cus = 0, per_cu = 0;
        hipGetDevice(&dev);
        hipDeviceGetAttribute(&cus, hipDeviceAttributeMultiprocessorCount, dev);
        if (hipFuncSetAttribute((const void*)fwd_megakernel, hipFuncAttributeMaxDynamicSharedMemorySize, LDS_BYTES) != hipSuccess) { fprintf(stderr, "kernel_launch: hipFuncSetAttribute failed\n"); }
        if (hipOccupancyMaxActiveBlocksPerMultiprocessor(&per_cu, fwd_megakernel, 512, LDS_BYTES) != hipSuccess || per_cu < 1) { fprintf(stderr, "kernel_launch: occupancy query gave %d\n", per_cu); per_cu = 1; }
        (void)hipGetLastError();
        grid_blocks = cus * per_cu; if (grid_blocks > 256) grid_blocks = 256;
        if (grid_blocks != 256) { fprintf(stderr, "kernel_launch: this build needs exactly 256 co-resident workgroups (one output tile each in the fused out-projection epilogue); got %d\n", grid_blocks); grid_blocks = -1; return; }
    }
    if (grid_blocks < 0) return;
    Params p{};
    const float** f = (const float**)&p;
    for (int i = 0; i < 25; ++i) f[i] = (const float*)d_in[i];
    p.out = (float*)d_out; p.ws = (unsigned char*)d_ws; p.ph_lo = 0; p.ph_hi = 8; p.mask = 0xff;
    void* args[] = {&p};
    hipError_t e = hipLaunchCooperativeKernel((const void*)fwd_megakernel, dim3(grid_blocks), dim3(512), args, LDS_BYTES, stream);
    if (e != hipSuccess) fprintf(stderr, "cooperative launch failed: %s (grid %d)\n", hipGetErrorString(e), grid_blocks);
}
```

```cpp
#include <hip/hip_runtime.h>
#include <hip/hip_cooperative_groups.h>
#include <cstdio>
namespace cg = cooperative_groups;

#define LAS __attribute__((address_space(3)))
#define GAS __attribute__((address_space(1)))
typedef unsigned short bf16_t;
typedef short bf16x8 __attribute__((ext_vector_type(8)));
typedef short bf16x4 __attribute__((ext_vector_type(4)));
typedef float f32x4 __attribute__((ext_vector_type(4)));
typedef unsigned u32x4 __attribute__((ext_vector_type(4)));
typedef unsigned u32x2 __attribute__((ext_vector_type(2)));

constexpr int NP = 16384, NS = 128, MROWS = 16640, HM0 = 16640, LDA = 2560, PLD = 4608;
constexpr int C_AQ = 0, C_AK = 512, C_AV = 1024, C_AGATE = 1536, C_BU = 2048, C_BV = 2560, C_BGATE = 3072, C_CQ = 3584, C_CGATE = 4096;
constexpr int A_H = 0, A_YA = 1024, A_YB = 1536, A_YC = 2048;
constexpr float EPS = 1e-6f;
constexpr size_t OFF_W1T = 0;
constexpr size_t OFF_WG3 = 11534336;
constexpr size_t OFF_WOUT = 20971520;
constexpr size_t OFF_ACT = 23068672;
constexpr size_t OFF_PROJ = 118751232;
constexpr size_t OFF_ATTN = 272105472;
constexpr size_t OFF_MEMKV = 280494080;
constexpr size_t OFF_BETAG = 284688384;
constexpr size_t OFF_ROWSQ = 285216768;
constexpr size_t OFF_GL = 285283328;
constexpr size_t OFF_CNT = 285287424;
constexpr size_t OFF_BAR = 285287680;
constexpr size_t WS_END = 285290240;
constexpr size_t SCR_PER_WG = 393216;
constexpr size_t OFF_MERGED = OFF_PROJ + 256 * SCR_PER_WG;
constexpr size_t DO_U = 0, DO_W = 16777216, DO_QD = 33554432, DO_KDT = 50331648;
constexpr size_t O_YS = 16777216, O_SDP = 16908288, O_SCP = 17432576, O_MKP = 17469440, O_MVP = 18518016, O_SDS = 19566592, O_SCS = 27955200, O_CVS = 28545024;
constexpr int LDS_BYTES = 143360;
constexpr int LDS_ITEM = 143344;

struct Params {
    const float *x_prompt, *x_sample, *cache_k, *cache_v, *state_delta, *state_conv, *mem_prompt, *norm_g, *w_in, *conv_w, *a_log, *dt_bias, *a_norm_g,
        *ln_v_g, *ln_v_b, *w_spatial, *b_spatial, *mem_norm_g, *w_mem_kv, *w_br_a, *w_br_b, *w_br_c, *b_gate, *w_out, *final_norm_g;
    float* out;
    unsigned char* ws;
    int ph_lo, ph_hi, mask, pad_;
};

typedef __bf16 bf16v2_t __attribute__((ext_vector_type(2)));
__device__ __forceinline__ unsigned cvt_pk_bf16(float lo, float hi) { bf16v2_t v; v[0] = (__bf16)lo; v[1] = (__bf16)hi; return __builtin_bit_cast(unsigned, v); }
__device__ __forceinline__ bf16_t f2bf(float f) { return (bf16_t)(cvt_pk_bf16(f, 0.f) & 0xffffu); }
__device__ __forceinline__ float bf2f(bf16_t b) { return __uint_as_float(((unsigned)b) << 16); }
__device__ __forceinline__ float bflo(unsigned u) { return __uint_as_float(u << 16); }
__device__ __forceinline__ float bfhi(unsigned u) { return __uint_as_float(u & 0xffff0000u); }
__device__ __forceinline__ float sigmoidf_(float x) { return __builtin_amdgcn_rcpf(1.f + __expf(-x)); }
__device__ __forceinline__ float siluf_(float x) { return x * __builtin_amdgcn_rcpf(1.f + __expf(-x)); }
__device__ __forceinline__ float wave_sum(float v) {
#pragma unroll
    for (int o = 32; o >= 1; o >>= 1) v += __shfl_xor(v, o);
    return v;
}
__device__ __forceinline__ int opaque_zero() { int z; asm volatile("v_mov_b32 %0, 0" : "=v"(z)); return z; }
__device__ __forceinline__ f32x4 mfma16(bf16x8 a, bf16x8 b, f32x4 c) { return __builtin_amdgcn_mfma_f32_16x16x32_bf16(a, b, c, 0, 0, 0); }
__device__ __forceinline__ bf16x8 ldg8(const bf16_t* p) { return *(const bf16x8*)p; }
__device__ __forceinline__ bf16x8 lds8(LAS unsigned char* l, int off) { return *(const LAS bf16x8*)(l + off); }
__device__ __forceinline__ u32x4 pack8(f32x4 a, f32x4 b) { u32x4 r; r[0] = cvt_pk_bf16(a[0], a[1]); r[1] = cvt_pk_bf16(a[2], a[3]); r[2] = cvt_pk_bf16(b[0], b[1]); r[3] = cvt_pk_bf16(b[2], b[3]); return r; }

__device__ __forceinline__ void grid_sync_all(cg::grid_group& grid) {
    asm volatile("s_waitcnt vmcnt(0)" ::: "memory");
    grid.sync();
    if (threadIdx.x < 64) { __builtin_amdgcn_fence(__ATOMIC_ACQUIRE, "agent"); asm volatile("s_waitcnt vmcnt(0)" ::: "memory"); }
    __syncthreads();
}

__device__ __forceinline__ void fast_sync(unsigned* bar, unsigned epoch) {
    asm volatile("s_waitcnt vmcnt(0)" ::: "memory");
    __syncthreads();
    if (threadIdx.x == 0) {
        __builtin_amdgcn_fence(__ATOMIC_RELEASE, "agent"); asm volatile("s_waitcnt vmcnt(0)" ::: "memory");
        const unsigned g = blockIdx.x & 7u, ng = (gridDim.x - g + 7u) / 8u, ngroups = gridDim.x < 8u ? gridDim.x : 8u;
        const unsigned old = __hip_atomic_fetch_add(bar + g * 64, 1u, __ATOMIC_RELAXED, __HIP_MEMORY_SCOPE_AGENT);
        if (old + 1u == epoch * ng) __hip_atomic_fetch_add(bar + 8 * 64, 1u, __ATOMIC_RELAXED, __HIP_MEMORY_SCOPE_AGENT);
        while (__hip_atomic_load(bar + 8 * 64, __ATOMIC_RELAXED, __HIP_MEMORY_SCOPE_AGENT) < epoch * ngroups) __builtin_amdgcn_s_sleep(1);
        __builtin_amdgcn_fence(__ATOMIC_ACQUIRE, "agent"); asm volatile("s_waitcnt vmcnt(0)" ::: "memory");
    }
    __syncthreads();
}

namespace pg8 {
constexpr int BM = 256, BK = 64, HALF = 128, HTB = HALF * BK * 2, STAGE_BYTES = 8 * HTB;
__device__ __forceinline__ int lds_byte(int r, int c) { const int st = (r >> 4) * 2 + (c >> 5), rr = r & 15, cc = c & 31, ob = rr * 64 + cc * 2; return st * 1024 + (ob ^ (((ob >> 9) & 1) << 5)); }
__device__ __forceinline__ void stage_rc(int b, int& R, int& C) { const int st = b / 1024, sb = b % 1024, swz = sb ^ (((sb >> 9) & 1) << 5); R = (st >> 1) * 16 + swz / 64; C = (st & 1) * 32 + (swz % 64) / 2; }
__device__ __forceinline__ int perm32(int rho) { const int n = rho >> 4, i = rho & 15; return 8 * (i >> 2) + 4 * n + (i & 3); }
struct Unit { int pm, pn, sub; };

template <class Epi, class Sched>
__device__ __forceinline__ void gemm_phase(LAS unsigned char* lds, const int lda, const int ldb, const Sched& S, const Epi& E) {
    const int tid = threadIdx.x, wid = __builtin_amdgcn_readfirstlane(tid >> 6), lane = tid & 63, wr = wid >> 2, wc = wid & 3, fr = lane & 15, fq = lane >> 4;
    unsigned voffA[2], voffB[2];
#pragma unroll
    for (int i = 0; i < 2; ++i) { int R, C; stage_rc(tid * 16 + i * 8192, R, C); const int Rb = (R & ~31) + perm32(R & 31);
        voffA[i] = (unsigned)(R * lda + C) * 2u; voffB[i] = (unsigned)(Rb * ldb + C) * 2u; }
    const size_t kstep = (size_t)(BK * 2);
    const size_t hstepA = (size_t)HALF * lda * 2, hstepB = (size_t)HALF * ldb * 2;
    const unsigned ldsw = (unsigned)wid * 1024u;
    const int aoff = lds_byte(wr * 64 + fr, fq * 8), boff = lds_byte(wc * 32 + fr, fq * 8);
#define PG8_SA(b, h) (((b) * 2 + (h)) * HTB)
#define PG8_SB(b, h) ((4 + (b) * 2 + (h)) * HTB)
#define PG8_STAGE(bufoff, gbase, voff) do { _Pragma("unroll") for (int _i = 0; _i < 2; ++_i) \
        __builtin_amdgcn_global_load_lds((const unsigned*)((const char*)(gbase) + (voff)[_i]), (LAS unsigned*)(lds + (bufoff) + ldsw + _i * 8192), 16, 0, 0); } while (0)
#define PG8_LDA(dst, b, h) do { _Pragma("unroll") for (int m = 0; m < 4; ++m) _Pragma("unroll") for (int k = 0; k < 2; ++k) dst[m][k] = *(const LAS bf16x8*)(lds + PG8_SA(b, h) + aoff + m * 2048 + k * 1024); } while (0)
#define PG8_LDB(dst, b, h) do { _Pragma("unroll") for (int n = 0; n < 2; ++n) _Pragma("unroll") for (int k = 0; k < 2; ++k) dst[n][k] = *(const LAS bf16x8*)(lds + PG8_SB(b, h) + boff + n * 2048 + k * 1024); } while (0)
#define PG8_MMA(ai, bj, At, Bt) do { __builtin_amdgcn_s_setprio(1); _Pragma("unroll") for (int m = 0; m < 4; ++m) _Pragma("unroll") for (int n = 0; n < 2; ++n) _Pragma("unroll") for (int k = 0; k < 2; ++k) \
        acc[ai][bj][m][n] = __builtin_amdgcn_mfma_f32_16x16x32_bf16(Bt[n][k], At[m][k], acc[ai][bj][m][n], 0, 0, 0); __builtin_amdgcn_s_setprio(0); } while (0)
#define PG8_WAIT_V(n) asm volatile("s_waitcnt vmcnt(" #n ")" ::: "memory")
#define PG8_WAIT_L(n) asm volatile("s_waitcnt lgkmcnt(" #n ")" ::: "memory")
#define PG8_BAR __builtin_amdgcn_s_barrier()
#define PG8_SCHED __builtin_amdgcn_sched_barrier(0)
    Unit cur, nxt; int ui = 0;
    if (!S.next(0, cur)) return;
    f32x4 acc[2][2][4][2];
    bf16x8 At[4][2], B0[2][2], B1[2][2];
    const char* cA; const char* cB; int nt;
    S.ptrs(cur, cA, cB, nt);
    PG8_STAGE(PG8_SB(0, 0), cB, voffB); PG8_STAGE(PG8_SA(0, 0), cA, voffA); PG8_STAGE(PG8_SB(0, 1), cB + hstepB, voffB); PG8_STAGE(PG8_SA(0, 1), cA + hstepA, voffA);
    if (wr == 1) PG8_BAR;
    PG8_WAIT_V(4); PG8_BAR;
    PG8_STAGE(PG8_SB(1, 0), cB + kstep, voffB); PG8_STAGE(PG8_SA(1, 0), cA + kstep, voffA); PG8_STAGE(PG8_SB(1, 1), cB + hstepB + kstep, voffB);
    PG8_WAIT_V(6); PG8_BAR;
    PG8_SCHED;
#pragma unroll
    for (int a = 0; a < 2; ++a)
#pragma unroll
        for (int b = 0; b < 2; ++b)
#pragma unroll
            for (int m = 0; m < 4; ++m)
#pragma unroll
                for (int n = 0; n < 2; ++n) acc[a][b][m][n] = (f32x4){0.f, 0.f, 0.f, 0.f};
    for (;;) {
        const bool has_next = S.next(ui + 1, nxt);
        const char* nA = cA; const char* nB = cB; int nnt = nt;
        if (has_next) S.ptrs(nxt, nA, nB, nnt);
        for (int t = 0; t < nt; t += 2) {
            const bool last = (t == nt - 2);
            const char* a1 = cA + (size_t)(t + 1) * kstep;
            const char* a2 = last ? nA : cA + (size_t)(t + 2) * kstep; const char* b2 = last ? nB : cB + (size_t)(t + 2) * kstep;
            const char* a3 = a2 + kstep; const char* b3 = b2 + kstep;
            PG8_LDB(B0, 0, 0); PG8_SCHED; PG8_LDA(At, 0, 0); PG8_STAGE(PG8_SA(1, 1), a1 + hstepA, voffA);
            PG8_WAIT_L(8); PG8_BAR; PG8_WAIT_L(0); PG8_MMA(0, 0, At, B0); PG8_BAR; PG8_SCHED;
            PG8_LDB(B1, 0, 1); PG8_STAGE(PG8_SB(0, 0), b2, voffB);
            PG8_BAR; PG8_WAIT_L(0); PG8_MMA(0, 1, At, B1); PG8_BAR;
            PG8_LDA(At, 0, 1); PG8_STAGE(PG8_SA(0, 0), a2, voffA);
            PG8_BAR; PG8_WAIT_L(0); PG8_MMA(1, 0, At, B0); PG8_BAR; PG8_SCHED;
            PG8_STAGE(PG8_SB(0, 1), b2 + hstepB, voffB);
            PG8_WAIT_V(6); PG8_BAR; PG8_MMA(1, 1, At, B1); PG8_BAR;
            PG8_LDB(B0, 1, 0); PG8_SCHED; PG8_LDA(At, 1, 0); PG8_STAGE(PG8_SA(0, 1), a2 + hstepA, voffA);
            PG8_WAIT_L(8); PG8_BAR; PG8_WAIT_L(0); PG8_MMA(0, 0, At, B0); PG8_BAR; PG8_SCHED;
            PG8_LDB(B1, 1, 1); PG8_STAGE(PG8_SB(1, 0), b3, voffB);
            PG8_BAR; PG8_WAIT_L(0); PG8_MMA(0, 1, At, B1); PG8_BAR;
            PG8_LDA(At, 1, 1); PG8_STAGE(PG8_SA(1, 0), a3, voffA);
            PG8_BAR; PG8_WAIT_L(0); PG8_MMA(1, 0, At, B0); PG8_BAR; PG8_SCHED;
            PG8_STAGE(PG8_SB(1, 1), b3 + hstepB, voffB);
            PG8_WAIT_V(6); PG8_BAR; PG8_MMA(1, 1, At, B1); PG8_BAR;
        }
        __builtin_amdgcn_sched_barrier(0);
        E(acc, cur, wr, wc, fr, fq);
        __builtin_amdgcn_sched_barrier(0);
        if (!has_next) break;
        const float kf = S.keep(cur) ? 1.f : 0.f;
#pragma unroll
        for (int a = 0; a < 2; ++a)
#pragma unroll
            for (int b = 0; b < 2; ++b)
#pragma unroll
                for (int m = 0; m < 4; ++m)
#pragma unroll
                    for (int n = 0; n < 2; ++n) { if constexpr (Sched::HAS_KEEP) acc[a][b][m][n] *= kf; else acc[a][b][m][n] = (f32x4){0.f, 0.f, 0.f, 0.f}; }
        cur = nxt; cA = nA; cB = nB; nt = nnt; ++ui;
    }
    PG8_WAIT_V(0);
    if (wr == 0) PG8_BAR;
    PG8_BAR;
    if constexpr (Epi::HAS_POST) E.post(acc, cur, wr, wc, fr, fq);
#undef PG8_SA
#undef PG8_SB
#undef PG8_STAGE
#undef PG8_LDA
#undef PG8_LDB
#undef PG8_MMA
#undef PG8_WAIT_V
#undef PG8_WAIT_L
#undef PG8_BAR
#undef PG8_SCHED
}
}

struct SchedG1 {
    const char* A; const char* B; int G, c;
    __device__ __forceinline__ bool next(int i, pg8::Unit& u) const {
        const int L = i * G + c; if (L >= 1202) return false;
        if (L < 1170) {
            const int nM = 65, nN = 18, nwg = 1170;
            int wgid = L; { const int q = nwg / 8, r = nwg % 8, xcd = wgid % 8, off = wgid / 8; wgid = (xcd < r ? xcd * (q + 1) : r * (q + 1) + (xcd - r) * q) + off; }
            const int nig = 8 * nN, gid = wgid / nig, fm = gid * 8, gsz = (nM - fm) < 8 ? (nM - fm) : 8;
            u.pm = fm + ((wgid % nig) % gsz); u.pn = (wgid % nig) / gsz;
        } else { const int l2 = L - 1170; u.pm = 65 + (l2 >> 2); u.pn = 18 + (l2 & 3); }
        u.sub = 0; return true;
    }
    __device__ __forceinline__ void ptrs(const pg8::Unit& u, const char*& a, const char*& b, int& nt) const {
        a = A + (size_t)u.pm * 256 * LDA * 2; b = B + (size_t)u.pn * 256 * 1024 * 2; nt = 16;
    }
    static constexpr bool HAS_KEEP = false;
    __device__ __forceinline__ bool keep(const pg8::Unit&) const { return false; }
};
struct EpiG1 {
    static constexpr bool HAS_POST = false;
    bf16_t* proj; bf16_t* memkv; float* out;
    __device__ __forceinline__ void operator()(f32x4 (&acc)[2][2][4][2], const pg8::Unit& u, int wr, int wc, int fr, int fq) const {
        const int row0 = u.pm * 256 + wr * 64 + fr, col0 = u.pn * 256 + wc * 32 + 8 * fq;
        if (u.pn < 18) {
#pragma unroll
            for (int ai = 0; ai < 2; ++ai)
#pragma unroll
                for (int m = 0; m < 4; ++m) { bf16_t* rp = proj + (size_t)(row0 + ai * 128 + m * 16) * PLD + col0;
#pragma unroll
                    for (int bj = 0; bj < 2; ++bj) *(u32x4*)(rp + bj * 128) = pack8(acc[ai][bj][m][0], acc[ai][bj][m][1]); }
        } else {
            const int rr0 = row0 - HM0, cc0 = col0 - 4608;
#pragma unroll
            for (int ai = 0; ai < 2; ++ai)
#pragma unroll
                for (int m = 0; m < 4; ++m) { const int rr = rr0 + ai * 128 + m * 16;
#pragma unroll
                    for (int bj = 0; bj < 2; ++bj) { const int cc = cc0 + bj * 128;
                        *(u32x4*)(memkv + (size_t)rr * 1024 + cc) = pack8(acc[ai][bj][m][0], acc[ai][bj][m][1]);
                        float* op = out + (cc < 512 ? O_MKP + (size_t)rr * 512 + cc : O_MVP + (size_t)rr * 512 + (cc - 512));
                        *(f32x4*)op = acc[ai][bj][m][0]; *(f32x4*)(op + 4) = acc[ai][bj][m][1]; } }
        }
    }
};

struct SchedG3 {
    const char* A; const char* B; int G, c;
    __device__ __forceinline__ bool next(int i, pg8::Unit& u) const {
        const int r = i / 6, T = r * G + c; if (T >= 256) return false;
        const int xcd = T & 7, idx = T >> 3; u.pm = xcd * 8 + (idx >> 2); u.pn = idx & 3; u.sub = i - r * 6; return true;
    }
    __device__ __forceinline__ void ptrs(const pg8::Unit& u, const char*& a, const char*& b, int& nt) const {
        const int br = u.sub >= 3 ? u.sub - 3 : u.sub;
        const char* a0 = A + (size_t)u.pm * 256 * LDA * 2; const char* b0 = B + ((size_t)br * 1024 + (size_t)u.pn * 256) * 1536 * 2;
        if (u.sub >= 3) { a = a0 + (A_YA + br * 512) * 2; b = b0 + 1024 * 2; nt = 8; } else { a = a0; b = b0; nt = 16; }
    }
    static constexpr bool HAS_KEEP = false;
    __device__ __forceinline__ bool keep(const pg8::Unit&) const { return false; }
};
__device__ __forceinline__ void unpack8(const u32x4 g, f32x4& g0, f32x4& g1) { g0 = (f32x4){bflo(g[0]), bfhi(g[0]), bflo(g[1]), bfhi(g[1])}; g1 = (f32x4){bflo(g[2]), bfhi(g[2]), bflo(g[3]), bfhi(g[3])}; }
struct EpiG3 {
    static constexpr bool HAS_POST = false;
    unsigned char* scr; bf16_t* merged; const float* b_gate;
    __device__ __forceinline__ void operator()(f32x4 (&acc)[2][2][4][2], const pg8::Unit& u, int wr, int wc, int fr, int fq) const {
        const int tid = threadIdx.x + opaque_zero();
        const int row0 = u.pm * 256 + wr * 64 + fr, col0 = u.pn * 256 + wc * 32 + 8 * fq + opaque_zero();
        const bool gate = u.sub < 3; const int br = gate ? u.sub : u.sub - 3;
        GAS u32x4* s0 = (GAS u32x4*)scr + tid * 4;
        const int boff = br * 8192;
        const float* bp = b_gate + br * 1024 + col0;
        bf16_t* mp = merged + (size_t)row0 * 1024 + col0;
#pragma unroll
        for (int ai = 0; ai < 2; ++ai)
#pragma unroll
            for (int bj = 0; bj < 2; ++bj) {
                if (gate) {
                    const f32x4 b0 = *(const f32x4*)(bp + bj * 128), b1 = *(const f32x4*)(bp + bj * 128 + 4);
#pragma unroll
                    for (int m = 0; m < 4; ++m) { f32x4 g0, g1;
#pragma unroll
                        for (int e = 0; e < 4; ++e) { g0[e] = sigmoidf_(acc[ai][bj][m][0][e] + b0[e]); g1[e] = sigmoidf_(acc[ai][bj][m][1][e] + b1[e]); }
                        s0[boff + m] = pack8(g0, g1); }
                } else {
                    u32x4 gn[4], gm[4];
#pragma unroll
                    for (int m = 0; m < 4; ++m) { gn[m] = s0[boff + m]; gm[m] = s0[m]; }
#pragma unroll
                    for (int m = 0; m < 4; ++m) { f32x4 n0, n1, p0, p1; unpack8(gn[m], n0, n1); unpack8(gm[m], p0, p1);
                        f32x4 r0 = acc[ai][bj][m][0] * n0, r1 = acc[ai][bj][m][1] * n1;
                        if (br > 0) { r0 += p0; r1 += p1; }
                        const u32x4 pk = pack8(r0, r1);
                        if (br < 2) s0[m] = pk; else *(u32x4*)(mp + (size_t)(ai * 128 + m * 16) * 1024 + bj * 128) = pk; }
                }
                s0 += 2048; asm volatile("" : "+v"(s0)); __builtin_amdgcn_sched_barrier(0); }
    }
};

struct SchedG4 {
    const char* A; const char* B; int G, c;
    __device__ __forceinline__ bool next(int i, pg8::Unit& u) const {
        const int T = i * G + c; if (T >= 256) return false;
        const int xcd = T & 7, idx = T >> 3; u.pm = xcd * 8 + (idx >> 2); u.pn = idx & 3; u.sub = 0; return true;
    }
    __device__ __forceinline__ void ptrs(const pg8::Unit& u, const char*& a, const char*& b, int& nt) const {
        a = A + (size_t)u.pm * 256 * 1024 * 2; b = B + (size_t)u.pn * 256 * 1024 * 2; nt = 16;
    }
    static constexpr bool HAS_KEEP = false;
    __device__ __forceinline__ bool keep(const pg8::Unit&) const { return false; }
};
struct EpiG4 {
    static constexpr bool HAS_POST = true;
    const float* x; float* out; float* rowsq; const float* fg; unsigned* bar; unsigned epoch;
    __device__ __forceinline__ void operator()(f32x4 (&acc)[2][2][4][2], const pg8::Unit& u, int wr, int wc, int fr, int fq) const {
        const int row0 = u.pm * 256 + wr * 64 + fr + opaque_zero(), col0 = u.pn * 256 + wc * 32 + 8 * fq;
        const GAS float* xp = (const GAS float*)x + (size_t)row0 * 1024 + col0; float* rq = rowsq + row0;
#pragma unroll
        for (int ai = 0; ai < 2; ++ai) {
#pragma unroll
            for (int m = 0; m < 4; ++m) { float ss = 0.f;
#pragma unroll
                for (int bj = 0; bj < 2; ++bj) {
                    acc[ai][bj][m][0] += *(const GAS f32x4*)(xp + bj * 128); acc[ai][bj][m][1] += *(const GAS f32x4*)(xp + bj * 128 + 4);
#pragma unroll
                    for (int e = 0; e < 4; ++e) ss += acc[ai][bj][m][0][e] * acc[ai][bj][m][0][e] + acc[ai][bj][m][1][e] * acc[ai][bj][m][1][e]; }
                ss += __shfl_xor(ss, 16); ss += __shfl_xor(ss, 32);
                if (fq == 0) unsafeAtomicAdd(rq, ss);
                xp += 16 * 1024; rq += 16;
                if (m & 1) asm volatile("" : "+v"(xp), "+v"(rq)); }
            xp += 64 * 1024; rq += 64; }
    }
    __device__ __forceinline__ void post(f32x4 (&acc)[2][2][4][2], const pg8::Unit& u, int wr, int wc, int fr, int fq) const {
        fast_sync(bar, epoch);
        const int row0 = u.pm * 256 + wr * 64 + fr + opaque_zero(), col0 = u.pn * 256 + wc * 32 + 8 * fq;
        GAS float* op = (GAS float*)out + (size_t)row0 * 1024 + col0; const float* rq = rowsq + row0;
        f32x4 g[2][2];
#pragma unroll
        for (int bj = 0; bj < 2; ++bj) { g[bj][0] = *(const f32x4*)(fg + col0 + bj * 128); g[bj][1] = *(const f32x4*)(fg + col0 + bj * 128 + 4); }
#pragma unroll
        for (int ai = 0; ai < 2; ++ai) {
#pragma unroll
            for (int m = 0; m < 4; ++m) {
                const float rs = rsqrtf(__hip_atomic_load(rq, __ATOMIC_RELAXED, __HIP_MEMORY_SCOPE_AGENT) * (1.f / 1024.f) + EPS);
#pragma unroll
                for (int bj = 0; bj < 2; ++bj) { *(GAS f32x4*)(op + bj * 128) = acc[ai][bj][m][0] * rs * g[bj][0]; *(GAS f32x4*)(op + bj * 128 + 4) = acc[ai][bj][m][1] * rs * g[bj][1]; }
                op += 16 * 1024; rq += 16;
                if (m & 1) asm volatile("" : "+v"(op), "+v"(rq)); }
            op += 64 * 1024; rq += 64; }
    }
};

__device__ __forceinline__ void transpose_tile(const Params& p, LAS unsigned char* lds, int t) {
    const float* src; int sld, col0, ntn; bf16_t* dst; int dld;
    bf16_t* W1T = (bf16_t*)(p.ws + OFF_W1T); bf16_t* WG3 = (bf16_t*)(p.ws + OFF_WG3); bf16_t* WOUT = (bf16_t*)(p.ws + OFF_WOUT);
    if (t < 384) { src = p.w_in; sld = 7688; col0 = 0; ntn = 24; dst = W1T; dld = 1024; }
    else if (t < 1152) { t -= 384; src = p.w_in; sld = 7688; col0 = 1544; ntn = 48; dst = W1T + (size_t)1536 * 1024; dld = 1024; }
    else if (t < 1408) { t -= 1152; src = p.w_mem_kv; sld = 1024; col0 = 0; ntn = 16; dst = W1T + (size_t)4608 * 1024; dld = 1024; }
    else if (t < 2176) { t -= 1408; const int i = t >> 8; t &= 255; src = p.w_in; sld = 7688; col0 = 4616 + i * 1024; ntn = 16; dst = WG3 + (size_t)i * 1024 * 1536; dld = 1536; }
    else if (t < 2304) { t -= 2176; src = p.w_br_a; sld = 1024; col0 = 0; ntn = 16; dst = WG3 + 1024; dld = 1536; }
    else if (t < 2432) { t -= 2304; src = p.w_br_b; sld = 1024; col0 = 0; ntn = 16; dst = WG3 + (size_t)1 * 1024 * 1536 + 1024; dld = 1536; }
    else if (t < 2560) { t -= 2432; src = p.w_br_c; sld = 1024; col0 = 0; ntn = 16; dst = WG3 + (size_t)2 * 1024 * 1536 + 1024; dld = 1536; }
    else { t -= 2560; src = p.w_out; sld = 1024; col0 = 0; ntn = 16; dst = WOUT; dld = 1024; }
    const int k0 = (t / ntn) * 64, n0 = (t % ntn) * 64, tid = threadIdx.x;
    LAS float* tile = (LAS float*)lds;
    __syncthreads();
#pragma unroll
    for (int ps = 0; ps < 2; ++ps) { const int r = (tid >> 4) + ps * 32, c4 = (tid & 15) * 4;
        const f32x4 v = *(const f32x4*)(src + (size_t)(k0 + r) * sld + col0 + n0 + c4);
        tile[r * 65 + c4] = v[0]; tile[r * 65 + c4 + 1] = v[1]; tile[r * 65 + c4 + 2] = v[2]; tile[r * 65 + c4 + 3] = v[3]; }
    __syncthreads();
    const int n = tid >> 3, kc = (tid & 7) * 8;
    u32x4 o;
#pragma unroll
    for (int j = 0; j < 4; ++j) o[j] = cvt_pk_bf16(tile[(kc + 2 * j) * 65 + n], tile[(kc + 2 * j + 1) * 65 + n]);
    *(u32x4*)(dst + (size_t)(n0 + n) * dld + k0 + kc) = o;
}

static __device__ __forceinline__ void phase_prep(const Params& p, LAS unsigned char* lds) {
    const int tid = threadIdx.x, wg = blockIdx.x, G = gridDim.x, lane = tid & 63, wave = tid >> 6;
    float* rowsq = (float*)(p.ws + OFF_ROWSQ); unsigned* cnt = (unsigned*)(p.ws + OFF_CNT);
    for (int i = wg * 512 + tid; i < MROWS + 64; i += G * 512) { if (i < MROWS) rowsq[i] = 0.f; else cnt[i - MROWS] = 0u; }
    for (int t = wg; t < 2816; t += G) transpose_tile(p, lds, t);
    __syncthreads();
    LAS float* wb = (LAS float*)lds;
    for (int idx = tid; idx < 8192; idx += 512) { const int k = idx >> 3, j = idx & 7; wb[j * 1024 + k] = p.w_in[(size_t)k * 7688 + 1536 + j]; }
    __syncthreads();
    bf16_t* ACT = (bf16_t*)(p.ws + OFF_ACT); float* betag = (float*)(p.ws + OFF_BETAG);
    for (int row = wg * 8 + wave; row < 18560; row += G * 8) {
        const float* src; const float* gn; size_t drow;
        if (row < NP) { src = p.x_prompt + (size_t)row * 1024; gn = p.norm_g; drow = row; }
        else if (row < NP + NS) { src = p.x_sample + (size_t)(row - NP) * 1024; gn = p.norm_g; drow = row; }
        else { src = p.mem_prompt + (size_t)(row - NP - NS) * 1024; gn = p.mem_norm_g; drow = HM0 + (row - NP - NS); }
        f32x4 v[4]; float ss = 0.f;
#pragma unroll
        for (int q = 0; q < 4; ++q) { v[q] = *(const f32x4*)(src + q * 256 + lane * 4); ss += v[q][0] * v[q][0] + v[q][1] * v[q][1] + v[q][2] * v[q][2] + v[q][3] * v[q][3]; }
        ss = wave_sum(ss);
        const float rstd = rsqrtf(ss * (1.f / 1024.f) + EPS);
#pragma unroll
        for (int q = 0; q < 4; ++q) { const f32x4 g = *(const f32x4*)(gn + q * 256 + lane * 4); v[q] = v[q] * rstd * g;
            u32x2 o; o[0] = cvt_pk_bf16(v[q][0], v[q][1]); o[1] = cvt_pk_bf16(v[q][2], v[q][3]);
            *(u32x2*)(ACT + drow * LDA + q * 256 + lane * 4) = o; }
        if (row < NP + NS) {
            float d[8];
#pragma unroll
            for (int j = 0; j < 8; ++j) { float a = 0.f;
#pragma unroll
                for (int q = 0; q < 4; ++q) { const f32x4 w = *(const LAS f32x4*)(wb + j * 1024 + q * 256 + lane * 4); a += v[q][0] * w[0] + v[q][1] * w[1] + v[q][2] * w[2] + v[q][3] * w[3]; }
                d[j] = wave_sum(a); }
            float dl = d[0];
#pragma unroll
            for (int j = 1; j < 8; ++j) dl = (lane == j) ? d[j] : dl;
            if (lane < 4) betag[(size_t)row * 8 + lane] = sigmoidf_(dl);
            else if (lane < 8) { const int h = lane - 4; const float xx = dl + p.dt_bias[h]; const float sp = xx > 20.f ? xx : log1pf(expf(xx));
                betag[(size_t)row * 8 + lane] = -expf(p.a_log[h]) * sp; }
        }
    }
}

static __device__ __forceinline__ void delta_chunk_item(const Params& p, LAS unsigned char* lds, int ci) {
    const int tid = threadIdx.x, lane = tid & 63, wave = tid >> 6, l16 = lane & 15, quad = lane >> 4;
    const int bh = ci >> 5, n = ci & 31, b = bh >> 2, h = bh & 3;
    const bf16_t* PROJ = (const bf16_t*)(p.ws + OFF_PROJ); const float* betag = (const float*)(p.ws + OFF_BETAG);
    bf16_t* U = (bf16_t*)((unsigned char*)p.out + DO_U) + (size_t)ci * 8192; bf16_t* W = (bf16_t*)((unsigned char*)p.out + DO_W) + (size_t)ci * 8192;
    bf16_t* QD = (bf16_t*)((unsigned char*)p.out + DO_QD) + (size_t)ci * 8192; bf16_t* KDT = (bf16_t*)((unsigned char*)p.out + DO_KDT) + (size_t)ci * 8192;
    bf16_t* ATT = (bf16_t*)(p.ws + OFF_ATTN) + (size_t)ci * 4096; float* GL = (float*)(p.ws + OFF_GL);
    LAS bf16_t* Kb = (LAS bf16_t*)lds; LAS bf16_t* Qb = (LAS bf16_t*)(lds + 17408);
    LAS float* RHS = (LAS float*)(lds + 34816);
    LAS float* Lm = (LAS float*)(lds + 100352);
    LAS float* gcs = (LAS float*)(lds + 116736); LAS float* bts = gcs + 64;
    const int trow0 = b * 2048 + n * 64;
    __syncthreads();
    if (wave == 0) {
        float g = betag[(size_t)(trow0 + lane) * 8 + 4 + h];
#pragma unroll
        for (int o = 1; o < 64; o <<= 1) { const float t = __shfl_up(g, o); if (lane >= o) g += t; }
        gcs[lane] = g; bts[lane] = betag[(size_t)(trow0 + lane) * 8 + h];
        if (lane == 63) GL[ci] = __expf(g);
    }
    __syncthreads();
    {
        const int t = tid >> 3, cc = (tid & 7) * 16;
        const float gct = gcs[t], bet = bts[t], eg = __expf(gct);
#pragma unroll 1
        for (int sec = 0; sec < 3; ++sec) {
            const int col = sec * 512 + h * 128 + cc;
            float y[16];
#pragma unroll
            for (int e = 0; e < 16; ++e) y[e] = 0.f;
#pragma unroll
            for (int j = 0; j < 4; ++j) { const int tl = n * 64 + t - 3 + j;
                if (tl >= 0) { const bf16_t* rp = PROJ + (size_t)(b * 2048 + tl) * PLD + col; const u32x4 x0 = *(const u32x4*)rp, x1 = *(const u32x4*)(rp + 8);
                    const float* wp = p.conv_w + j * 1536 + col;
#pragma unroll
                    for (int e = 0; e < 4; ++e) { const f32x4 w = *(const f32x4*)(wp + e * 4); const unsigned ua = (e < 2 ? x0[2 * e] : x1[2 * e - 4]), ub = (e < 2 ? x0[2 * e + 1] : x1[2 * e - 3]);
                        y[e * 4] += bflo(ua) * w[0]; y[e * 4 + 1] += bfhi(ua) * w[1]; y[e * 4 + 2] += bflo(ub) * w[2]; y[e * 4 + 3] += bfhi(ub) * w[3]; } } }
            float ss = 0.f;
#pragma unroll
            for (int e = 0; e < 16; ++e) { y[e] = siluf_(y[e]); ss += y[e] * y[e]; }
            if (sec < 2) { ss += __shfl_xor(ss, 1); ss += __shfl_xor(ss, 2); ss += __shfl_xor(ss, 4);
                const float sc = rsqrtf(ss + EPS) * (sec == 0 ? 0.08838834764831845f : 1.f);
#pragma unroll
                for (int e = 0; e < 16; ++e) y[e] *= sc; }
            if (sec == 0) {
                u32x4 o0, o1, d0, d1;
#pragma unroll
                for (int e = 0; e < 4; ++e) { o0[e] = cvt_pk_bf16(y[2 * e], y[2 * e + 1]); o1[e] = cvt_pk_bf16(y[8 + 2 * e], y[9 + 2 * e]);
                    d0[e] = cvt_pk_bf16(y[2 * e] * eg, y[2 * e + 1] * eg); d1[e] = cvt_pk_bf16(y[8 + 2 * e] * eg, y[9 + 2 * e] * eg); }
                *(LAS u32x4*)(Qb + t * 136 + cc) = o0; *(LAS u32x4*)(Qb + t * 136 + cc + 8) = o1;
                *(u32x4*)(QD + t * 128 + cc) = d0; *(u32x4*)(QD + t * 128 + cc + 8) = d1;
            } else if (sec == 1) {
                u32x4 o0, o1;
#pragma unroll
                for (int e = 0; e < 4; ++e) { o0[e] = cvt_pk_bf16(y[2 * e], y[2 * e + 1]); o1[e] = cvt_pk_bf16(y[8 + 2 * e], y[9 + 2 * e]); }
                *(LAS u32x4*)(Kb + t * 136 + cc) = o0; *(LAS u32x4*)(Kb + t * 136 + cc + 8) = o1;
                const float s2 = bet * eg;
#pragma unroll
                for (int e = 0; e < 4; ++e) *(LAS f32x4*)(RHS + t * 256 + 128 + cc + e * 4) = (f32x4){y[e * 4] * s2, y[e * 4 + 1] * s2, y[e * 4 + 2] * s2, y[e * 4 + 3] * s2};
            } else {
#pragma unroll
                for (int e = 0; e < 4; ++e) *(LAS f32x4*)(RHS + t * 256 + cc + e * 4) = (f32x4){y[e * 4] * bet, y[e * 4 + 1] * bet, y[e * 4 + 2] * bet, y[e * 4 + 3] * bet};
            }
        }
    }
    __syncthreads();
    {
        const int sel = wave >> 2, it = wave & 3;
        LAS unsigned char* Xb = lds + (sel ? 17408 : 0);
        bf16x8 af[4];
#pragma unroll
        for (int ks = 0; ks < 4; ++ks) af[ks] = lds8(Xb, ((it * 16 + l16) * 136 + ks * 32 + quad * 8) * 2);
#pragma unroll
        for (int jt = 0; jt < 4; ++jt) {
            f32x4 a = {0.f, 0.f, 0.f, 0.f};
            if (jt <= it) {
#pragma unroll
                for (int ks = 0; ks < 4; ++ks) a = mfma16(af[ks], lds8(lds, ((jt * 16 + l16) * 136 + ks * 32 + quad * 8) * 2), a);
            }
            const int j = jt * 16 + l16; const float gj = gcs[j];
#pragma unroll
            for (int r = 0; r < 4; ++r) { const int i = it * 16 + quad * 4 + r;
                const float dec = (i >= j) ? __expf(gcs[i] - gj) : 0.f;
                if (sel == 0) Lm[i * 64 + j] = (i > j) ? bts[i] * a[r] * dec : 0.f;
                else ATT[i * 64 + j] = f2bf((i >= j) ? a[r] * dec : 0.f); }
        }
    }
    {
        const int d = tid >> 2, tq = (tid & 3) * 16; const float gl = gcs[63];
        u32x4 o0, o1;
#pragma unroll
        for (int e = 0; e < 8; ++e) { const int t0 = tq + 2 * e;
            const unsigned v = cvt_pk_bf16(bf2f(Kb[t0 * 136 + d]) * __expf(gl - gcs[t0]), bf2f(Kb[(t0 + 1) * 136 + d]) * __expf(gl - gcs[t0 + 1]));
            if (e < 4) o0[e] = v; else o1[e - 4] = v; }
        *(u32x4*)(KDT + d * 64 + tq) = o0; *(u32x4*)(KDT + d * 64 + tq + 8) = o1;
    }
    __syncthreads();
    if (wave < 4 && (p.mask & 32)) {
        const int col = tid;
        const LAS float* Lz = Lm + opaque_zero();
        float x[64];
#pragma unroll
        for (int i = 0; i < 64; ++i) {
            f32x4 lr[16];
#pragma unroll
            for (int j4 = 0; j4 < (i + 3) / 4; ++j4) lr[j4] = *(const LAS f32x4*)(Lz + i * 64 + j4 * 4);
            const float rcur = RHS[i * 256 + col];
            __builtin_amdgcn_sched_barrier(0);
            float s4[4] = {0.f, 0.f, 0.f, 0.f};
#pragma unroll
            for (int j4 = 0; j4 < (i + 3) / 4; ++j4) {
#pragma unroll
                for (int e = 0; e < 4; ++e) if (j4 * 4 + e < i) s4[e] += lr[j4][e] * x[j4 * 4 + e]; }
            x[i] = rcur - ((s4[0] + s4[1]) + (s4[2] + s4[3]));
            __builtin_amdgcn_sched_barrier(0);
        }
        bf16_t* dst = (col < 128) ? (U + col) : (W + (col - 128));
#pragma unroll
        for (int i = 0; i < 64; ++i) dst[i * 128] = f2bf(x[i]);
    }
}

static __device__ __forceinline__ void phase_delta_pre(const Params& p, LAS unsigned char* lds) {
    const int wg = blockIdx.x, G = gridDim.x, tid = threadIdx.x;
    const bf16_t* PROJ = (const bf16_t*)(p.ws + OFF_PROJ);
    for (int i = wg * 512 + tid; i < 8 * 3 * 1536; i += G * 512) { const int b = i / 4608, r = i % 4608, j = r / 1536, ch = r % 1536;
        p.out[O_SCP + i] = bf2f(PROJ[(size_t)(b * 2048 + 2045 + j) * PLD + ch]); }
    for (int ci = wg; ci < 1024; ci += G) delta_chunk_item(p, lds, ci);
}

struct ScanFr { bf16x8 w[4], qd[4], at[2], kd[2][2]; u32x2 u; };
__device__ __forceinline__ void scan_load(ScanFr& f, const Params& p, int ci, int vb, int vt, int tt, int dtb, int l16, int quad) {
    const bf16_t* U = (const bf16_t*)((const unsigned char*)p.out + DO_U) + (size_t)ci * 8192; const bf16_t* W = (const bf16_t*)((const unsigned char*)p.out + DO_W) + (size_t)ci * 8192;
    const bf16_t* QD = (const bf16_t*)((const unsigned char*)p.out + DO_QD) + (size_t)ci * 8192; const bf16_t* KDT = (const bf16_t*)((const unsigned char*)p.out + DO_KDT) + (size_t)ci * 8192;
    const bf16_t* ATT = (const bf16_t*)(p.ws + OFF_ATTN) + (size_t)ci * 4096;
#pragma unroll
    for (int ks = 0; ks < 4; ++ks) { f.w[ks] = ldg8(W + (tt * 16 + l16) * 128 + ks * 32 + quad * 8); f.qd[ks] = ldg8(QD + (tt * 16 + l16) * 128 + ks * 32 + quad * 8); }
#pragma unroll
    for (int ks = 0; ks < 2; ++ks) { f.at[ks] = ldg8(ATT + (tt * 16 + l16) * 64 + ks * 32 + quad * 8);
#pragma unroll
        for (int d = 0; d < 2; ++d) f.kd[d][ks] = ldg8(KDT + ((dtb + d) * 16 + l16) * 64 + ks * 32 + quad * 8); }
    f.u = *(const u32x2*)(U + (tt * 16 + l16) * 128 + vb * 32 + vt * 16 + quad * 4);
}
static __device__ __forceinline__ void scan_unit(const Params& p, LAS unsigned char* lds, int unit) {
    const int tid = threadIdx.x, lane = tid & 63, wave = tid >> 6, l16 = lane & 15, quad = lane >> 4;
    const int bh = unit >> 2, vb = unit & 3, b = bh >> 2, h = bh & 3;
    const int vt = wave & 1, tt = wave >> 1, dtb = (wave >> 1) * 2;
    LAS bf16_t* STs = (LAS bf16_t*)lds;
    LAS bf16_t* vnT = (LAS bf16_t*)(lds + 8704);
    bf16_t* PROJ = (bf16_t*)(p.ws + OFF_PROJ); const float* GL = (const float*)(p.ws + OFF_GL);
    __syncthreads();
    for (int i = tid; i < 32 * 136 / 2; i += 512) ((LAS unsigned*)STs)[i] = 0u;
    f32x4 accS[2] = {{0.f, 0.f, 0.f, 0.f}, {0.f, 0.f, 0.f, 0.f}};
    const int ci0 = bh * 32;
    const float glv = GL[ci0 + (lane & 31)];
    ScanFr cur, nxt;
    scan_load(cur, p, ci0, vb, vt, tt, dtb, l16, quad);
    nxt = cur;
    __syncthreads();
    for (int n = 0; n < 32; ++n) {
        if (n + 1 < 32) scan_load(nxt, p, ci0 + n + 1, vb, vt, tt, dtb, l16, quad);
        const float gl = __shfl(glv, n);
        f32x4 aW = {0.f, 0.f, 0.f, 0.f}, aQ = {0.f, 0.f, 0.f, 0.f};
#pragma unroll
        for (int ks = 0; ks < 4; ++ks) { const bf16x8 a = lds8(lds, ((vt * 16 + l16) * 136 + ks * 32 + quad * 8) * 2); aW = mfma16(a, cur.w[ks], aW); aQ = mfma16(a, cur.qd[ks], aQ); }
        const float u0 = bflo(cur.u[0]) - aW[0], u1 = bfhi(cur.u[0]) - aW[1], u2 = bflo(cur.u[1]) - aW[2], u3 = bfhi(cur.u[1]) - aW[3];
        vnT[(vt * 16 + quad * 4 + 0) * 72 + tt * 16 + l16] = f2bf(u0); vnT[(vt * 16 + quad * 4 + 1) * 72 + tt * 16 + l16] = f2bf(u1);
        vnT[(vt * 16 + quad * 4 + 2) * 72 + tt * 16 + l16] = f2bf(u2); vnT[(vt * 16 + quad * 4 + 3) * 72 + tt * 16 + l16] = f2bf(u3);
        asm volatile("s_waitcnt lgkmcnt(0)" ::: "memory"); __builtin_amdgcn_s_barrier(); asm volatile("" ::: "memory");
        accS[0] *= gl; accS[1] *= gl;
#pragma unroll
        for (int ks = 0; ks < 2; ++ks) { const bf16x8 a = lds8(lds, 8704 + ((vt * 16 + l16) * 72 + ks * 32 + quad * 8) * 2);
            aQ = mfma16(a, cur.at[ks], aQ); accS[0] = mfma16(a, cur.kd[0][ks], accS[0]); accS[1] = mfma16(a, cur.kd[1][ks], accS[1]); }
        { u32x2 o; o[0] = cvt_pk_bf16(aQ[0], aQ[1]); o[1] = cvt_pk_bf16(aQ[2], aQ[3]);
          *(u32x2*)(PROJ + (size_t)(b * 2048 + n * 64 + tt * 16 + l16) * PLD + C_AQ + h * 128 + vb * 32 + vt * 16 + quad * 4) = o; }
#pragma unroll
        for (int d = 0; d < 2; ++d)
#pragma unroll
            for (int r = 0; r < 4; ++r) STs[(vt * 16 + quad * 4 + r) * 136 + (dtb + d) * 16 + l16] = f2bf(accS[d][r]);
        asm volatile("s_waitcnt lgkmcnt(0)" ::: "memory"); __builtin_amdgcn_s_barrier(); asm volatile("" ::: "memory");
        cur = nxt;
    }
    float* sdp = p.out + O_SDP + (size_t)bh * 16384;
#pragma unroll
    for (int d = 0; d < 2; ++d) *(f32x4*)(sdp + (size_t)((dtb + d) * 16 + l16) * 128 + vb * 32 + vt * 16 + quad * 4) = accS[d];
}

static __device__ __forceinline__ void sample_delta_item(const Params& p, LAS unsigned char* lds, int it) {
    const int tid = threadIdx.x, b = it >> 2, h = it & 3;
    const bf16_t* PROJ = (const bf16_t*)(p.ws + OFF_PROJ); const float* betag = (const float*)(p.ws + OFF_BETAG); bf16_t* ACT = (bf16_t*)(p.ws + OFF_ACT);
    LAS float* qkv = (LAS float*)lds;
    LAS float* red = (LAS float*)(lds + 2048);
    LAS float* fin = (LAS float*)(lds + 2048 + 16384);
    LAS float* sc = (LAS float*)(lds + 2048 + 16384 + 1024);
    const size_t prow = (size_t)(NP + b) * PLD;
    __syncthreads();
    float yv = 0.f;
    if (tid < 384) { const int sec = tid >> 7, c = tid & 127, ch = sec * 512 + h * 128 + c;
        const float b0 = p.state_conv[(size_t)(b * 3 + 0) * 1536 + ch], b1 = p.state_conv[(size_t)(b * 3 + 1) * 1536 + ch], b2 = p.state_conv[(size_t)(b * 3 + 2) * 1536 + ch];
        const float xn = bf2f(PROJ[prow + ch]);
        float y = b0 * p.conv_w[ch] + b1 * p.conv_w[1536 + ch] + b2 * p.conv_w[3072 + ch] + xn * p.conv_w[4608 + ch];
        yv = siluf_(y);
        float* scs = p.out + O_SCS + (size_t)b * 4608;
        scs[ch] = b1; scs[1536 + ch] = b2; scs[3072 + ch] = xn;
    }
    {
        float ss = wave_sum(yv * yv);
        if ((tid & 63) == 0) sc[8 + (tid >> 6)] = ss;
    }
    __syncthreads();
    if (tid < 384) { const int sec = tid >> 7, c = tid & 127;
        float v = yv;
        if (sec == 0) v *= rsqrtf(sc[8] + sc[9] + EPS) * 0.08838834764831845f;
        else if (sec == 1) v *= rsqrtf(sc[10] + sc[11] + EPS);
        qkv[sec * 128 + c] = v; }
    __syncthreads();
    const int dvq = tid & 31, dkg = tid >> 5;
    const float* S0 = p.state_delta + (size_t)it * 16384;
    f32x4 s[8]; f32x4 pk = {0.f, 0.f, 0.f, 0.f}, pq = {0.f, 0.f, 0.f, 0.f};
#pragma unroll
    for (int j = 0; j < 8; ++j) { const int dk = dkg * 8 + j; s[j] = *(const f32x4*)(S0 + (size_t)dk * 128 + dvq * 4); pk += s[j] * qkv[128 + dk]; pq += s[j] * qkv[dk]; }
    *(LAS f32x4*)(red + dkg * 256 + dvq * 4) = pk; *(LAS f32x4*)(red + dkg * 256 + 128 + dvq * 4) = pq;
    {
        float qk = (tid < 128) ? qkv[tid] * qkv[128 + tid] : 0.f; qk = wave_sum(qk);
        if (tid < 128 && (tid & 63) == 0) sc[tid >> 6] = qk;
    }
    __syncthreads();
    const float beta = betag[(size_t)(NP + b) * 8 + h], a = __expf(betag[(size_t)(NP + b) * 8 + 4 + h]);
    if (tid < 128) { float sk = 0.f, sq = 0.f;
#pragma unroll
        for (int g = 0; g < 16; ++g) { sk += red[g * 256 + tid]; sq += red[g * 256 + 128 + tid]; }
        const float vn = beta * (qkv[256 + tid] - a * sk); const float o = a * sq + (sc[0] + sc[1]) * vn;
        fin[tid] = vn; fin[128 + tid] = o;
        const float oo = wave_sum(o * o); if ((tid & 63) == 0) sc[4 + (tid >> 6)] = oo; }
    __syncthreads();
    const f32x4 vn4 = *(const LAS f32x4*)(fin + dvq * 4);
    float* Sn = p.out + O_SDS + (size_t)it * 16384;
#pragma unroll
    for (int j = 0; j < 8; ++j) { const int dk = dkg * 8 + j; *(f32x4*)(Sn + (size_t)dk * 128 + dvq * 4) = s[j] * a + vn4 * qkv[128 + dk]; }
    if (tid < 128) { const float rstd = rsqrtf((sc[4] + sc[5]) * (1.f / 128.f) + EPS);
        const float gt = bf2f(PROJ[prow + C_AGATE + h * 128 + tid]);
        ACT[(size_t)(NP + b) * LDA + A_YA + h * 128 + tid] = f2bf(fin[128 + tid] * rstd * p.a_norm_g[tid] * siluf_(gt)); }
}

static __device__ __forceinline__ void sample_xattn_item(const Params& p, LAS unsigned char* lds, int it) {
    const int tid = threadIdx.x, lane = tid & 63, wave = tid >> 6, b = it >> 2, h = it & 3;
    const bf16_t* PROJ = (const bf16_t*)(p.ws + OFF_PROJ); bf16_t* ACT = (bf16_t*)(p.ws + OFF_ACT);
    LAS float* scr = (LAS float*)lds;
    LAS float* red = (LAS float*)(lds + 1024);
    const int half = lane >> 5, dl = lane & 31;
    const size_t prow = (size_t)(NP + b) * PLD;
    f32x4 q; { const bf16_t* qp = PROJ + prow + C_CQ + h * 128 + dl * 4; const u32x2 u = *(const u32x2*)qp; q = (f32x4){bflo(u[0]), bfhi(u[0]), bflo(u[1]), bfhi(u[1])}; }
    const float* Kp = p.cache_k + ((size_t)(b * 256) * 4 + h) * 128 + dl * 4; const float* Vp = p.cache_v + ((size_t)(b * 256) * 4 + h) * 128 + dl * 4;
    __syncthreads();
    f32x4 kv[16];
#pragma unroll
    for (int i = 0; i < 16; ++i) { const int m = wave * 32 + i * 2 + half; kv[i] = *(const f32x4*)(Kp + (size_t)m * 512); }
#pragma unroll
    for (int i = 0; i < 16; ++i) { float d = kv[i][0] * q[0] + kv[i][1] * q[1] + kv[i][2] * q[2] + kv[i][3] * q[3];
#pragma unroll
        for (int o = 16; o >= 1; o >>= 1) d += __shfl_xor(d, o);
        if (dl == 0) scr[wave * 32 + i * 2 + half] = d * 0.08838834764831845f; }
#pragma unroll
    for (int i = 0; i < 16; ++i) { const int m = wave * 32 + i * 2 + half; kv[i] = *(const f32x4*)(Vp + (size_t)m * 512); }
    __syncthreads();
    float mx = -3.0e38f;
#pragma unroll
    for (int i = 0; i < 4; ++i) mx = fmaxf(mx, scr[lane + 64 * i]);
#pragma unroll
    for (int o = 32; o >= 1; o >>= 1) mx = fmaxf(mx, __shfl_xor(mx, o));
    float sm = 0.f;
#pragma unroll
    for (int i = 0; i < 4; ++i) sm += __expf(scr[lane + 64 * i] - mx);
    sm = wave_sum(sm);
    const float inv = 1.f / sm;
    f32x4 o = {0.f, 0.f, 0.f, 0.f};
#pragma unroll
    for (int i = 0; i < 16; ++i) { const float pr = __expf(scr[wave * 32 + i * 2 + half] - mx) * inv; o += kv[i] * pr; }
    *(LAS f32x4*)(red + (wave * 2 + half) * 128 + dl * 4) = o;
    __syncthreads();
    if (tid < 128) { float s = 0.f;
#pragma unroll
        for (int g = 0; g < 16; ++g) s += red[g * 128 + tid];
        const float gt = bf2f(PROJ[prow + C_CGATE + h * 128 + tid]);
        ACT[(size_t)(NP + b) * LDA + A_YC + h * 128 + tid] = f2bf(s * siluf_(gt)); }
}

static __device__ __forceinline__ void sample_mlp_item(const Params& p, int it) {
    const int tid = threadIdx.x, lane = tid & 63, wave = tid >> 6, b = it * 8 + wave;
    const bf16_t* PROJ = (const bf16_t*)(p.ws + OFF_PROJ); bf16_t* ACT = (bf16_t*)(p.ws + OFF_ACT);
    const size_t prow = (size_t)(NP + b) * PLD; const int c0 = lane * 8;
    const u32x4 xv = *(const u32x4*)(PROJ + prow + C_BV + c0), xu = *(const u32x4*)(PROJ + prow + C_BU + c0), xg = *(const u32x4*)(PROJ + prow + C_BGATE + c0);
    float v[8], s1 = 0.f, s2 = 0.f;
#pragma unroll
    for (int e = 0; e < 4; ++e) { v[2 * e] = bflo(xv[e]); v[2 * e + 1] = bfhi(xv[e]); }
#pragma unroll
    for (int e = 0; e < 8; ++e) s1 += v[e];
    s1 = wave_sum(s1); const float mu = s1 * (1.f / 512.f);
#pragma unroll
    for (int e = 0; e < 8; ++e) { v[e] -= mu; s2 += v[e] * v[e]; }
    s2 = wave_sum(s2); const float rstd = rsqrtf(s2 * (1.f / 512.f) + EPS);
    const int g = c0 >> 7; const float w00 = p.w_spatial[(size_t)g * 16384], bs = p.b_spatial[g * 128];
    float* cvs = p.out + O_CVS + (size_t)b * 512 + c0;
    u32x4 o;
#pragma unroll
    for (int e = 0; e < 4; ++e) { float r[2];
#pragma unroll
        for (int z = 0; z < 2; ++z) { const int c = c0 + 2 * e + z; const float vn = v[2 * e + z] * rstd * p.ln_v_g[c] + p.ln_v_b[c]; cvs[2 * e + z] = vn;
            const float uu = z ? bfhi(xu[e]) : bflo(xu[e]), gg = z ? bfhi(xg[e]) : bflo(xg[e]); r[z] = uu * (w00 * vn + bs) * siluf_(gg); }
        o[e] = cvt_pk_bf16(r[0], r[1]); }
    *(u32x4*)(ACT + (size_t)(NP + b) * LDA + A_YB + c0) = o;
}

static __device__ __forceinline__ void mlp_item(const Params& p, LAS unsigned char* lds, int it) {
    const int tid = threadIdx.x, lane = tid & 63, wave = tid >> 6, l16 = lane & 15, quad = lane >> 4;
    const int row0 = (it >> 4) * 2048 + (it & 15) * 128;
    const bf16_t* PROJ = (const bf16_t*)(p.ws + OFF_PROJ); bf16_t* ACT = (bf16_t*)(p.ws + OFF_ACT);
    LAS bf16_t* vnT = (LAS bf16_t*)lds;
    LAS bf16_t* Wsm = (LAS bf16_t*)(lds + 34816);
    LAS float* st = (LAS float*)(lds + 69632);
    __syncthreads();
    { const int r = tid >> 2, part = tid & 3; const bf16_t* rp = PROJ + (size_t)(row0 + r) * PLD + C_BV + part * 128; float s1 = 0.f, s2 = 0.f;
#pragma unroll
      for (int i = 0; i < 16; ++i) { const u32x4 x = *(const u32x4*)(rp + i * 8);
#pragma unroll
          for (int e = 0; e < 4; ++e) { const float a = bflo(x[e]), c = bfhi(x[e]); s1 += a + c; s2 += a * a + c * c; } }
      s1 += __shfl_xor(s1, 1); s1 += __shfl_xor(s1, 2); s2 += __shfl_xor(s2, 1); s2 += __shfl_xor(s2, 2);
      const float mu = s1 * (1.f / 512.f); const float var = fmaxf(s2 * (1.f / 512.f) - mu * mu, 0.f);
      if (part == 0) { st[r * 2] = mu; st[r * 2 + 1] = rsqrtf(var + EPS); } }
    __syncthreads();
#pragma unroll 1
    for (int g = 0; g < 4; ++g) {
        { const int s = lane + 64 * (wave & 1), cq = (wave >> 1) * 32; const float mu = st[s * 2], rstd = st[s * 2 + 1];
          const bf16_t* rp = PROJ + (size_t)(row0 + s) * PLD + C_BV + g * 128 + cq;
#pragma unroll
          for (int i = 0; i < 4; ++i) { const u32x4 x = *(const u32x4*)(rp + i * 8);
#pragma unroll
              for (int e = 0; e < 4; ++e) { const int c = cq + i * 8 + 2 * e; const int gc = g * 128 + c;
                  vnT[c * 136 + s] = f2bf((bflo(x[e]) - mu) * rstd * p.ln_v_g[gc] + p.ln_v_b[gc]);
                  vnT[(c + 1) * 136 + s] = f2bf((bfhi(x[e]) - mu) * rstd * p.ln_v_g[gc + 1] + p.ln_v_b[gc + 1]); } }
          const int t = tid >> 2, sq = (tid & 3) * 32; const float* wp = p.w_spatial + ((size_t)g * 128 + t) * 128 + sq;
#pragma unroll
          for (int i = 0; i < 4; ++i) { const f32x4 w0 = *(const f32x4*)(wp + i * 8), w1 = *(const f32x4*)(wp + i * 8 + 4); const int s0 = sq + i * 8;
              f32x4 m0, m1;
#pragma unroll
              for (int e = 0; e < 4; ++e) { m0[e] = (s0 + e <= t) ? w0[e] : 0.f; m1[e] = (s0 + 4 + e <= t) ? w1[e] : 0.f; }
              *(LAS u32x4*)(Wsm + t * 136 + s0) = pack8(m0, m1); } }
        __syncthreads();
        f32x4 acc[8];
#pragma unroll
        for (int ct = 0; ct < 8; ++ct) acc[ct] = (f32x4){0.f, 0.f, 0.f, 0.f};
        const int nks = (wave >> 1) + 1;
        for (int ks = 0; ks < nks; ++ks) { const bf16x8 bw = lds8(lds, 34816 + ((wave * 16 + l16) * 136 + ks * 32 + quad * 8) * 2);
#pragma unroll
            for (int ct = 0; ct < 8; ++ct) acc[ct] = mfma16(lds8(lds, ((ct * 16 + l16) * 136 + ks * 32 + quad * 8) * 2), bw, acc[ct]); }
        const int t = wave * 16 + l16; const size_t prow = (size_t)(row0 + t) * PLD; const float bs = p.b_spatial[g * 128 + t];
#pragma unroll
        for (int ct = 0; ct < 8; ++ct) { const int col = g * 128 + ct * 16 + quad * 4;
            const u32x2 xu = *(const u32x2*)(PROJ + prow + C_BU + col), xg = *(const u32x2*)(PROJ + prow + C_BGATE + col);
            u32x2 o; o[0] = cvt_pk_bf16(bflo(xu[0]) * (acc[ct][0] + bs) * siluf_(bflo(xg[0])), bfhi(xu[0]) * (acc[ct][1] + bs) * siluf_(bfhi(xg[0])));
            o[1] = cvt_pk_bf16(bflo(xu[1]) * (acc[ct][2] + bs) * siluf_(bflo(xg[1])), bfhi(xu[1]) * (acc[ct][3] + bs) * siluf_(bfhi(xg[1])));
            *(u32x2*)(ACT + (size_t)(row0 + t) * LDA + A_YB + col) = o; }
        __syncthreads();
    }
}

static __device__ __forceinline__ void xattn_item(const Params& p, LAS unsigned char* lds, int it) {
    const int tid = threadIdx.x, lane = tid & 63, wave = tid >> 6, l16 = lane & 15, quad = lane >> 4;
    const int b = it >> 6, h = (it >> 4) & 3, qt = it & 15;
    const bf16_t* PROJ = (const bf16_t*)(p.ws + OFF_PROJ); bf16_t* ACT = (bf16_t*)(p.ws + OFF_ACT); const bf16_t* MKV = (const bf16_t*)(p.ws + OFF_MEMKV);
    LAS bf16_t* Ks = (LAS bf16_t*)lds;
    LAS bf16_t* Vt = (LAS bf16_t*)(lds + 69632);
    __syncthreads();
#pragma unroll
    for (int i = 0; i < 8; ++i) { const int idx = wave * 8 + i, m = (idx & 3) * 64 + lane, dc = (idx >> 2) * 8; const bf16_t* sp = MKV + (size_t)(b * 256 + m) * 1024 + h * 128 + dc;
        *(LAS u32x4*)(Ks + m * 136 + dc) = *(const u32x4*)sp;
        const u32x4 v = *(const u32x4*)(sp + 512);
#pragma unroll
        for (int e = 0; e < 4; ++e) { Vt[(dc + 2 * e) * 264 + m] = (bf16_t)(v[e] & 0xffffu); Vt[(dc + 2 * e + 1) * 264 + m] = (bf16_t)(v[e] >> 16); } }
    const int q0 = b * 2048 + qt * 128 + wave * 16; const size_t prow = (size_t)(q0 + l16) * PLD;
    bf16x8 qf[4];
#pragma unroll
    for (int ks = 0; ks < 4; ++ks) qf[ks] = ldg8(PROJ + prow + C_CQ + h * 128 + ks * 32 + quad * 8);
    __syncthreads();
    f32x4 s[16];
#pragma unroll
    for (int mt = 0; mt < 16; ++mt) { s[mt] = (f32x4){0.f, 0.f, 0.f, 0.f};
#pragma unroll
        for (int ks = 0; ks < 4; ++ks) s[mt] = mfma16(lds8(lds, ((mt * 16 + l16) * 136 + ks * 32 + quad * 8) * 2), qf[ks], s[mt]); }
    float mx = -3.0e38f;
#pragma unroll
    for (int mt = 0; mt < 16; ++mt)
#pragma unroll
        for (int r = 0; r < 4; ++r) mx = fmaxf(mx, s[mt][r]);
    mx = fmaxf(mx, __shfl_xor(mx, 16)); mx = fmaxf(mx, __shfl_xor(mx, 32));
    const float sc = 0.08838834764831845f * 1.4426950408889634f; float sm = 0.f;
#pragma unroll
    for (int mt = 0; mt < 16; ++mt)
#pragma unroll
        for (int r = 0; r < 4; ++r) { s[mt][r] = exp2f((s[mt][r] - mx) * sc); sm += s[mt][r]; }
    sm += __shfl_xor(sm, 16); sm += __shfl_xor(sm, 32);
    const float inv = 1.f / sm;
    bf16x8 pb[8];
#pragma unroll
    for (int ss = 0; ss < 8; ++ss) { const u32x4 pu = pack8(s[2 * ss], s[2 * ss + 1]); pb[ss] = __builtin_bit_cast(bf16x8, pu); }
#pragma unroll 1
    for (int dt = 0; dt < 8; ++dt) {
        f32x4 o = {0.f, 0.f, 0.f, 0.f};
#pragma unroll
        for (int ss = 0; ss < 8; ++ss) { const bf16x4 v0 = *(const LAS bf16x4*)(Vt + (dt * 16 + l16) * 264 + ss * 32 + quad * 4), v1 = *(const LAS bf16x4*)(Vt + (dt * 16 + l16) * 264 + ss * 32 + 16 + quad * 4);
            o = mfma16(__builtin_shufflevector(v0, v1, 0, 1, 2, 3, 4, 5, 6, 7), pb[ss], o); }
        const int col = h * 128 + dt * 16 + quad * 4; const u32x2 xg = *(const u32x2*)(PROJ + prow + C_CGATE + col);
        u32x2 w; w[0] = cvt_pk_bf16(o[0] * inv * siluf_(bflo(xg[0])), o[1] * inv * siluf_(bfhi(xg[0])));
        w[1] = cvt_pk_bf16(o[2] * inv * siluf_(bflo(xg[1])), o[3] * inv * siluf_(bfhi(xg[1])));
        *(u32x2*)(ACT + (size_t)(q0 + l16) * LDA + A_YC + col) = w;
        __builtin_amdgcn_sched_barrier(0); }
}

static __device__ __forceinline__ void phase_mixers(const Params& p, LAS unsigned char* lds) {
    const int wg = blockIdx.x, G = gridDim.x, tid = threadIdx.x;
    if (p.mask & 1) for (int u = wg; u < 128; u += G) scan_unit(p, lds, u);
    if (G > 128) { for (int it = wg - 128; it >= 0 && it < 128; it += G - 128) mlp_item(p, lds, it); }
    else { for (int it = wg; it < 128; it += G) mlp_item(p, lds, it); }
    unsigned* cnt = (unsigned*)(p.ws + OFF_CNT);
    LAS unsigned* slot = (LAS unsigned*)(lds + LDS_ITEM);
    for (;;) {
        __syncthreads();
        if (tid == 0) *slot = atomicAdd(cnt, 1u);
        __syncthreads();
        const int it = (int)*slot;
        if (it >= 1552) break;
        if (it < 512) xattn_item(p, lds, it);
        else if (it < 1024) sample_delta_item(p, lds, it - 512);
        else if (it < 1536) sample_xattn_item(p, lds, it - 1024);
        else sample_mlp_item(p, it - 1536);
    }
}

static __device__ __forceinline__ void phase_ya(const Params& p) {
    const int tid = threadIdx.x, lane = tid & 63, wave = tid >> 6;
    const bf16_t* PROJ = (const bf16_t*)(p.ws + OFF_PROJ); bf16_t* ACT = (bf16_t*)(p.ws + OFF_ACT);
    const int c0 = lane * 8, d0 = c0 & 127, nw = gridDim.x * 8;
    f32x4 ng0 = *(const f32x4*)(p.a_norm_g + d0), ng1 = *(const f32x4*)(p.a_norm_g + d0 + 4);
    for (int row0 = blockIdx.x * 8 + wave; row0 < NP; row0 += nw * 4) {
        u32x4 xo[4], xg[4];
#pragma unroll
        for (int k = 0; k < 4; ++k) { const int row = row0 + k * nw; if (row < NP) { const size_t prow = (size_t)row * PLD; xo[k] = *(const u32x4*)(PROJ + prow + C_AQ + c0); xg[k] = *(const u32x4*)(PROJ + prow + C_AGATE + c0); } }
#pragma unroll
        for (int k = 0; k < 4; ++k) { const int row = row0 + k * nw; if (row < NP) {
            float v[8], ss = 0.f;
#pragma unroll
            for (int e = 0; e < 4; ++e) { v[2 * e] = bflo(xo[k][e]); v[2 * e + 1] = bfhi(xo[k][e]); ss += v[2 * e] * v[2 * e] + v[2 * e + 1] * v[2 * e + 1]; }
            ss += __shfl_xor(ss, 1); ss += __shfl_xor(ss, 2); ss += __shfl_xor(ss, 4); ss += __shfl_xor(ss, 8);
            const float rstd = rsqrtf(ss * (1.f / 128.f) + EPS);
            u32x4 o;
#pragma unroll
            for (int e = 0; e < 4; ++e) { const float g0 = e < 2 ? ng0[2 * e] : ng1[2 * e - 4], g1 = e < 2 ? ng0[2 * e + 1] : ng1[2 * e - 3];
                o[e] = cvt_pk_bf16(v[2 * e] * rstd * g0 * siluf_(bflo(xg[k][e])), v[2 * e + 1] * rstd * g1 * siluf_(bfhi(xg[k][e]))); }
            *(u32x4*)(ACT + (size_t)row * LDA + A_YA + c0) = o; } }
    }
}

template <int NKS> __device__ __forceinline__ f32x4 small_gemm(const bf16_t* Wt, const bf16_t* A) {
    bf16x8 wv[NKS], av[NKS];
#pragma unroll
    for (int ks = 0; ks < NKS; ++ks) { wv[ks] = ldg8(Wt + ks * 32); av[ks] = ldg8(A + ks * 32); }
    f32x4 acc = {0.f, 0.f, 0.f, 0.f};
#pragma unroll
    for (int ks = 0; ks < NKS; ++ks) acc = mfma16(wv[ks], av[ks], acc);
    return acc;
}
static __device__ __forceinline__ void sample_g3(const Params& p, LAS unsigned char* lds) {
    const int tid = threadIdx.x, lane = tid & 63, wave = tid >> 6, l16 = lane & 15, quad = lane >> 4, c = blockIdx.x;
    const int ct = c >> 2, rt = 2 * (c & 3) + (wave >> 2), kp = wave & 3;
    const bf16_t* ACT = (const bf16_t*)(p.ws + OFF_ACT); const bf16_t* WG3 = (const bf16_t*)(p.ws + OFF_WG3); bf16_t* MERGED = (bf16_t*)(p.ws + OFF_MERGED);
    const int r = NP + rt * 16 + l16 + opaque_zero(), n0 = ct * 16;
    LAS f32x4* red = (LAS f32x4*)lds;
#pragma unroll
    for (int br = 0; br < 3; ++br) {
        const bf16_t* wrow = WG3 + ((size_t)br * 1024 + n0 + l16) * 1536 + quad * 8; const bf16_t* arow = ACT + (size_t)r * LDA + quad * 8;
        red[(wave * 6 + 2 * br) * 64 + lane] = small_gemm<8>(wrow + kp * 256, arow + kp * 256);
        red[(wave * 6 + 2 * br + 1) * 64 + lane] = small_gemm<4>(wrow + 1024 + kp * 128, arow + A_YA + br * 512 + kp * 128);
    }
    __syncthreads();
    if (kp == 0) {
        f32x4 m = {0.f, 0.f, 0.f, 0.f};
#pragma unroll
        for (int br = 0; br < 3; ++br) {
            f32x4 ag = {0.f, 0.f, 0.f, 0.f}, at = {0.f, 0.f, 0.f, 0.f};
#pragma unroll
            for (int k = 0; k < 4; ++k) { ag += red[((wave + k) * 6 + 2 * br) * 64 + lane]; at += red[((wave + k) * 6 + 2 * br + 1) * 64 + lane]; }
            const f32x4 bg = *(const f32x4*)(p.b_gate + br * 1024 + n0 + quad * 4);
#pragma unroll
            for (int e = 0; e < 4; ++e) m[e] += sigmoidf_(ag[e] + bg[e]) * at[e];
        }
        u32x2 o; o[0] = cvt_pk_bf16(m[0], m[1]); o[1] = cvt_pk_bf16(m[2], m[3]);
        *(u32x2*)(MERGED + (size_t)r * 1024 + n0 + quad * 4) = o;
    }
}
static __device__ __forceinline__ void sample_g4(const Params& p, LAS unsigned char* lds) {
    const int tid = threadIdx.x, lane = tid & 63, wave = tid >> 6, l16 = lane & 15, quad = lane >> 4, c = blockIdx.x;
    const int ct = c >> 2, rt = 2 * (c & 3) + (wave >> 2), kp = wave & 3;
    const bf16_t* WOUT = (const bf16_t*)(p.ws + OFF_WOUT); const bf16_t* MERGED = (const bf16_t*)(p.ws + OFF_MERGED); float* rowsq = (float*)(p.ws + OFF_ROWSQ);
    const int rs = rt * 16 + l16 + opaque_zero(), n0 = ct * 16;
    LAS f32x4* red = (LAS f32x4*)lds;
    red[wave * 64 + lane] = small_gemm<8>(WOUT + (size_t)(n0 + l16) * 1024 + quad * 8 + kp * 256, MERGED + (size_t)(NP + rs) * 1024 + quad * 8 + kp * 256);
    __syncthreads();
    if (kp == 0) {
        f32x4 a = red[wave * 64 + lane] + red[(wave + 1) * 64 + lane] + red[(wave + 2) * 64 + lane] + red[(wave + 3) * 64 + lane];
        const f32x4 v = *(const f32x4*)(p.x_sample + (size_t)rs * 1024 + n0 + quad * 4) + a;
        *(f32x4*)(p.out + O_YS + (size_t)rs * 1024 + n0 + quad * 4) = v;
        float ss = v[0] * v[0] + v[1] * v[1] + v[2] * v[2] + v[3] * v[3];
        ss += __shfl_xor(ss, 16); ss += __shfl_xor(ss, 32);
        if (quad == 0) unsafeAtomicAdd(rowsq + NP + rs, ss);
    }
}

static __device__ __forceinline__ void sample_g4_finish(const Params& p) {
    const int tid = threadIdx.x, lane = tid & 63, wave = tid >> 6, l16 = lane & 15, quad = lane >> 4, c = blockIdx.x;
    const int ct = c >> 2, rt = 2 * (c & 3) + (wave >> 2), kp = wave & 3;
    const float* rowsq = (const float*)(p.ws + OFF_ROWSQ);
    if (kp == 0) { const int rs = rt * 16 + l16, n0 = ct * 16; float* op = p.out + O_YS + (size_t)rs * 1024 + n0 + quad * 4;
        const float r = rsqrtf(__hip_atomic_load(rowsq + NP + rs, __ATOMIC_RELAXED, __HIP_MEMORY_SCOPE_AGENT) * (1.f / 1024.f) + EPS);
        *(f32x4*)op = *(const f32x4*)op * r * *(const f32x4*)(p.final_norm_g + n0 + quad * 4); }
}
static __device__ __forceinline__ void phase_final(const Params& p) {
    const float* rowsq = (const float*)(p.ws + OFF_ROWSQ);
    const int total4 = (NP + NS) * 256, stride = gridDim.x * 512;
    for (int base = blockIdx.x * 512 + threadIdx.x; base < total4; base += stride * 8) {
        f32x4 v[8]; float rs[8];
#pragma unroll
        for (int k = 0; k < 8; ++k) { const int i = base + k * stride; if (i < total4) { v[k] = *(const f32x4*)(p.out + (size_t)i * 4); rs[k] = rowsq[i >> 8]; } }
#pragma unroll
        for (int k = 0; k < 8; ++k) { const int i = base + k * stride; if (i < total4) { const f32x4 g = *(const f32x4*)(p.final_norm_g + (i & 255) * 4);
            *(f32x4*)(p.out + (size_t)i * 4) = v[k] * rsqrtf(rs[k] * (1.f / 1024.f) + EPS) * g; } }
    }
}

__global__ void __launch_bounds__(512, 2) fwd_megakernel(Params p) {
    extern __shared__ __attribute__((aligned(16))) unsigned char shm[];
    LAS unsigned char* lds = (LAS unsigned char*)shm;
    cg::grid_group grid = cg::this_grid();
    const int G = gridDim.x, c = blockIdx.x;
    unsigned* bar = (unsigned*)(p.ws + OFF_BAR); unsigned ep = 0u;
#define PH_BEGIN(k) if (p.ph_lo <= (k) && (k) < p.ph_hi) { if ((k) > p.ph_lo) { if ((k) == 1) grid_sync_all(grid); else fast_sync(bar, ++ep); }
#define PH_END }
#if !defined(ONLY_PH) || ONLY_PH == 0
    PH_BEGIN(0) phase_prep(p, lds); PH_END
#endif
#if !defined(ONLY_PH) || ONLY_PH == 1
    PH_BEGIN(1) { SchedG1 S{(const char*)(p.ws + OFF_ACT), (const char*)(p.ws + OFF_W1T), G, c};
                  EpiG1 E{(bf16_t*)(p.ws + OFF_PROJ), (bf16_t*)(p.ws + OFF_MEMKV), p.out};
                  pg8::gemm_phase(lds, LDA, 1024, S, E); } PH_END
#endif
#if !defined(ONLY_PH) || ONLY_PH == 2
    PH_BEGIN(2) phase_delta_pre(p, lds); PH_END
#endif
#if !defined(ONLY_PH) || ONLY_PH == 3
    PH_BEGIN(3) phase_mixers(p, lds); PH_END
#endif
#if !defined(ONLY_PH) || ONLY_PH == 4
    PH_BEGIN(4) phase_ya(p); PH_END
#endif
#if !defined(ONLY_PH) || ONLY_PH == 5
    PH_BEGIN(5) { SchedG3 S{(const char*)(p.ws + OFF_ACT), (const char*)(p.ws + OFF_WG3), G, c};
                  EpiG3 E{p.ws + OFF_PROJ + (size_t)c * SCR_PER_WG, (bf16_t*)(p.ws + OFF_MERGED), p.b_gate};
                  pg8::gemm_phase(lds, LDA, 1536, S, E);
                  sample_g3(p, lds); } PH_END
#endif
#if !defined(ONLY_PH) || ONLY_PH == 6
    PH_BEGIN(6) { sample_g4(p, lds); __syncthreads();
                  SchedG4 S{(const char*)(p.ws + OFF_MERGED), (const char*)(p.ws + OFF_WOUT), G, c};
                  EpiG4 E{p.x_prompt, p.out, (float*)(p.ws + OFF_ROWSQ), p.final_norm_g, bar, ep + 1u};
                  pg8::gemm_phase(lds, 1024, 1024, S, E);
                  sample_g4_finish(p); } PH_END
#endif
#if !defined(ONLY_PH) || ONLY_PH == 7
#endif
}

extern "C" void kernel_launch(void* const* d_in, const int* in_sizes, int n_in, void* d_out, int out_size, void* d_ws, size_t ws_size, hipStream_t stream) {
    static int grid_blocks = 0;
    if (grid_blocks == 0) {
        if (n_in != 25 || ws_size < WS_END) { fprintf(stderr, "kernel_launch: unexpected n_in %d / ws_size %zu (need %zu)\n", n_in, ws_size, (size_t)WS_END); grid_blocks = -1; return; }
        int dev = 0, cus = 0, per_cu = 0;
        hipGetDevice(&dev);
        hipDeviceGetAttribute(&cus, hipDeviceAttributeMultiprocessorCount, dev);
        if (hipFuncSetAttribute((const void*)fwd_megakernel, hipFuncAttributeMaxDynamicSharedMemorySize, LDS_BYTES) != hipSuccess) { fprintf(stderr, "kernel_launch: hipFuncSetAttribute failed\n"); }
        if (hipOccupancyMaxActiveBlocksPerMultiprocessor(&per_cu, fwd_megakernel, 512, LDS_BYTES) != hipSuccess || per_cu < 1) { fprintf(stderr, "kernel_launch: occupancy query gave %d\n", per_cu); per_cu = 1; }
        (void)hipGetLastError();
        grid_blocks = cus * per_cu; if (grid_blocks > 256) grid_blocks = 256;
        if (grid_blocks != 256) { fprintf(stderr, "kernel_launch: this build needs exactly 256 co-resident workgroups (one output tile each in the fused out-projection epilogue); got %d\n", grid_blocks); grid_blocks = -1; return; }
    }
    if (grid_blocks < 0) return;
    Params p{};
    const float** f = (const float**)&p;
    for (int i = 0; i < 25; ++i) f[i] = (const float*)d_in[i];
    p.out = (float*)d_out; p.ws = (unsigned char*)d_ws; p.ph_lo = 0; p.ph_hi = 8; p.mask = 0xff;
    hipMemsetAsync((char*)d_ws + OFF_BAR, 0, 9 * 256, stream);
    void* args[] = {&p};
    hipError_t e = hipLaunchCooperativeKernel((const void*)fwd_megakernel, dim3(grid_blocks), dim3(512), args, LDS_BYTES, stream);
    if (e != hipSuccess) fprintf(stderr, "cooperative launch failed: %s (grid %d)\n", hipGetErrorString(e), grid_blocks);
}
```

```cpp
#include <hip/hip_runtime.h>
#include <hip/hip_cooperative_groups.h>
#include <cstdio>
namespace cg = cooperative_groups;

#define LAS __attribute__((address_space(3)))
#define GAS __attribute__((address_space(1)))
typedef unsigned short bf16_t;
typedef short bf16x8 __attribute__((ext_vector_type(8)));
typedef short bf16x4 __attribute__((ext_vector_type(4)));
typedef float f32x4 __attribute__((ext_vector_type(4)));
typedef unsigned u32x4 __attribute__((ext_vector_type(4)));
typedef unsigned u32x2 __attribute__((ext_vector_type(2)));

constexpr int NP = 16384, NS = 128, MROWS = 16640, HM0 = 16640, LDA = 2560, PLD = 4608;
constexpr int C_AQ = 0, C_AK = 512, C_AV = 1024, C_AGATE = 1536, C_BU = 2048, C_BV = 2560, C_BGATE = 3072, C_CQ = 3584, C_CGATE = 4096;
constexpr int A_H = 0, A_YA = 1024, A_YB = 1536, A_YC = 2048;
constexpr float EPS = 1e-6f;
constexpr size_t OFF_W1T = 0;
constexpr size_t OFF_WG3 = 11534336;
constexpr size_t OFF_WOUT = 20971520;
constexpr size_t OFF_ACT = 23068672;
constexpr size_t OFF_PROJ = 118751232;
constexpr size_t OFF_ATTN = 272105472;
constexpr size_t OFF_MEMKV = 280494080;
constexpr size_t OFF_BETAG = 284688384;
constexpr size_t OFF_ROWSQ = 285216768;
constexpr size_t OFF_GL = 285283328;
constexpr size_t OFF_CNT = 285287424;
constexpr size_t OFF_BAR = 285287680;
constexpr size_t WS_END = 285290240;
constexpr size_t SCR_PER_WG = 262144;
constexpr size_t OFF_MERGED = OFF_PROJ + 256 * SCR_PER_WG;
constexpr size_t DO_U = 0, DO_W = 16777216, DO_QD = 33554432, DO_KDT = 50331648;
constexpr size_t O_YS = 16777216, O_SDP = 16908288, O_SCP = 17432576, O_MKP = 17469440, O_MVP = 18518016, O_SDS = 19566592, O_SCS = 27955200, O_CVS = 28545024;
constexpr int LDS_BYTES = 143360;
constexpr int LDS_ITEM = 143344;

struct Params {
    const float *x_prompt, *x_sample, *cache_k, *cache_v, *state_delta, *state_conv, *mem_prompt, *norm_g, *w_in, *conv_w, *a_log, *dt_bias, *a_norm_g,
        *ln_v_g, *ln_v_b, *w_spatial, *b_spatial, *mem_norm_g, *w_mem_kv, *w_br_a, *w_br_b, *w_br_c, *b_gate, *w_out, *final_norm_g;
    float* out;
    unsigned char* ws;
    int ph_lo, ph_hi, mask, pad_;
};

typedef __bf16 bf16v2_t __attribute__((ext_vector_type(2)));
__device__ __forceinline__ unsigned cvt_pk_bf16(float lo, float hi) { bf16v2_t v; v[0] = (__bf16)lo; v[1] = (__bf16)hi; return __builtin_bit_cast(unsigned, v); }
__device__ __forceinline__ bf16_t f2bf(float f) { return (bf16_t)(cvt_pk_bf16(f, 0.f) & 0xffffu); }
__device__ __forceinline__ float bf2f(bf16_t b) { return __uint_as_float(((unsigned)b) << 16); }
__device__ __forceinline__ float bflo(unsigned u) { return __uint_as_float(u << 16); }
__device__ __forceinline__ float bfhi(unsigned u) { return __uint_as_float(u & 0xffff0000u); }
__device__ __forceinline__ float sigmoidf_(float x) { return __builtin_amdgcn_rcpf(1.f + __expf(-x)); }
__device__ __forceinline__ float siluf_(float x) { return x * __builtin_amdgcn_rcpf(1.f + __expf(-x)); }
__device__ __forceinline__ float wave_sum(float v) {
#pragma unroll
    for (int o = 32; o >= 1; o >>= 1) v += __shfl_xor(v, o);
    return v;
}
__device__ __forceinline__ int opaque_zero() { int z; asm volatile("v_mov_b32 %0, 0" : "=v"(z)); return z; }
__device__ __forceinline__ f32x4 mfma16(bf16x8 a, bf16x8 b, f32x4 c) { return __builtin_amdgcn_mfma_f32_16x16x32_bf16(a, b, c, 0, 0, 0); }
__device__ __forceinline__ bf16x8 ldg8(const bf16_t* p) { return *(const bf16x8*)p; }
__device__ __forceinline__ bf16x8 lds8(LAS unsigned char* l, int off) { return *(const LAS bf16x8*)(l + off); }
__device__ __forceinline__ u32x4 pack8(f32x4 a, f32x4 b) { u32x4 r; r[0] = cvt_pk_bf16(a[0], a[1]); r[1] = cvt_pk_bf16(a[2], a[3]); r[2] = cvt_pk_bf16(b[0], b[1]); r[3] = cvt_pk_bf16(b[2], b[3]); return r; }

__device__ __forceinline__ void grid_sync_all(cg::grid_group& grid) {
    asm volatile("s_waitcnt vmcnt(0)" ::: "memory");
    grid.sync();
    if (threadIdx.x < 64) { __builtin_amdgcn_fence(__ATOMIC_ACQUIRE, "agent"); asm volatile("s_waitcnt vmcnt(0)" ::: "memory"); }
    __syncthreads();
}

__device__ __forceinline__ void fast_sync(unsigned* bar, unsigned epoch) {
    asm volatile("s_waitcnt vmcnt(0)" ::: "memory");
    __syncthreads();
    if (threadIdx.x == 0) {
        __builtin_amdgcn_fence(__ATOMIC_RELEASE, "agent"); asm volatile("s_waitcnt vmcnt(0)" ::: "memory");
        const unsigned g = blockIdx.x & 7u, ng = (gridDim.x - g + 7u) / 8u, ngroups = gridDim.x < 8u ? gridDim.x : 8u;
        const unsigned old = __hip_atomic_fetch_add(bar + g * 64, 1u, __ATOMIC_RELAXED, __HIP_MEMORY_SCOPE_AGENT);
        if (old + 1u == epoch * ng) __hip_atomic_fetch_add(bar + 8 * 64, 1u, __ATOMIC_RELAXED, __HIP_MEMORY_SCOPE_AGENT);
        while (__hip_atomic_load(bar + 8 * 64, __ATOMIC_RELAXED, __HIP_MEMORY_SCOPE_AGENT) < epoch * ngroups) __builtin_amdgcn_s_sleep(1);
        __builtin_amdgcn_fence(__ATOMIC_ACQUIRE, "agent"); asm volatile("s_waitcnt vmcnt(0)" ::: "memory");
    }
    __syncthreads();
}

namespace pg8 {
constexpr int BM = 256, BK = 64, HALF = 128, HTB = HALF * BK * 2, STAGE_BYTES = 8 * HTB;
__device__ __forceinline__ int lds_byte(int r, int c) { const int st = (r >> 4) * 2 + (c >> 5), rr = r & 15, cc = c & 31, ob = rr * 64 + cc * 2; return st * 1024 + (ob ^ (((ob >> 9) & 1) << 5)); }
__device__ __forceinline__ void stage_rc(int b, int& R, int& C) { const int st = b / 1024, sb = b % 1024, swz = sb ^ (((sb >> 9) & 1) << 5); R = (st >> 1) * 16 + swz / 64; C = (st & 1) * 32 + (swz % 64) / 2; }
__device__ __forceinline__ int perm32(int rho) { const int n = rho >> 4, i = rho & 15; return 8 * (i >> 2) + 4 * n + (i & 3); }
struct Unit { int pm, pn, sub; };

template <class Epi, class Sched>
__device__ __forceinline__ void gemm_phase(LAS unsigned char* lds, const int lda, const int ldb, const Sched& S, const Epi& E) {
    const int tid = threadIdx.x, wid = __builtin_amdgcn_readfirstlane(tid >> 6), lane = tid & 63, wr = wid >> 2, wc = wid & 3, fr = lane & 15, fq = lane >> 4;
    unsigned voffA[2], voffB[2];
#pragma unroll
    for (int i = 0; i < 2; ++i) { int R, C; stage_rc(tid * 16 + i * 8192, R, C); const int Rb = (R & ~31) + perm32(R & 31);
        voffA[i] = (unsigned)(R * lda + C) * 2u; voffB[i] = (unsigned)(Rb * ldb + C) * 2u; }
    const size_t kstep = (size_t)(BK * 2);
    const size_t hstepA = (size_t)HALF * lda * 2, hstepB = (size_t)HALF * ldb * 2;
    const unsigned ldsw = (unsigned)wid * 1024u;
    const int aoff = lds_byte(wr * 64 + fr, fq * 8), boff = lds_byte(wc * 32 + fr, fq * 8);
#define PG8_SA(b, h) (((b) * 2 + (h)) * HTB)
#define PG8_SB(b, h) ((4 + (b) * 2 + (h)) * HTB)
#define PG8_STAGE(bufoff, gbase, voff) do { _Pragma("unroll") for (int _i = 0; _i < 2; ++_i) \
        __builtin_amdgcn_global_load_lds((const unsigned*)((const char*)(gbase) + (voff)[_i]), (LAS unsigned*)(lds + (bufoff) + ldsw + _i * 8192), 16, 0, 0); } while (0)
#define PG8_LDA(dst, b, h) do { _Pragma("unroll") for (int m = 0; m < 4; ++m) _Pragma("unroll") for (int k = 0; k < 2; ++k) dst[m][k] = *(const LAS bf16x8*)(lds + PG8_SA(b, h) + aoff + m * 2048 + k * 1024); } while (0)
#define PG8_LDB(dst, b, h) do { _Pragma("unroll") for (int n = 0; n < 2; ++n) _Pragma("unroll") for (int k = 0; k < 2; ++k) dst[n][k] = *(const LAS bf16x8*)(lds + PG8_SB(b, h) + boff + n * 2048 + k * 1024); } while (0)
#define PG8_MMA(ai, bj, At, Bt) do { __builtin_amdgcn_s_setprio(1); _Pragma("unroll") for (int m = 0; m < 4; ++m) _Pragma("unroll") for (int n = 0; n < 2; ++n) _Pragma("unroll") for (int k = 0; k < 2; ++k) \
        acc[ai][bj][m][n] = __builtin_amdgcn_mfma_f32_16x16x32_bf16(Bt[n][k], At[m][k], acc[ai][bj][m][n], 0, 0, 0); __builtin_amdgcn_s_setprio(0); } while (0)
#define PG8_WAIT_V(n) asm volatile("s_waitcnt vmcnt(" #n ")" ::: "memory")
#define PG8_WAIT_L(n) asm volatile("s_waitcnt lgkmcnt(" #n ")" ::: "memory")
#define PG8_BAR __builtin_amdgcn_s_barrier()
#define PG8_SCHED __builtin_amdgcn_sched_barrier(0)
    Unit cur, nxt; int ui = 0;
    if (!S.next(0, cur)) return;
    f32x4 acc[2][2][4][2];
    bf16x8 At[4][2], B0[2][2], B1[2][2];
    const char* cA; const char* cB; int nt;
    S.ptrs(cur, cA, cB, nt);
    PG8_STAGE(PG8_SB(0, 0), cB, voffB); PG8_STAGE(PG8_SA(0, 0), cA, voffA); PG8_STAGE(PG8_SB(0, 1), cB + hstepB, voffB); PG8_STAGE(PG8_SA(0, 1), cA + hstepA, voffA);
    if (wr == 1) PG8_BAR;
    PG8_WAIT_V(4); PG8_BAR;
    PG8_STAGE(PG8_SB(1, 0), cB + kstep, voffB); PG8_STAGE(PG8_SA(1, 0), cA + kstep, voffA); PG8_STAGE(PG8_SB(1, 1), cB + hstepB + kstep, voffB);
    PG8_WAIT_V(6); PG8_BAR;
    PG8_SCHED;
#pragma unroll
    for (int a = 0; a < 2; ++a)
#pragma unroll
        for (int b = 0; b < 2; ++b)
#pragma unroll
            for (int m = 0; m < 4; ++m)
#pragma unroll
                for (int n = 0; n < 2; ++n) acc[a][b][m][n] = (f32x4){0.f, 0.f, 0.f, 0.f};
    for (;;) {
        const bool has_next = S.next(ui + 1, nxt);
        const char* nA = cA; const char* nB = cB; int nnt = nt;
        if (has_next) S.ptrs(nxt, nA, nB, nnt);
        for (int t = 0; t < nt; t += 2) {
            const bool last = (t == nt - 2);
            const char* a1 = cA + (size_t)(t + 1) * kstep;
            const char* a2 = last ? nA : cA + (size_t)(t + 2) * kstep; const char* b2 = last ? nB : cB + (size_t)(t + 2) * kstep;
            const char* a3 = a2 + kstep; const char* b3 = b2 + kstep;
            PG8_LDB(B0, 0, 0); PG8_SCHED; PG8_LDA(At, 0, 0); PG8_STAGE(PG8_SA(1, 1), a1 + hstepA, voffA);
            PG8_WAIT_L(8); PG8_BAR; PG8_WAIT_L(0); PG8_MMA(0, 0, At, B0); PG8_BAR; PG8_SCHED;
            PG8_LDB(B1, 0, 1); PG8_STAGE(PG8_SB(0, 0), b2, voffB);
            PG8_BAR; PG8_WAIT_L(0); PG8_MMA(0, 1, At, B1); PG8_BAR;
            PG8_LDA(At, 0, 1); PG8_STAGE(PG8_SA(0, 0), a2, voffA);
            PG8_BAR; PG8_WAIT_L(0); PG8_MMA(1, 0, At, B0); PG8_BAR; PG8_SCHED;
            PG8_STAGE(PG8_SB(0, 1), b2 + hstepB, voffB);
            PG8_WAIT_V(6); PG8_BAR; PG8_MMA(1, 1, At, B1); PG8_BAR;
            PG8_LDB(B0, 1, 0); PG8_SCHED; PG8_LDA(At, 1, 0); PG8_STAGE(PG8_SA(0, 1), a2 + hstepA, voffA);
            PG8_WAIT_L(8); PG8_BAR; PG8_WAIT_L(0); PG8_MMA(0, 0, At, B0); PG8_BAR; PG8_SCHED;
            PG8_LDB(B1, 1, 1); PG8_STAGE(PG8_SB(1, 0), b3, voffB);
            PG8_BAR; PG8_WAIT_L(0); PG8_MMA(0, 1, At, B1); PG8_BAR;
            PG8_LDA(At, 1, 1); PG8_STAGE(PG8_SA(1, 0), a3, voffA);
            PG8_BAR; PG8_WAIT_L(0); PG8_MMA(1, 0, At, B0); PG8_BAR; PG8_SCHED;
            PG8_STAGE(PG8_SB(1, 1), b3 + hstepB, voffB);
            PG8_WAIT_V(6); PG8_BAR; PG8_MMA(1, 1, At, B1); PG8_BAR;
        }
        __builtin_amdgcn_sched_barrier(0);
        E(acc, cur, wr, wc, fr, fq);
        __builtin_amdgcn_sched_barrier(0);
        if (!has_next) break;
        const float kf = S.keep(cur) ? 1.f : 0.f;
#pragma unroll
        for (int a = 0; a < 2; ++a)
#pragma unroll
            for (int b = 0; b < 2; ++b)
#pragma unroll
                for (int m = 0; m < 4; ++m)
#pragma unroll
                    for (int n = 0; n < 2; ++n) { if constexpr (Sched::HAS_KEEP) acc[a][b][m][n] *= kf; else acc[a][b][m][n] = (f32x4){0.f, 0.f, 0.f, 0.f}; }
        cur = nxt; cA = nA; cB = nB; nt = nnt; ++ui;
    }
    PG8_WAIT_V(0);
    if (wr == 0) PG8_BAR;
    PG8_BAR;
    if constexpr (Epi::HAS_POST) E.post(acc, cur, wr, wc, fr, fq);
#undef PG8_SA
#undef PG8_SB
#undef PG8_STAGE
#undef PG8_LDA
#undef PG8_LDB
#undef PG8_MMA
#undef PG8_WAIT_V
#undef PG8_WAIT_L
#undef PG8_BAR
#undef PG8_SCHED
}
}

struct SchedG1 {
    const char* A; const char* B; int G, c;
    __device__ __forceinline__ bool next(int i, pg8::Unit& u) const {
        const int L = i * G + c; if (L >= 1202) return false;
        if (L < 1170) {
            const int nM = 65, nN = 18, nwg = 1170;
            int wgid = L; { const int q = nwg / 8, r = nwg % 8, xcd = wgid % 8, off = wgid / 8; wgid = (xcd < r ? xcd * (q + 1) : r * (q + 1) + (xcd - r) * q) + off; }
            const int nig = 8 * nN, gid = wgid / nig, fm = gid * 8, gsz = (nM - fm) < 8 ? (nM - fm) : 8;
            u.pm = fm + ((wgid % nig) % gsz); u.pn = (wgid % nig) / gsz;
        } else { const int l2 = L - 1170; u.pm = 65 + (l2 >> 2); u.pn = 18 + (l2 & 3); }
        u.sub = 0; return true;
    }
    __device__ __forceinline__ void ptrs(const pg8::Unit& u, const char*& a, const char*& b, int& nt) const {
        a = A + (size_t)u.pm * 256 * LDA * 2; b = B + (size_t)u.pn * 256 * 1024 * 2; nt = 16;
    }
    static constexpr bool HAS_KEEP = false;
    __device__ __forceinline__ bool keep(const pg8::Unit&) const { return false; }
};
struct EpiG1 {
    static constexpr bool HAS_POST = false;
    bf16_t* proj; bf16_t* memkv; float* out;
    __device__ __forceinline__ void operator()(f32x4 (&acc)[2][2][4][2], const pg8::Unit& u, int wr, int wc, int fr, int fq) const {
        const int row0 = u.pm * 256 + wr * 64 + fr, col0 = u.pn * 256 + wc * 32 + 8 * fq;
        if (u.pn < 18) {
#pragma unroll
            for (int ai = 0; ai < 2; ++ai)
#pragma unroll
                for (int m = 0; m < 4; ++m) { bf16_t* rp = proj + (size_t)(row0 + ai * 128 + m * 16) * PLD + col0;
#pragma unroll
                    for (int bj = 0; bj < 2; ++bj) *(u32x4*)(rp + bj * 128) = pack8(acc[ai][bj][m][0], acc[ai][bj][m][1]); }
        } else {
            const int rr0 = row0 - HM0, cc0 = col0 - 4608;
#pragma unroll
            for (int ai = 0; ai < 2; ++ai)
#pragma unroll
                for (int m = 0; m < 4; ++m) { const int rr = rr0 + ai * 128 + m * 16;
#pragma unroll
                    for (int bj = 0; bj < 2; ++bj) { const int cc = cc0 + bj * 128;
                        *(u32x4*)(memkv + (size_t)rr * 1024 + cc) = pack8(acc[ai][bj][m][0], acc[ai][bj][m][1]);
                        float* op = out + (cc < 512 ? O_MKP + (size_t)rr * 512 + cc : O_MVP + (size_t)rr * 512 + (cc - 512));
                        *(f32x4*)op = acc[ai][bj][m][0]; *(f32x4*)(op + 4) = acc[ai][bj][m][1]; } }
        }
    }
};

struct SchedG3 {
    const char* A; const char* B; int G, c;
    __device__ __forceinline__ bool next(int i, pg8::Unit& u) const {
        const int r = i / 6, T = r * G + c; if (T >= 256) return false;
        const int xcd = T & 7, idx = T >> 3; u.pm = xcd * 8 + (idx >> 2); u.pn = idx & 3; u.sub = i - r * 6; return true;
    }
    __device__ __forceinline__ void ptrs(const pg8::Unit& u, const char*& a, const char*& b, int& nt) const {
        const int br = u.sub >> 1;
        const char* a0 = A + (size_t)u.pm * 256 * LDA * 2; const char* b0 = B + ((size_t)br * 1024 + (size_t)u.pn * 256) * 1536 * 2;
        if (u.sub & 1) { a = a0 + (A_YA + br * 512) * 2; b = b0 + 1024 * 2; nt = 8; } else { a = a0; b = b0; nt = 16; }
    }
    static constexpr bool HAS_KEEP = false;
    __device__ __forceinline__ bool keep(const pg8::Unit&) const { return false; }
};
__device__ __forceinline__ void unpack8(const u32x4 g, f32x4& g0, f32x4& g1) { g0 = (f32x4){bflo(g[0]), bfhi(g[0]), bflo(g[1]), bfhi(g[1])}; g1 = (f32x4){bflo(g[2]), bfhi(g[2]), bflo(g[3]), bfhi(g[3])}; }
struct EpiG3 {
    static constexpr bool HAS_POST = false;
    unsigned char* scr; bf16_t* merged; const float* b_gate;
    __device__ __forceinline__ void operator()(f32x4 (&acc)[2][2][4][2], const pg8::Unit& u, int wr, int wc, int fr, int fq) const {
        const int tid = threadIdx.x + opaque_zero();
        const int row0 = u.pm * 256 + wr * 64 + fr, col0 = u.pn * 256 + wc * 32 + 8 * fq + opaque_zero();
        const bool gate = (u.sub & 1) == 0; const int br = u.sub >> 1;
        GAS u32x4* s0 = (GAS u32x4*)scr + tid * 4;
        const int boff = 8192;
        const float* bp = b_gate + br * 1024 + col0;
        bf16_t* mp = merged + (size_t)row0 * 1024 + col0;
#pragma unroll
        for (int ai = 0; ai < 2; ++ai)
#pragma unroll
            for (int bj = 0; bj < 2; ++bj) {
                if (gate) {
                    const f32x4 b0 = *(const f32x4*)(bp + bj * 128), b1 = *(const f32x4*)(bp + bj * 128 + 4);
#pragma unroll
                    for (int m = 0; m < 4; ++m) { f32x4 g0, g1;
#pragma unroll
                        for (int e = 0; e < 4; ++e) { g0[e] = sigmoidf_(acc[ai][bj][m][0][e] + b0[e]); g1[e] = sigmoidf_(acc[ai][bj][m][1][e] + b1[e]); }
                        s0[boff + m] = pack8(g0, g1); }
                } else {
                    u32x4 gn[4], gm[4];
#pragma unroll
                    for (int m = 0; m < 4; ++m) { gn[m] = s0[boff + m]; gm[m] = gn[m]; }
                    if (br > 0) {
#pragma unroll
                        for (int m = 0; m < 4; ++m) gm[m] = s0[m];
                    }
#pragma unroll
                    for (int m = 0; m < 4; ++m) { f32x4 n0, n1, p0, p1; unpack8(gn[m], n0, n1); unpack8(gm[m], p0, p1);
                        f32x4 r0 = acc[ai][bj][m][0] * n0, r1 = acc[ai][bj][m][1] * n1;
                        if (br > 0) { r0 += p0; r1 += p1; }
                        const u32x4 pk = pack8(r0, r1);
                        if (br < 2) s0[m] = pk; else *(u32x4*)(mp + (size_t)(ai * 128 + m * 16) * 1024 + bj * 128) = pk; }
                }
                s0 += 2048; asm volatile("" : "+v"(s0)); __builtin_amdgcn_sched_barrier(0); }
    }
};

struct SchedG4 {
    const char* A; const char* B; int G, c;
    __device__ __forceinline__ bool next(int i, pg8::Unit& u) const {
        const int T = i * G + c; if (T >= 256) return false;
        const int xcd = T & 7, idx = T >> 3; u.pm = xcd * 8 + (idx >> 2); u.pn = idx & 3; u.sub = 0; return true;
    }
    __device__ __forceinline__ void ptrs(const pg8::Unit& u, const char*& a, const char*& b, int& nt) const {
        a = A + (size_t)u.pm * 256 * 1024 * 2; b = B + (size_t)u.pn * 256 * 1024 * 2; nt = 16;
    }
    static constexpr bool HAS_KEEP = false;
    __device__ __forceinline__ bool keep(const pg8::Unit&) const { return false; }
};
struct EpiG4 {
    static constexpr bool HAS_POST = true;
    const float* x; float* out; float* rowsq; const float* fg; unsigned* bar; unsigned epoch;
    __device__ __forceinline__ void operator()(f32x4 (&acc)[2][2][4][2], const pg8::Unit& u, int wr, int wc, int fr, int fq) const {
        const int row0 = u.pm * 256 + wr * 64 + fr + opaque_zero(), col0 = u.pn * 256 + wc * 32 + 8 * fq;
        const GAS float* xp = (const GAS float*)x + (size_t)row0 * 1024 + col0; float* rq = rowsq + row0;
#pragma unroll
        for (int ai = 0; ai < 2; ++ai) {
#pragma unroll
            for (int m = 0; m < 4; ++m) { float ss = 0.f;
#pragma unroll
                for (int bj = 0; bj < 2; ++bj) {
                    acc[ai][bj][m][0] += *(const GAS f32x4*)(xp + bj * 128); acc[ai][bj][m][1] += *(const GAS f32x4*)(xp + bj * 128 + 4);
#pragma unroll
                    for (int e = 0; e < 4; ++e) ss += acc[ai][bj][m][0][e] * acc[ai][bj][m][0][e] + acc[ai][bj][m][1][e] * acc[ai][bj][m][1][e]; }
                ss += __shfl_xor(ss, 16); ss += __shfl_xor(ss, 32);
                if (fq == 0) unsafeAtomicAdd(rq, ss);
                xp += 16 * 1024; rq += 16;
                if (m & 1) asm volatile("" : "+v"(xp), "+v"(rq)); }
            xp += 64 * 1024; rq += 64; }
    }
    __device__ __forceinline__ void post(f32x4 (&acc)[2][2][4][2], const pg8::Unit& u, int wr, int wc, int fr, int fq) const {
        fast_sync(bar, epoch);
        const int row0 = u.pm * 256 + wr * 64 + fr + opaque_zero(), col0 = u.pn * 256 + wc * 32 + 8 * fq;
        GAS float* op = (GAS float*)out + (size_t)row0 * 1024 + col0; const float* rq = rowsq + row0;
        f32x4 g[2][2];
#pragma unroll
        for (int bj = 0; bj < 2; ++bj) { g[bj][0] = *(const f32x4*)(fg + col0 + bj * 128); g[bj][1] = *(const f32x4*)(fg + col0 + bj * 128 + 4); }
#pragma unroll
        for (int ai = 0; ai < 2; ++ai) {
#pragma unroll
            for (int m = 0; m < 4; ++m) {
                const float rs = rsqrtf(__hip_atomic_load(rq, __ATOMIC_RELAXED, __HIP_MEMORY_SCOPE_AGENT) * (1.f / 1024.f) + EPS);
#pragma unroll
                for (int bj = 0; bj < 2; ++bj) { *(GAS f32x4*)(op + bj * 128) = acc[ai][bj][m][0] * rs * g[bj][0]; *(GAS f32x4*)(op + bj * 128 + 4) = acc[ai][bj][m][1] * rs * g[bj][1]; }
                op += 16 * 1024; rq += 16;
                if (m & 1) asm volatile("" : "+v"(op), "+v"(rq)); }
            op += 64 * 1024; rq += 64; }
    }
};

__device__ __forceinline__ void transpose_tile(const Params& p, LAS unsigned char* lds, int t) {
    const float* src; int sld, col0, ntn; bf16_t* dst; int dld;
    bf16_t* W1T = (bf16_t*)(p.ws + OFF_W1T); bf16_t* WG3 = (bf16_t*)(p.ws + OFF_WG3); bf16_t* WOUT = (bf16_t*)(p.ws + OFF_WOUT);
    if (t < 384) { src = p.w_in; sld = 7688; col0 = 0; ntn = 24; dst = W1T; dld = 1024; }
    else if (t < 1152) { t -= 384; src = p.w_in; sld = 7688; col0 = 1544; ntn = 48; dst = W1T + (size_t)1536 * 1024; dld = 1024; }
    else if (t < 1408) { t -= 1152; src = p.w_mem_kv; sld = 1024; col0 = 0; ntn = 16; dst = W1T + (size_t)4608 * 1024; dld = 1024; }
    else if (t < 2176) { t -= 1408; const int i = t >> 8; t &= 255; src = p.w_in; sld = 7688; col0 = 4616 + i * 1024; ntn = 16; dst = WG3 + (size_t)i * 1024 * 1536; dld = 1536; }
    else if (t < 2304) { t -= 2176; src = p.w_br_a; sld = 1024; col0 = 0; ntn = 16; dst = WG3 + 1024; dld = 1536; }
    else if (t < 2432) { t -= 2304; src = p.w_br_b; sld = 1024; col0 = 0; ntn = 16; dst = WG3 + (size_t)1 * 1024 * 1536 + 1024; dld = 1536; }
    else if (t < 2560) { t -= 2432; src = p.w_br_c; sld = 1024; col0 = 0; ntn = 16; dst = WG3 + (size_t)2 * 1024 * 1536 + 1024; dld = 1536; }
    else { t -= 2560; src = p.w_out; sld = 1024; col0 = 0; ntn = 16; dst = WOUT; dld = 1024; }
    const int k0 = (t / ntn) * 64, n0 = (t % ntn) * 64, tid = threadIdx.x;
    LAS float* tile = (LAS float*)lds;
    __syncthreads();
#pragma unroll
    for (int ps = 0; ps < 2; ++ps) { const int r = (tid >> 4) + ps * 32, c4 = (tid & 15) * 4;
        const f32x4 v = *(const f32x4*)(src + (size_t)(k0 + r) * sld + col0 + n0 + c4);
        tile[r * 65 + c4] = v[0]; tile[r * 65 + c4 + 1] = v[1]; tile[r * 65 + c4 + 2] = v[2]; tile[r * 65 + c4 + 3] = v[3]; }
    __syncthreads();
    const int n = tid >> 3, kc = (tid & 7) * 8;
    u32x4 o;
#pragma unroll
    for (int j = 0; j < 4; ++j) o[j] = cvt_pk_bf16(tile[(kc + 2 * j) * 65 + n], tile[(kc + 2 * j + 1) * 65 + n]);
    *(u32x4*)(dst + (size_t)(n0 + n) * dld + k0 + kc) = o;
}

static __device__ __forceinline__ void phase_prep(const Params& p, LAS unsigned char* lds) {
    const int tid = threadIdx.x, wg = blockIdx.x, G = gridDim.x, lane = tid & 63, wave = tid >> 6;
    float* rowsq = (float*)(p.ws + OFF_ROWSQ); unsigned* cnt = (unsigned*)(p.ws + OFF_CNT);
    for (int i = wg * 512 + tid; i < MROWS + 64; i += G * 512) { if (i < MROWS) rowsq[i] = 0.f; else cnt[i - MROWS] = 0u; }
    for (int t = wg; t < 2816; t += G) transpose_tile(p, lds, t);
    __syncthreads();
    LAS float* wb = (LAS float*)lds;
    for (int idx = tid; idx < 8192; idx += 512) { const int k = idx >> 3, j = idx & 7; wb[j * 1024 + k] = p.w_in[(size_t)k * 7688 + 1536 + j]; }
    __syncthreads();
    bf16_t* ACT = (bf16_t*)(p.ws + OFF_ACT); float* betag = (float*)(p.ws + OFF_BETAG);
    for (int row = wg * 8 + wave; row < 18560; row += G * 8) {
        const float* src; const float* gn; size_t drow;
        if (row < NP) { src = p.x_prompt + (size_t)row * 1024; gn = p.norm_g; drow = row; }
        else if (row < NP + NS) { src = p.x_sample + (size_t)(row - NP) * 1024; gn = p.norm_g; drow = row; }
        else { src = p.mem_prompt + (size_t)(row - NP - NS) * 1024; gn = p.mem_norm_g; drow = HM0 + (row - NP - NS); }
        f32x4 v[4]; float ss = 0.f;
#pragma unroll
        for (int q = 0; q < 4; ++q) { v[q] = *(const f32x4*)(src + q * 256 + lane * 4); ss += v[q][0] * v[q][0] + v[q][1] * v[q][1] + v[q][2] * v[q][2] + v[q][3] * v[q][3]; }
        ss = wave_sum(ss);
        const float rstd = rsqrtf(ss * (1.f / 1024.f) + EPS);
#pragma unroll
        for (int q = 0; q < 4; ++q) { const f32x4 g = *(const f32x4*)(gn + q * 256 + lane * 4); v[q] = v[q] * rstd * g;
            u32x2 o; o[0] = cvt_pk_bf16(v[q][0], v[q][1]); o[1] = cvt_pk_bf16(v[q][2], v[q][3]);
            *(u32x2*)(ACT + drow * LDA + q * 256 + lane * 4) = o; }
        if (row < NP + NS) {
            float d[8];
#pragma unroll
            for (int j = 0; j < 8; ++j) { float a = 0.f;
#pragma unroll
                for (int q = 0; q < 4; ++q) { const f32x4 w = *(const LAS f32x4*)(wb + j * 1024 + q * 256 + lane * 4); a += v[q][0] * w[0] + v[q][1] * w[1] + v[q][2] * w[2] + v[q][3] * w[3]; }
                d[j] = wave_sum(a); }
            float dl = d[0];
#pragma unroll
            for (int j = 1; j < 8; ++j) dl = (lane == j) ? d[j] : dl;
            if (lane < 4) betag[(size_t)row * 8 + lane] = sigmoidf_(dl);
            else if (lane < 8) { const int h = lane - 4; const float xx = dl + p.dt_bias[h]; const float sp = xx > 20.f ? xx : log1pf(expf(xx));
                betag[(size_t)row * 8 + lane] = -expf(p.a_log[h]) * sp; }
        }
    }
}

static __device__ __forceinline__ void delta_chunk_item(const Params& p, LAS unsigned char* lds, int ci) {
    const int tid = threadIdx.x, lane = tid & 63, wave = tid >> 6, l16 = lane & 15, quad = lane >> 4;
    const int bh = ci >> 5, n = ci & 31, b = bh >> 2, h = bh & 3;
    const bf16_t* PROJ = (const bf16_t*)(p.ws + OFF_PROJ); const float* betag = (const float*)(p.ws + OFF_BETAG);
    bf16_t* U = (bf16_t*)((unsigned char*)p.out + DO_U) + (size_t)ci * 8192; bf16_t* W = (bf16_t*)((unsigned char*)p.out + DO_W) + (size_t)ci * 8192;
    bf16_t* QD = (bf16_t*)((unsigned char*)p.out + DO_QD) + (size_t)ci * 8192; bf16_t* KDT = (bf16_t*)((unsigned char*)p.out + DO_KDT) + (size_t)ci * 8192;
    bf16_t* ATT = (bf16_t*)(p.ws + OFF_ATTN) + (size_t)ci * 4096; float* GL = (float*)(p.ws + OFF_GL);
    LAS bf16_t* Kb = (LAS bf16_t*)lds; LAS bf16_t* Qb = (LAS bf16_t*)(lds + 17408);
    LAS float* RHS = (LAS float*)(lds + 34816);
    LAS float* Lm = (LAS float*)(lds + 100352);
    LAS float* gcs = (LAS float*)(lds + 116736); LAS float* bts = gcs + 64;
    const int trow0 = b * 2048 + n * 64;
    __syncthreads();
    if (wave == 0) {
        float g = betag[(size_t)(trow0 + lane) * 8 + 4 + h];
#pragma unroll
        for (int o = 1; o < 64; o <<= 1) { const float t = __shfl_up(g, o); if (lane >= o) g += t; }
        gcs[lane] = g; bts[lane] = betag[(size_t)(trow0 + lane) * 8 + h];
        if (lane == 63) GL[ci] = __expf(g);
    }
    __syncthreads();
    {
        const int t = tid >> 3, cc = (tid & 7) * 16;
        const float gct = gcs[t], bet = bts[t], eg = __expf(gct);
#pragma unroll 1
        for (int sec = 0; sec < 3; ++sec) {
            const int col = sec * 512 + h * 128 + cc;
            float y[16];
#pragma unroll
            for (int e = 0; e < 16; ++e) y[e] = 0.f;
#pragma unroll
            for (int j = 0; j < 4; ++j) { const int tl = n * 64 + t - 3 + j;
                if (tl >= 0) { const bf16_t* rp = PROJ + (size_t)(b * 2048 + tl) * PLD + col; const u32x4 x0 = *(const u32x4*)rp, x1 = *(const u32x4*)(rp + 8);
                    const float* wp = p.conv_w + j * 1536 + col;
#pragma unroll
                    for (int e = 0; e < 4; ++e) { const f32x4 w = *(const f32x4*)(wp + e * 4); const unsigned ua = (e < 2 ? x0[2 * e] : x1[2 * e - 4]), ub = (e < 2 ? x0[2 * e + 1] : x1[2 * e - 3]);
                        y[e * 4] += bflo(ua) * w[0]; y[e * 4 + 1] += bfhi(ua) * w[1]; y[e * 4 + 2] += bflo(ub) * w[2]; y[e * 4 + 3] += bfhi(ub) * w[3]; } } }
            float ss = 0.f;
#pragma unroll
            for (int e = 0; e < 16; ++e) { y[e] = siluf_(y[e]); ss += y[e] * y[e]; }
            if (sec < 2) { ss += __shfl_xor(ss, 1); ss += __shfl_xor(ss, 2); ss += __shfl_xor(ss, 4);
                const float sc = rsqrtf(ss + EPS) * (sec == 0 ? 0.08838834764831845f : 1.f);
#pragma unroll
                for (int e = 0; e < 16; ++e) y[e] *= sc; }
            if (sec == 0) {
                u32x4 o0, o1, d0, d1;
#pragma unroll
                for (int e = 0; e < 4; ++e) { o0[e] = cvt_pk_bf16(y[2 * e], y[2 * e + 1]); o1[e] = cvt_pk_bf16(y[8 + 2 * e], y[9 + 2 * e]);
                    d0[e] = cvt_pk_bf16(y[2 * e] * eg, y[2 * e + 1] * eg); d1[e] = cvt_pk_bf16(y[8 + 2 * e] * eg, y[9 + 2 * e] * eg); }
                *(LAS u32x4*)(Qb + t * 136 + cc) = o0; *(LAS u32x4*)(Qb + t * 136 + cc + 8) = o1;
                *(u32x4*)(QD + t * 128 + cc) = d0; *(u32x4*)(QD + t * 128 + cc + 8) = d1;
            } else if (sec == 1) {
                u32x4 o0, o1;
#pragma unroll
                for (int e = 0; e < 4; ++e) { o0[e] = cvt_pk_bf16(y[2 * e], y[2 * e + 1]); o1[e] = cvt_pk_bf16(y[8 + 2 * e], y[9 + 2 * e]); }
                *(LAS u32x4*)(Kb + t * 136 + cc) = o0; *(LAS u32x4*)(Kb + t * 136 + cc + 8) = o1;
                const float s2 = bet * eg;
#pragma unroll
                for (int e = 0; e < 4; ++e) *(LAS f32x4*)(RHS + t * 256 + 128 + cc + e * 4) = (f32x4){y[e * 4] * s2, y[e * 4 + 1] * s2, y[e * 4 + 2] * s2, y[e * 4 + 3] * s2};
            } else {
#pragma unroll
                for (int e = 0; e < 4; ++e) *(LAS f32x4*)(RHS + t * 256 + cc + e * 4) = (f32x4){y[e * 4] * bet, y[e * 4 + 1] * bet, y[e * 4 + 2] * bet, y[e * 4 + 3] * bet};
            }
        }
    }
    __syncthreads();
    {
        const int sel = wave >> 2, it = wave & 3;
        LAS unsigned char* Xb = lds + (sel ? 17408 : 0);
        bf16x8 af[4];
#pragma unroll
        for (int ks = 0; ks < 4; ++ks) af[ks] = lds8(Xb, ((it * 16 + l16) * 136 + ks * 32 + quad * 8) * 2);
#pragma unroll
        for (int jt = 0; jt < 4; ++jt) {
            f32x4 a = {0.f, 0.f, 0.f, 0.f};
            if (jt <= it) {
#pragma unroll
                for (int ks = 0; ks < 4; ++ks) a = mfma16(af[ks], lds8(lds, ((jt * 16 + l16) * 136 + ks * 32 + quad * 8) * 2), a);
            }
            const int j = jt * 16 + l16; const float gj = gcs[j];
#pragma unroll
            for (int r = 0; r < 4; ++r) { const int i = it * 16 + quad * 4 + r;
                const float dec = (i >= j) ? __expf(gcs[i] - gj) : 0.f;
                if (sel == 0) Lm[i * 64 + j] = (i > j) ? bts[i] * a[r] * dec : 0.f;
                else ATT[i * 64 + j] = f2bf((i >= j) ? a[r] * dec : 0.f); }
        }
    }
    {
        const int d = tid >> 2, tq = (tid & 3) * 16; const float gl = gcs[63];
        u32x4 o0, o1;
#pragma unroll
        for (int e = 0; e < 8; ++e) { const int t0 = tq + 2 * e;
            const unsigned v = cvt_pk_bf16(bf2f(Kb[t0 * 136 + d]) * __expf(gl - gcs[t0]), bf2f(Kb[(t0 + 1) * 136 + d]) * __expf(gl - gcs[t0 + 1]));
            if (e < 4) o0[e] = v; else o1[e - 4] = v; }
        *(u32x4*)(KDT + d * 64 + tq) = o0; *(u32x4*)(KDT + d * 64 + tq + 8) = o1;
    }
    __syncthreads();
    if (wave < 4 && (p.mask & 32)) {
        const int col = tid;
        const LAS float* Lz = Lm + opaque_zero();
        float x[64];
#pragma unroll
        for (int i = 0; i < 64; ++i) {
            f32x4 lr[16];
#pragma unroll
            for (int j4 = 0; j4 < (i + 3) / 4; ++j4) lr[j4] = *(const LAS f32x4*)(Lz + i * 64 + j4 * 4);
            const float rcur = RHS[i * 256 + col];
            __builtin_amdgcn_sched_barrier(0);
            float s4[4] = {0.f, 0.f, 0.f, 0.f};
#pragma unroll
            for (int j4 = 0; j4 < (i + 3) / 4; ++j4) {
#pragma unroll
                for (int e = 0; e < 4; ++e) if (j4 * 4 + e < i) s4[e] += lr[j4][e] * x[j4 * 4 + e]; }
            x[i] = rcur - ((s4[0] + s4[1]) + (s4[2] + s4[3]));
            __builtin_amdgcn_sched_barrier(0);
        }
        bf16_t* dst = (col < 128) ? (U + col) : (W + (col - 128));
#pragma unroll
        for (int i = 0; i < 64; ++i) dst[i * 128] = f2bf(x[i]);
    }
}

static __device__ __forceinline__ void phase_delta_pre(const Params& p, LAS unsigned char* lds) {
    const int wg = blockIdx.x, G = gridDim.x, tid = threadIdx.x;
    const bf16_t* PROJ = (const bf16_t*)(p.ws + OFF_PROJ);
    for (int i = wg * 512 + tid; i < 8 * 3 * 1536; i += G * 512) { const int b = i / 4608, r = i % 4608, j = r / 1536, ch = r % 1536;
        p.out[O_SCP + i] = bf2f(PROJ[(size_t)(b * 2048 + 2045 + j) * PLD + ch]); }
    for (int ci = wg; ci < 1024; ci += G) delta_chunk_item(p, lds, ci);
}

struct ScanFr { bf16x8 w[4], qd[4], at[2], kd[2][2]; u32x2 u; };
__device__ __forceinline__ void scan_load(ScanFr& f, const Params& p, int ci, int vb, int vt, int tt, int dtb, int l16, int quad) {
    const bf16_t* U = (const bf16_t*)((const unsigned char*)p.out + DO_U) + (size_t)ci * 8192; const bf16_t* W = (const bf16_t*)((const unsigned char*)p.out + DO_W) + (size_t)ci * 8192;
    const bf16_t* QD = (const bf16_t*)((const unsigned char*)p.out + DO_QD) + (size_t)ci * 8192; const bf16_t* KDT = (const bf16_t*)((const unsigned char*)p.out + DO_KDT) + (size_t)ci * 8192;
    const bf16_t* ATT = (const bf16_t*)(p.ws + OFF_ATTN) + (size_t)ci * 4096;
#pragma unroll
    for (int ks = 0; ks < 4; ++ks) { f.w[ks] = ldg8(W + (tt * 16 + l16) * 128 + ks * 32 + quad * 8); f.qd[ks] = ldg8(QD + (tt * 16 + l16) * 128 + ks * 32 + quad * 8); }
#pragma unroll
    for (int ks = 0; ks < 2; ++ks) { f.at[ks] = ldg8(ATT + (tt * 16 + l16) * 64 + ks * 32 + quad * 8);
#pragma unroll
        for (int d = 0; d < 2; ++d) f.kd[d][ks] = ldg8(KDT + ((dtb + d) * 16 + l16) * 64 + ks * 32 + quad * 8); }
    f.u = *(const u32x2*)(U + (tt * 16 + l16) * 128 + vb * 32 + vt * 16 + quad * 4);
}
static __device__ __forceinline__ void scan_unit(const Params& p, LAS unsigned char* lds, int unit) {
    const int tid = threadIdx.x, lane = tid & 63, wave = tid >> 6, l16 = lane & 15, quad = lane >> 4;
    const int bh = unit >> 2, vb = unit & 3, b = bh >> 2, h = bh & 3;
    const int vt = wave & 1, tt = wave >> 1, dtb = (wave >> 1) * 2;
    LAS bf16_t* STs = (LAS bf16_t*)lds;
    LAS bf16_t* vnT = (LAS bf16_t*)(lds + 8704);
    bf16_t* PROJ = (bf16_t*)(p.ws + OFF_PROJ); const float* GL = (const float*)(p.ws + OFF_GL);
    __syncthreads();
    for (int i = tid; i < 32 * 136 / 2; i += 512) ((LAS unsigned*)STs)[i] = 0u;
    f32x4 accS[2] = {{0.f, 0.f, 0.f, 0.f}, {0.f, 0.f, 0.f, 0.f}};
    const int ci0 = bh * 32;
    const float glv = GL[ci0 + (lane & 31)];
    ScanFr cur, nxt;
    scan_load(cur, p, ci0, vb, vt, tt, dtb, l16, quad);
    nxt = cur;
    __syncthreads();
    for (int n = 0; n < 32; ++n) {
        if (n + 1 < 32) scan_load(nxt, p, ci0 + n + 1, vb, vt, tt, dtb, l16, quad);
        const float gl = __shfl(glv, n);
        f32x4 aW = {0.f, 0.f, 0.f, 0.f}, aQ = {0.f, 0.f, 0.f, 0.f};
#pragma unroll
        for (int ks = 0; ks < 4; ++ks) { const bf16x8 a = lds8(lds, ((vt * 16 + l16) * 136 + ks * 32 + quad * 8) * 2); aW = mfma16(a, cur.w[ks], aW); aQ = mfma16(a, cur.qd[ks], aQ); }
        const float u0 = bflo(cur.u[0]) - aW[0], u1 = bfhi(cur.u[0]) - aW[1], u2 = bflo(cur.u[1]) - aW[2], u3 = bfhi(cur.u[1]) - aW[3];
        vnT[(vt * 16 + quad * 4 + 0) * 72 + tt * 16 + l16] = f2bf(u0); vnT[(vt * 16 + quad * 4 + 1) * 72 + tt * 16 + l16] = f2bf(u1);
        vnT[(vt * 16 + quad * 4 + 2) * 72 + tt * 16 + l16] = f2bf(u2); vnT[(vt * 16 + quad * 4 + 3) * 72 + tt * 16 + l16] = f2bf(u3);
        asm volatile("s_waitcnt lgkmcnt(0)" ::: "memory"); __builtin_amdgcn_s_barrier(); asm volatile("" ::: "memory");
        accS[0] *= gl; accS[1] *= gl;
#pragma unroll
        for (int ks = 0; ks < 2; ++ks) { const bf16x8 a = lds8(lds, 8704 + ((vt * 16 + l16) * 72 + ks * 32 + quad * 8) * 2);
            aQ = mfma16(a, cur.at[ks], aQ); accS[0] = mfma16(a, cur.kd[0][ks], accS[0]); accS[1] = mfma16(a, cur.kd[1][ks], accS[1]); }
        { u32x2 o; o[0] = cvt_pk_bf16(aQ[0], aQ[1]); o[1] = cvt_pk_bf16(aQ[2], aQ[3]);
          *(u32x2*)(PROJ + (size_t)(b * 2048 + n * 64 + tt * 16 + l16) * PLD + C_AQ + h * 128 + vb * 32 + vt * 16 + quad * 4) = o; }
#pragma unroll
        for (int d = 0; d < 2; ++d)
#pragma unroll
            for (int r = 0; r < 4; ++r) STs[(vt * 16 + quad * 4 + r) * 136 + (dtb + d) * 16 + l16] = f2bf(accS[d][r]);
        asm volatile("s_waitcnt lgkmcnt(0)" ::: "memory"); __builtin_amdgcn_s_barrier(); asm volatile("" ::: "memory");
        cur = nxt;
    }
    float* sdp = p.out + O_SDP + (size_t)bh * 16384;
#pragma unroll
    for (int d = 0; d < 2; ++d) *(f32x4*)(sdp + (size_t)((dtb + d) * 16 + l16) * 128 + vb * 32 + vt * 16 + quad * 4) = accS[d];
}

static __device__ __forceinline__ void sample_delta_item(const Params& p, LAS unsigned char* lds, int it) {
    const int tid = threadIdx.x, b = it >> 2, h = it & 3;
    const bf16_t* PROJ = (const bf16_t*)(p.ws + OFF_PROJ); const float* betag = (const float*)(p.ws + OFF_BETAG); bf16_t* ACT = (bf16_t*)(p.ws + OFF_ACT);
    LAS float* qkv = (LAS float*)lds;
    LAS float* red = (LAS float*)(lds + 2048);
    LAS float* fin = (LAS float*)(lds + 2048 + 16384);
    LAS float* sc = (LAS float*)(lds + 2048 + 16384 + 1024);
    const size_t prow = (size_t)(NP + b) * PLD;
    __syncthreads();
    float yv = 0.f;
    if (tid < 384) { const int sec = tid >> 7, c = tid & 127, ch = sec * 512 + h * 128 + c;
        const float b0 = p.state_conv[(size_t)(b * 3 + 0) * 1536 + ch], b1 = p.state_conv[(size_t)(b * 3 + 1) * 1536 + ch], b2 = p.state_conv[(size_t)(b * 3 + 2) * 1536 + ch];
        const float xn = bf2f(PROJ[prow + ch]);
        float y = b0 * p.conv_w[ch] + b1 * p.conv_w[1536 + ch] + b2 * p.conv_w[3072 + ch] + xn * p.conv_w[4608 + ch];
        yv = siluf_(y);
        float* scs = p.out + O_SCS + (size_t)b * 4608;
        scs[ch] = b1; scs[1536 + ch] = b2; scs[3072 + ch] = xn;
    }
    {
        float ss = wave_sum(yv * yv);
        if ((tid & 63) == 0) sc[8 + (tid >> 6)] = ss;
    }
    __syncthreads();
    if (tid < 384) { const int sec = tid >> 7, c = tid & 127;
        float v = yv;
        if (sec == 0) v *= rsqrtf(sc[8] + sc[9] + EPS) * 0.08838834764831845f;
        else if (sec == 1) v *= rsqrtf(sc[10] + sc[11] + EPS);
        qkv[sec * 128 + c] = v; }
    __syncthreads();
    const int dvq = tid & 31, dkg = tid >> 5;
    const float* S0 = p.state_delta + (size_t)it * 16384;
    f32x4 s[8]; f32x4 pk = {0.f, 0.f, 0.f, 0.f}, pq = {0.f, 0.f, 0.f, 0.f};
#pragma unroll
    for (int j = 0; j < 8; ++j) { const int dk = dkg * 8 + j; s[j] = *(const f32x4*)(S0 + (size_t)dk * 128 + dvq * 4); pk += s[j] * qkv[128 + dk]; pq += s[j] * qkv[dk]; }
    *(LAS f32x4*)(red + dkg * 256 + dvq * 4) = pk; *(LAS f32x4*)(red + dkg * 256 + 128 + dvq * 4) = pq;
    {
        float qk = (tid < 128) ? qkv[tid] * qkv[128 + tid] : 0.f; qk = wave_sum(qk);
        if (tid < 128 && (tid & 63) == 0) sc[tid >> 6] = qk;
    }
    __syncthreads();
    const float beta = betag[(size_t)(NP + b) * 8 + h], a = __expf(betag[(size_t)(NP + b) * 8 + 4 + h]);
    if (tid < 128) { float sk = 0.f, sq = 0.f;
#pragma unroll
        for (int g = 0; g < 16; ++g) { sk += red[g * 256 + tid]; sq += red[g * 256 + 128 + tid]; }
        const float vn = beta * (qkv[256 + tid] - a * sk); const float o = a * sq + (sc[0] + sc[1]) * vn;
        fin[tid] = vn; fin[128 + tid] = o;
        const float oo = wave_sum(o * o); if ((tid & 63) == 0) sc[4 + (tid >> 6)] = oo; }
    __syncthreads();
    const f32x4 vn4 = *(const LAS f32x4*)(fin + dvq * 4);
    float* Sn = p.out + O_SDS + (size_t)it * 16384;
#pragma unroll
    for (int j = 0; j < 8; ++j) { const int dk = dkg * 8 + j; *(f32x4*)(Sn + (size_t)dk * 128 + dvq * 4) = s[j] * a + vn4 * qkv[128 + dk]; }
    if (tid < 128) { const float rstd = rsqrtf((sc[4] + sc[5]) * (1.f / 128.f) + EPS);
        const float gt = bf2f(PROJ[prow + C_AGATE + h * 128 + tid]);
        ACT[(size_t)(NP + b) * LDA + A_YA + h * 128 + tid] = f2bf(fin[128 + tid] * rstd * p.a_norm_g[tid] * siluf_(gt)); }
}

static __device__ __forceinline__ void sample_xattn_item(const Params& p, LAS unsigned char* lds, int it) {
    const int tid = threadIdx.x, lane = tid & 63, wave = tid >> 6, b = it >> 2, h = it & 3;
    const bf16_t* PROJ = (const bf16_t*)(p.ws + OFF_PROJ); bf16_t* ACT = (bf16_t*)(p.ws + OFF_ACT);
    LAS float* scr = (LAS float*)lds;
    LAS float* red = (LAS float*)(lds + 1024);
    const int half = lane >> 5, dl = lane & 31;
    const size_t prow = (size_t)(NP + b) * PLD;
    f32x4 q; { const bf16_t* qp = PROJ + prow + C_CQ + h * 128 + dl * 4; const u32x2 u = *(const u32x2*)qp; q = (f32x4){bflo(u[0]), bfhi(u[0]), bflo(u[1]), bfhi(u[1])}; }
    const float* Kp = p.cache_k + ((size_t)(b * 256) * 4 + h) * 128 + dl * 4; const float* Vp = p.cache_v + ((size_t)(b * 256) * 4 + h) * 128 + dl * 4;
    __syncthreads();
    f32x4 kv[16];
#pragma unroll
    for (int i = 0; i < 16; ++i) { const int m = wave * 32 + i * 2 + half; kv[i] = *(const f32x4*)(Kp + (size_t)m * 512); }
#pragma unroll
    for (int i = 0; i < 16; ++i) { float d = kv[i][0] * q[0] + kv[i][1] * q[1] + kv[i][2] * q[2] + kv[i][3] * q[3];
#pragma unroll
        for (int o = 16; o >= 1; o >>= 1) d += __shfl_xor(d, o);
        if (dl == 0) scr[wave * 32 + i * 2 + half] = d * 0.08838834764831845f; }
#pragma unroll
    for (int i = 0; i < 16; ++i) { const int m = wave * 32 + i * 2 + half; kv[i] = *(const f32x4*)(Vp + (size_t)m * 512); }
    __syncthreads();
    float mx = -3.0e38f;
#pragma unroll
    for (int i = 0; i < 4; ++i) mx = fmaxf(mx, scr[lane + 64 * i]);
#pragma unroll
    for (int o = 32; o >= 1; o >>= 1) mx = fmaxf(mx, __shfl_xor(mx, o));
    float sm = 0.f;
#pragma unroll
    for (int i = 0; i < 4; ++i) sm += __expf(scr[lane + 64 * i] - mx);
    sm = wave_sum(sm);
    const float inv = 1.f / sm;
    f32x4 o = {0.f, 0.f, 0.f, 0.f};
#pragma unroll
    for (int i = 0; i < 16; ++i) { const float pr = __expf(scr[wave * 32 + i * 2 + half] - mx) * inv; o += kv[i] * pr; }
    *(LAS f32x4*)(red + (wave * 2 + half) * 128 + dl * 4) = o;
    __syncthreads();
    if (tid < 128) { float s = 0.f;
#pragma unroll
        for (int g = 0; g < 16; ++g) s += red[g * 128 + tid];
        const float gt = bf2f(PROJ[prow + C_CGATE + h * 128 + tid]);
        ACT[(size_t)(NP + b) * LDA + A_YC + h * 128 + tid] = f2bf(s * siluf_(gt)); }
}

static __device__ __forceinline__ void sample_mlp_item(const Params& p, int it) {
    const int tid = threadIdx.x, lane = tid & 63, wave = tid >> 6, b = it * 8 + wave;
    const bf16_t* PROJ = (const bf16_t*)(p.ws + OFF_PROJ); bf16_t* ACT = (bf16_t*)(p.ws + OFF_ACT);
    const size_t prow = (size_t)(NP + b) * PLD; const int c0 = lane * 8;
    const u32x4 xv = *(const u32x4*)(PROJ + prow + C_BV + c0), xu = *(const u32x4*)(PROJ + prow + C_BU + c0), xg = *(const u32x4*)(PROJ + prow + C_BGATE + c0);
    float v[8], s1 = 0.f, s2 = 0.f;
#pragma unroll
    for (int e = 0; e < 4; ++e) { v[2 * e] = bflo(xv[e]); v[2 * e + 1] = bfhi(xv[e]); }
#pragma unroll
    for (int e = 0; e < 8; ++e) s1 += v[e];
    s1 = wave_sum(s1); const float mu = s1 * (1.f / 512.f);
#pragma unroll
    for (int e = 0; e < 8; ++e) { v[e] -= mu; s2 += v[e] * v[e]; }
    s2 = wave_sum(s2); const float rstd = rsqrtf(s2 * (1.f / 512.f) + EPS);
    const int g = c0 >> 7; const float w00 = p.w_spatial[(size_t)g * 16384], bs = p.b_spatial[g * 128];
    float* cvs = p.out + O_CVS + (size_t)b * 512 + c0;
    u32x4 o;
#pragma unroll
    for (int e = 0; e < 4; ++e) { float r[2];
#pragma unroll
        for (int z = 0; z < 2; ++z) { const int c = c0 + 2 * e + z; const float vn = v[2 * e + z] * rstd * p.ln_v_g[c] + p.ln_v_b[c]; cvs[2 * e + z] = vn;
            const float uu = z ? bfhi(xu[e]) : bflo(xu[e]), gg = z ? bfhi(xg[e]) : bflo(xg[e]); r[z] = uu * (w00 * vn + bs) * siluf_(gg); }
        o[e] = cvt_pk_bf16(r[0], r[1]); }
    *(u32x4*)(ACT + (size_t)(NP + b) * LDA + A_YB + c0) = o;
}

static __device__ __forceinline__ void mlp_item(const Params& p, LAS unsigned char* lds, int it) {
    const int tid = threadIdx.x, lane = tid & 63, wave = tid >> 6, l16 = lane & 15, quad = lane >> 4;
    const int row0 = (it >> 4) * 2048 + (it & 15) * 128;
    const bf16_t* PROJ = (const bf16_t*)(p.ws + OFF_PROJ); bf16_t* ACT = (bf16_t*)(p.ws + OFF_ACT);
    LAS bf16_t* vnT = (LAS bf16_t*)lds;
    LAS bf16_t* Wsm = (LAS bf16_t*)(lds + 34816);
    LAS float* st = (LAS float*)(lds + 69632);
    __syncthreads();
    { const int r = tid >> 2, part = tid & 3; const bf16_t* rp = PROJ + (size_t)(row0 + r) * PLD + C_BV + part * 128; float s1 = 0.f, s2 = 0.f;
#pragma unroll
      for (int i = 0; i < 16; ++i) { const u32x4 x = *(const u32x4*)(rp + i * 8);
#pragma unroll
          for (int e = 0; e < 4; ++e) { const float a = bflo(x[e]), c = bfhi(x[e]); s1 += a + c; s2 += a * a + c * c; } }
      s1 += __shfl_xor(s1, 1); s1 += __shfl_xor(s1, 2); s2 += __shfl_xor(s2, 1); s2 += __shfl_xor(s2, 2);
      const float mu = s1 * (1.f / 512.f); const float var = fmaxf(s2 * (1.f / 512.f) - mu * mu, 0.f);
      if (part == 0) { st[r * 2] = mu; st[r * 2 + 1] = rsqrtf(var + EPS); } }
    __syncthreads();
#pragma unroll 1
    for (int g = 0; g < 4; ++g) {
        { const int s = lane + 64 * (wave & 1), cq = (wave >> 1) * 32; const float mu = st[s * 2], rstd = st[s * 2 + 1];
          const bf16_t* rp = PROJ + (size_t)(row0 + s) * PLD + C_BV + g * 128 + cq;
#pragma unroll
          for (int i = 0; i < 4; ++i) { const u32x4 x = *(const u32x4*)(rp + i * 8);
#pragma unroll
              for (int e = 0; e < 4; ++e) { const int c = cq + i * 8 + 2 * e; const int gc = g * 128 + c;
                  vnT[c * 136 + s] = f2bf((bflo(x[e]) - mu) * rstd * p.ln_v_g[gc] + p.ln_v_b[gc]);
                  vnT[(c + 1) * 136 + s] = f2bf((bfhi(x[e]) - mu) * rstd * p.ln_v_g[gc + 1] + p.ln_v_b[gc + 1]); } }
          const int t = tid >> 2, sq = (tid & 3) * 32; const float* wp = p.w_spatial + ((size_t)g * 128 + t) * 128 + sq;
#pragma unroll
          for (int i = 0; i < 4; ++i) { const f32x4 w0 = *(const f32x4*)(wp + i * 8), w1 = *(const f32x4*)(wp + i * 8 + 4); const int s0 = sq + i * 8;
              f32x4 m0, m1;
#pragma unroll
              for (int e = 0; e < 4; ++e) { m0[e] = (s0 + e <= t) ? w0[e] : 0.f; m1[e] = (s0 + 4 + e <= t) ? w1[e] : 0.f; }
              *(LAS u32x4*)(Wsm + t * 136 + s0) = pack8(m0, m1); } }
        __syncthreads();
        f32x4 acc[8];
#pragma unroll
        for (int ct = 0; ct < 8; ++ct) acc[ct] = (f32x4){0.f, 0.f, 0.f, 0.f};
        const int nks = (wave >> 1) + 1;
        for (int ks = 0; ks < nks; ++ks) { const bf16x8 bw = lds8(lds, 34816 + ((wave * 16 + l16) * 136 + ks * 32 + quad * 8) * 2);
#pragma unroll
            for (int ct = 0; ct < 8; ++ct) acc[ct] = mfma16(lds8(lds, ((ct * 16 + l16) * 136 + ks * 32 + quad * 8) * 2), bw, acc[ct]); }
        const int t = wave * 16 + l16; const size_t prow = (size_t)(row0 + t) * PLD; const float bs = p.b_spatial[g * 128 + t];
#pragma unroll
        for (int ct = 0; ct < 8; ++ct) { const int col = g * 128 + ct * 16 + quad * 4;
            const u32x2 xu = *(const u32x2*)(PROJ + prow + C_BU + col), xg = *(const u32x2*)(PROJ + prow + C_BGATE + col);
            u32x2 o; o[0] = cvt_pk_bf16(bflo(xu[0]) * (acc[ct][0] + bs) * siluf_(bflo(xg[0])), bfhi(xu[0]) * (acc[ct][1] + bs) * siluf_(bfhi(xg[0])));
            o[1] = cvt_pk_bf16(bflo(xu[1]) * (acc[ct][2] + bs) * siluf_(bflo(xg[1])), bfhi(xu[1]) * (acc[ct][3] + bs) * siluf_(bfhi(xg[1])));
            *(u32x2*)(ACT + (size_t)(row0 + t) * LDA + A_YB + col) = o; }
        __syncthreads();
    }
}

static __device__ __forceinline__ void xattn_item(const Params& p, LAS unsigned char* lds, int it) {
    const int tid = threadIdx.x, lane = tid & 63, wave = tid >> 6, l16 = lane & 15, quad = lane >> 4;
    const int b = it >> 6, h = (it >> 4) & 3, qt = it & 15;
    const bf16_t* PROJ = (const bf16_t*)(p.ws + OFF_PROJ); bf16_t* ACT = (bf16_t*)(p.ws + OFF_ACT); const bf16_t* MKV = (const bf16_t*)(p.ws + OFF_MEMKV);
    LAS bf16_t* Ks = (LAS bf16_t*)lds;
    LAS bf16_t* Vt = (LAS bf16_t*)(lds + 69632);
    __syncthreads();
#pragma unroll
    for (int i = 0; i < 8; ++i) { const int idx = wave * 8 + i, m = (idx & 3) * 64 + lane, dc = (idx >> 2) * 8; const bf16_t* sp = MKV + (size_t)(b * 256 + m) * 1024 + h * 128 + dc;
        *(LAS u32x4*)(Ks + m * 136 + dc) = *(const u32x4*)sp;
        const u32x4 v = *(const u32x4*)(sp + 512);
#pragma unroll
        for (int e = 0; e < 4; ++e) { Vt[(dc + 2 * e) * 264 + m] = (bf16_t)(v[e] & 0xffffu); Vt[(dc + 2 * e + 1) * 264 + m] = (bf16_t)(v[e] >> 16); } }
    const int q0 = b * 2048 + qt * 128 + wave * 16; const size_t prow = (size_t)(q0 + l16) * PLD;
    bf16x8 qf[4];
#pragma unroll
    for (int ks = 0; ks < 4; ++ks) qf[ks] = ldg8(PROJ + prow + C_CQ + h * 128 + ks * 32 + quad * 8);
    __syncthreads();
    f32x4 s[16];
#pragma unroll
    for (int mt = 0; mt < 16; ++mt) { s[mt] = (f32x4){0.f, 0.f, 0.f, 0.f};
#pragma unroll
        for (int ks = 0; ks < 4; ++ks) s[mt] = mfma16(lds8(lds, ((mt * 16 + l16) * 136 + ks * 32 + quad * 8) * 2), qf[ks], s[mt]); }
    float mx = -3.0e38f;
#pragma unroll
    for (int mt = 0; mt < 16; ++mt)
#pragma unroll
        for (int r = 0; r < 4; ++r) mx = fmaxf(mx, s[mt][r]);
    mx = fmaxf(mx, __shfl_xor(mx, 16)); mx = fmaxf(mx, __shfl_xor(mx, 32));
    const float sc = 0.08838834764831845f * 1.4426950408889634f; float sm = 0.f;
#pragma unroll
    for (int mt = 0; mt < 16; ++mt)
#pragma unroll
        for (int r = 0; r < 4; ++r) { s[mt][r] = exp2f((s[mt][r] - mx) * sc); sm += s[mt][r]; }
    sm += __shfl_xor(sm, 16); sm += __shfl_xor(sm, 32);
    const float inv = 1.f / sm;
    bf16x8 pb[8];
#pragma unroll
    for (int ss = 0; ss < 8; ++ss) { const u32x4 pu = pack8(s[2 * ss], s[2 * ss + 1]); pb[ss] = __builtin_bit_cast(bf16x8, pu); }
#pragma unroll 1
    for (int dt = 0; dt < 8; ++dt) {
        f32x4 o = {0.f, 0.f, 0.f, 0.f};
#pragma unroll
        for (int ss = 0; ss < 8; ++ss) { const bf16x4 v0 = *(const LAS bf16x4*)(Vt + (dt * 16 + l16) * 264 + ss * 32 + quad * 4), v1 = *(const LAS bf16x4*)(Vt + (dt * 16 + l16) * 264 + ss * 32 + 16 + quad * 4);
            o = mfma16(__builtin_shufflevector(v0, v1, 0, 1, 2, 3, 4, 5, 6, 7), pb[ss], o); }
        const int col = h * 128 + dt * 16 + quad * 4; const u32x2 xg = *(const u32x2*)(PROJ + prow + C_CGATE + col);
        u32x2 w; w[0] = cvt_pk_bf16(o[0] * inv * siluf_(bflo(xg[0])), o[1] * inv * siluf_(bfhi(xg[0])));
        w[1] = cvt_pk_bf16(o[2] * inv * siluf_(bflo(xg[1])), o[3] * inv * siluf_(bfhi(xg[1])));
        *(u32x2*)(ACT + (size_t)(q0 + l16) * LDA + A_YC + col) = w;
        __builtin_amdgcn_sched_barrier(0); }
}

static __device__ __forceinline__ void phase_mixers(const Params& p, LAS unsigned char* lds) {
    const int wg = blockIdx.x, G = gridDim.x, tid = threadIdx.x;
    if (p.mask & 1) for (int u = wg; u < 128; u += G) scan_unit(p, lds, u);
    if (G > 128) { for (int it = wg - 128; it >= 0 && it < 128; it += G - 128) mlp_item(p, lds, it); }
    else { for (int it = wg; it < 128; it += G) mlp_item(p, lds, it); }
    unsigned* cnt = (unsigned*)(p.ws + OFF_CNT);
    LAS unsigned* slot = (LAS unsigned*)(lds + LDS_ITEM);
    for (;;) {
        __syncthreads();
        if (tid == 0) *slot = atomicAdd(cnt, 1u);
        __syncthreads();
        const int it = (int)*slot;
        if (it >= 1552) break;
        if (it < 512) xattn_item(p, lds, it);
        else if (it < 1024) sample_delta_item(p, lds, it - 512);
        else if (it < 1536) sample_xattn_item(p, lds, it - 1024);
        else sample_mlp_item(p, it - 1536);
    }
}

static __device__ __forceinline__ void phase_ya(const Params& p) {
    const int tid = threadIdx.x, lane = tid & 63, wave = tid >> 6;
    const bf16_t* PROJ = (const bf16_t*)(p.ws + OFF_PROJ); bf16_t* ACT = (bf16_t*)(p.ws + OFF_ACT);
    const int c0 = lane * 8, d0 = c0 & 127, nw = gridDim.x * 8;
    f32x4 ng0 = *(const f32x4*)(p.a_norm_g + d0), ng1 = *(const f32x4*)(p.a_norm_g + d0 + 4);
    for (int row0 = blockIdx.x * 8 + wave; row0 < NP; row0 += nw * 4) {
        u32x4 xo[4], xg[4];
#pragma unroll
        for (int k = 0; k < 4; ++k) { const int row = row0 + k * nw; if (row < NP) { const size_t prow = (size_t)row * PLD; xo[k] = *(const u32x4*)(PROJ + prow + C_AQ + c0); xg[k] = *(const u32x4*)(PROJ + prow + C_AGATE + c0); } }
#pragma unroll
        for (int k = 0; k < 4; ++k) { const int row = row0 + k * nw; if (row < NP) {
            float v[8], ss = 0.f;
#pragma unroll
            for (int e = 0; e < 4; ++e) { v[2 * e] = bflo(xo[k][e]); v[2 * e + 1] = bfhi(xo[k][e]); ss += v[2 * e] * v[2 * e] + v[2 * e + 1] * v[2 * e + 1]; }
            ss += __shfl_xor(ss, 1); ss += __shfl_xor(ss, 2); ss += __shfl_xor(ss, 4); ss += __shfl_xor(ss, 8);
            const float rstd = rsqrtf(ss * (1.f / 128.f) + EPS);
            u32x4 o;
#pragma unroll
            for (int e = 0; e < 4; ++e) { const float g0 = e < 2 ? ng0[2 * e] : ng1[2 * e - 4], g1 = e < 2 ? ng0[2 * e + 1] : ng1[2 * e - 3];
                o[e] = cvt_pk_bf16(v[2 * e] * rstd * g0 * siluf_(bflo(xg[k][e])), v[2 * e + 1] * rstd * g1 * siluf_(bfhi(xg[k][e]))); }
            *(u32x4*)(ACT + (size_t)row * LDA + A_YA + c0) = o; } }
    }
}

template <int NKS> __device__ __forceinline__ f32x4 small_gemm(const bf16_t* Wt, const bf16_t* A) {
    bf16x8 wv[NKS], av[NKS];
#pragma unroll
    for (int ks = 0; ks < NKS; ++ks) { wv[ks] = ldg8(Wt + ks * 32); av[ks] = ldg8(A + ks * 32); }
    f32x4 acc = {0.f, 0.f, 0.f, 0.f};
#pragma unroll
    for (int ks = 0; ks < NKS; ++ks) acc = mfma16(wv[ks], av[ks], acc);
    return acc;
}
static __device__ __forceinline__ void sample_g3(const Params& p, LAS unsigned char* lds) {
    const int tid = threadIdx.x, lane = tid & 63, wave = tid >> 6, l16 = lane & 15, quad = lane >> 4, c = blockIdx.x;
    const int ct = c >> 2, rt = 2 * (c & 3) + (wave >> 2), kp = wave & 3;
    const bf16_t* ACT = (const bf16_t*)(p.ws + OFF_ACT); const bf16_t* WG3 = (const bf16_t*)(p.ws + OFF_WG3); bf16_t* MERGED = (bf16_t*)(p.ws + OFF_MERGED);
    const int r = NP + rt * 16 + l16 + opaque_zero(), n0 = ct * 16;
    LAS f32x4* red = (LAS f32x4*)lds;
#pragma unroll
    for (int br = 0; br < 3; ++br) {
        const bf16_t* wrow = WG3 + ((size_t)br * 1024 + n0 + l16) * 1536 + quad * 8; const bf16_t* arow = ACT + (size_t)r * LDA + quad * 8;
        red[(wave * 6 + 2 * br) * 64 + lane] = small_gemm<8>(wrow + kp * 256, arow + kp * 256);
        red[(wave * 6 + 2 * br + 1) * 64 + lane] = small_gemm<4>(wrow + 1024 + kp * 128, arow + A_YA + br * 512 + kp * 128);
    }
    __syncthreads();
    if (kp == 0) {
        f32x4 m = {0.f, 0.f, 0.f, 0.f};
#pragma unroll
        for (int br = 0; br < 3; ++br) {
            f32x4 ag = {0.f, 0.f, 0.f, 0.f}, at = {0.f, 0.f, 0.f, 0.f};
#pragma unroll
            for (int k = 0; k < 4; ++k) { ag += red[((wave + k) * 6 + 2 * br) * 64 + lane]; at += red[((wave + k) * 6 + 2 * br + 1) * 64 + lane]; }
            const f32x4 bg = *(const f32x4*)(p.b_gate + br * 1024 + n0 + quad * 4);
#pragma unroll
            for (int e = 0; e < 4; ++e) m[e] += sigmoidf_(ag[e] + bg[e]) * at[e];
        }
        u32x2 o; o[0] = cvt_pk_bf16(m[0], m[1]); o[1] = cvt_pk_bf16(m[2], m[3]);
        *(u32x2*)(MERGED + (size_t)r * 1024 + n0 + quad * 4) = o;
    }
}
static __device__ __forceinline__ void sample_g4(const Params& p, LAS unsigned char* lds) {
    const int tid = threadIdx.x, lane = tid & 63, wave = tid >> 6, l16 = lane & 15, quad = lane >> 4, c = blockIdx.x;
    const int ct = c >> 2, rt = 2 * (c & 3) + (wave >> 2), kp = wave & 3;
    const bf16_t* WOUT = (const bf16_t*)(p.ws + OFF_WOUT); const bf16_t* MERGED = (const bf16_t*)(p.ws + OFF_MERGED); float* rowsq = (float*)(p.ws + OFF_ROWSQ);
    const int rs = rt * 16 + l16 + opaque_zero(), n0 = ct * 16;
    LAS f32x4* red = (LAS f32x4*)lds;
    red[wave * 64 + lane] = small_gemm<8>(WOUT + (size_t)(n0 + l16) * 1024 + quad * 8 + kp * 256, MERGED + (size_t)(NP + rs) * 1024 + quad * 8 + kp * 256);
    __syncthreads();
    if (kp == 0) {
        f32x4 a = red[wave * 64 + lane] + red[(wave + 1) * 64 + lane] + red[(wave + 2) * 64 + lane] + red[(wave + 3) * 64 + lane];
        const f32x4 v = *(const f32x4*)(p.x_sample + (size_t)rs * 1024 + n0 + quad * 4) + a;
        *(f32x4*)(p.out + O_YS + (size_t)rs * 1024 + n0 + quad * 4) = v;
        float ss = v[0] * v[0] + v[1] * v[1] + v[2] * v[2] + v[3] * v[3];
        ss += __shfl_xor(ss, 16); ss += __shfl_xor(ss, 32);
        if (quad == 0) unsafeAtomicAdd(rowsq + NP + rs, ss);
    }
}

static __device__ __forceinline__ void sample_g4_finish(const Params& p) {
    const int tid = threadIdx.x, lane = tid & 63, wave = tid >> 6, l16 = lane & 15, quad = lane >> 4, c = blockIdx.x;
    const int ct = c >> 2, rt = 2 * (c & 3) + (wave >> 2), kp = wave & 3;
    const float* rowsq = (const float*)(p.ws + OFF_ROWSQ);
    if (kp == 0) { const int rs = rt * 16 + l16, n0 = ct * 16; float* op = p.out + O_YS + (size_t)rs * 1024 + n0 + quad * 4;
        const float r = rsqrtf(__hip_atomic_load(rowsq + NP + rs, __ATOMIC_RELAXED, __HIP_MEMORY_SCOPE_AGENT) * (1.f / 1024.f) + EPS);
        *(f32x4*)op = *(const f32x4*)op * r * *(const f32x4*)(p.final_norm_g + n0 + quad * 4); }
}
static __device__ __forceinline__ void phase_final(const Params& p) {
    const float* rowsq = (const float*)(p.ws + OFF_ROWSQ);
    const int total4 = (NP + NS) * 256, stride = gridDim.x * 512;
    for (int base = blockIdx.x * 512 + threadIdx.x; base < total4; base += stride * 8) {
        f32x4 v[8]; float rs[8];
#pragma unroll
        for (int k = 0; k < 8; ++k) { const int i = base + k * stride; if (i < total4) { v[k] = *(const f32x4*)(p.out + (size_t)i * 4); rs[k] = rowsq[i >> 8]; } }
#pragma unroll
        for (int k = 0; k < 8; ++k) { const int i = base + k * stride; if (i < total4) { const f32x4 g = *(const f32x4*)(p.final_norm_g + (i & 255) * 4);
            *(f32x4*)(p.out + (size_t)i * 4) = v[k] * rsqrtf(rs[k] * (1.f / 1024.f) + EPS) * g; } }
    }
}

__global__ void __launch_bounds__(512, 2) fwd_megakernel(Params p) {
    extern __shared__ __attribute__((aligned(16))) unsigned char shm[];
    LAS unsigned char* lds = (LAS unsigned char*)shm;
    cg::grid_group grid = cg::this_grid();
    const int G = gridDim.x, c = blockIdx.x;
    unsigned* bar = (unsigned*)(p.ws + OFF_BAR); unsigned ep = 0u;
#define PH_BEGIN(k) if (p.ph_lo <= (k) && (k) < p.ph_hi) { if ((k) > p.ph_lo) { if ((k) == 1) grid_sync_all(grid); else fast_sync(bar, ++ep); }
#define PH_END }
#if !defined(ONLY_PH) || ONLY_PH == 0
    PH_BEGIN(0) phase_prep(p, lds); PH_END
#endif
#if !defined(ONLY_PH) || ONLY_PH == 1
    PH_BEGIN(1) { SchedG1 S{(const char*)(p.ws + OFF_ACT), (const char*)(p.ws + OFF_W1T), G, c};
                  EpiG1 E{(bf16_t*)(p.ws + OFF_PROJ), (bf16_t*)(p.ws + OFF_MEMKV), p.out};
                  pg8::gemm_phase(lds, LDA, 1024, S, E); } PH_END
#endif
#if !defined(ONLY_PH) || ONLY_PH == 2
    PH_BEGIN(2) phase_delta_pre(p, lds); PH_END
#endif
#if !defined(ONLY_PH) || ONLY_PH == 3
    PH_BEGIN(3) phase_mixers(p, lds); PH_END
#endif
#if !defined(ONLY_PH) || ONLY_PH == 4
    PH_BEGIN(4) phase_ya(p); PH_END
#endif
#if !defined(ONLY_PH) || ONLY_PH == 5
    PH_BEGIN(5) { SchedG3 S{(const char*)(p.ws + OFF_ACT), (const char*)(p.ws + OFF_WG3), G, c};
                  EpiG3 E{p.ws + OFF_PROJ + (size_t)c * SCR_PER_WG, (bf16_t*)(p.ws + OFF_MERGED), p.b_gate};
                  pg8::gemm_phase(lds, LDA, 1536, S, E);
                  sample_g3(p, lds); } PH_END
#endif
#if !defined(ONLY_PH) || ONLY_PH == 6
    PH_BEGIN(6) { sample_g4(p, lds); __syncthreads();
                  SchedG4 S{(const char*)(p.ws + OFF_MERGED), (const char*)(p.ws + OFF_WOUT), G, c};
                  EpiG4 E{p.x_prompt, p.out, (float*)(p.ws + OFF_ROWSQ), p.final_norm_g, bar, ep + 1u};
                  pg8::gemm_phase(lds, 1024, 1024, S, E);
                  sample_g4_finish(p); } PH_END
#endif
#if !defined(ONLY_PH) || ONLY_PH == 7
#endif
}

extern "C" void kernel_launch(void* const* d_in, const int* in_sizes, int n_in, void* d_out, int out_size, void* d_ws, size_t ws_size, hipStream_t stream) {
    static int grid_blocks = 0;
    if (grid_blocks == 0) {
        if (n_in != 25 || ws_size < WS_END) { fprintf(stderr, "kernel_launch: unexpected n_in %d / ws_size %zu (need %zu)\n", n_in, ws_size, (size_t)WS_END); grid_blocks = -1; return; }
        int dev = 0, cus = 0, per_cu = 0;
        hipGetDevice(&dev);
        hipDeviceGetAttribute(&cus, hipDeviceAttributeMultiprocessorCount, dev);
        if (hipFuncSetAttribute((const void*)fwd_megakernel, hipFuncAttributeMaxDynamicSharedMemorySize, LDS_BYTES) != hipSuccess) { fprintf(stderr, "kernel_launch: hipFuncSetAttribute failed\n"); }
        if (hipOccupancyMaxActiveBlocksPerMultiprocessor(&per_cu, fwd_megakernel, 512, LDS_BYTES) != hipSuccess || per_cu < 1) { fprintf(stderr, "kernel_launch: occupancy query gave %d\n", per_cu); per_cu = 1; }
        (void)hipGetLastError();
        grid_blocks = cus * per_cu; if (grid_blocks > 256) grid_blocks = 256;
        if (grid_blocks != 256) { fprintf(stderr, "kernel_launch: this build needs exactly 256 co-resident workgroups (one output tile each in the fused out-projection epilogue); got %d\n", grid_blocks); grid_blocks = -1; return; }
    }
    if (grid_blocks < 0) return;
    Params p{};
    const float** f = (const float**)&p;
    for (int i = 0; i < 25; ++i) f[i] = (const float*)d_in[i];
    p.out = (float*)d_out; p.ws = (unsigned char*)d_ws; p.ph_lo = 0; p.ph_hi = 8; p.mask = 0xff;
    hipMemsetAsync((char*)d_ws + OFF_BAR, 0, 9 * 256, stream);
    void* args[] = {&p};
    hipError_t e = hipLaunchCooperativeKernel((const void*)fwd_megakernel, dim3(grid_blocks), dim3(512), args, LDS_BYTES, stream);
    if (e != hipSuccess) fprintf(stderr, "cooperative launch failed: %s (grid %d)\n", hipGetErrorString(e), grid_blocks);
}
```

```cpp
#include <hip/hip_runtime.h>
#include <hip/hip_cooperative_groups.h>
#include <cstdio>
namespace cg = cooperative_groups;

#define LAS __attribute__((address_space(3)))
#define GAS __attribute__((address_space(1)))
typedef unsigned short bf16_t;
typedef short bf16x8 __attribute__((ext_vector_type(8)));
typedef short bf16x4 __attribute__((ext_vector_type(4)));
typedef float f32x4 __attribute__((ext_vector_type(4)));
typedef unsigned u32x4 __attribute__((ext_vector_type(4)));
typedef unsigned u32x2 __attribute__((ext_vector_type(2)));

constexpr int NP = 16384, NS = 128, MROWS = 16640, HM0 = 16640, LDA = 2560, PLD = 4608;
constexpr int C_AQ = 0, C_AK = 512, C_AV = 1024, C_AGATE = 1536, C_BU = 2048, C_BV = 2560, C_BGATE = 3072, C_CQ = 3584, C_CGATE = 4096;
constexpr int A_H = 0, A_YA = 1024, A_YB = 1536, A_YC = 2048;
constexpr float EPS = 1e-6f;
constexpr size_t OFF_W1T = 0;
constexpr size_t OFF_WG3 = 11534336;
constexpr size_t OFF_WOUT = 20971520;
constexpr size_t OFF_ACT = 23068672;
constexpr size_t OFF_PROJ = 118751232;
constexpr size_t OFF_ATTN = 272105472;
constexpr size_t OFF_MEMKV = 280494080;
constexpr size_t OFF_BETAG = 284688384;
constexpr size_t OFF_ROWSQ = 285216768;
constexpr size_t OFF_GL = 285283328;
constexpr size_t OFF_CNT = 285287424;
constexpr size_t OFF_BAR = 285287680;
constexpr size_t WS_END = 285290240;
constexpr size_t SCR_PER_WG = 262144;
constexpr size_t OFF_MERGED = OFF_PROJ + 256 * SCR_PER_WG;
constexpr size_t DO_U = 0, DO_W = 16777216, DO_QD = 33554432, DO_KDT = 50331648;
constexpr size_t O_YS = 16777216, O_SDP = 16908288, O_SCP = 17432576, O_MKP = 17469440, O_MVP = 18518016, O_SDS = 19566592, O_SCS = 27955200, O_CVS = 28545024;
constexpr int LDS_BYTES = 143360;
constexpr int LDS_ITEM = 143344;

struct Params {
    const float *x_prompt, *x_sample, *cache_k, *cache_v, *state_delta, *state_conv, *mem_prompt, *norm_g, *w_in, *conv_w, *a_log, *dt_bias, *a_norm_g,
        *ln_v_g, *ln_v_b, *w_spatial, *b_spatial, *mem_norm_g, *w_mem_kv, *w_br_a, *w_br_b, *w_br_c, *b_gate, *w_out, *final_norm_g;
    float* out;
    unsigned char* ws;
    int ph_lo, ph_hi, mask, pad_;
};

typedef __bf16 bf16v2_t __attribute__((ext_vector_type(2)));
__device__ __forceinline__ unsigned cvt_pk_bf16(float lo, float hi) { bf16v2_t v; v[0] = (__bf16)lo; v[1] = (__bf16)hi; return __builtin_bit_cast(unsigned, v); }
__device__ __forceinline__ bf16_t f2bf(float f) { return (bf16_t)(cvt_pk_bf16(f, 0.f) & 0xffffu); }
__device__ __forceinline__ float bf2f(bf16_t b) { return __uint_as_float(((unsigned)b) << 16); }
__device__ __forceinline__ float bflo(unsigned u) { return __uint_as_float(u << 16); }
__device__ __forceinline__ float bfhi(unsigned u) { return __uint_as_float(u & 0xffff0000u); }
__device__ __forceinline__ float sigmoidf_(float x) { return __builtin_amdgcn_rcpf(1.f + __expf(-x)); }
__device__ __forceinline__ float siluf_(float x) { return x * __builtin_amdgcn_rcpf(1.f + __expf(-x)); }
__device__ __forceinline__ float wave_sum(float v) {
#pragma unroll
    for (int o = 32; o >= 1; o >>= 1) v += __shfl_xor(v, o);
    return v;
}
__device__ __forceinline__ int opaque_zero() { int z; asm volatile("v_mov_b32 %0, 0" : "=v"(z)); return z; }
__device__ __forceinline__ f32x4 mfma16(bf16x8 a, bf16x8 b, f32x4 c) { return __builtin_amdgcn_mfma_f32_16x16x32_bf16(a, b, c, 0, 0, 0); }
__device__ __forceinline__ bf16x8 ldg8(const bf16_t* p) { return *(const bf16x8*)p; }
__device__ __forceinline__ bf16x8 lds8(LAS unsigned char* l, int off) { return *(const LAS bf16x8*)(l + off); }
__device__ __forceinline__ u32x4 pack8(f32x4 a, f32x4 b) { u32x4 r; r[0] = cvt_pk_bf16(a[0], a[1]); r[1] = cvt_pk_bf16(a[2], a[3]); r[2] = cvt_pk_bf16(b[0], b[1]); r[3] = cvt_pk_bf16(b[2], b[3]); return r; }

__device__ __forceinline__ void grid_sync_all(cg::grid_group& grid) {
    asm volatile("s_waitcnt vmcnt(0)" ::: "memory");
    grid.sync();
    if (threadIdx.x < 64) { __builtin_amdgcn_fence(__ATOMIC_ACQUIRE, "agent"); asm volatile("s_waitcnt vmcnt(0)" ::: "memory"); }
    __syncthreads();
}

__device__ __forceinline__ void fast_sync(unsigned* bar, unsigned epoch) {
    asm volatile("s_waitcnt vmcnt(0)" ::: "memory");
    __syncthreads();
    if (threadIdx.x == 0) {
        __builtin_amdgcn_fence(__ATOMIC_RELEASE, "agent"); asm volatile("s_waitcnt vmcnt(0)" ::: "memory");
        const unsigned g = blockIdx.x & 7u, ng = (gridDim.x - g + 7u) / 8u, ngroups = gridDim.x < 8u ? gridDim.x : 8u;
        const unsigned old = __hip_atomic_fetch_add(bar + g * 64, 1u, __ATOMIC_RELAXED, __HIP_MEMORY_SCOPE_AGENT);
        if (old + 1u == epoch * ng) __hip_atomic_fetch_add(bar + 8 * 64, 1u, __ATOMIC_RELAXED, __HIP_MEMORY_SCOPE_AGENT);
        while (__hip_atomic_load(bar + 8 * 64, __ATOMIC_RELAXED, __HIP_MEMORY_SCOPE_AGENT) < epoch * ngroups) __builtin_amdgcn_s_sleep(1);
        __builtin_amdgcn_fence(__ATOMIC_ACQUIRE, "agent"); asm volatile("s_waitcnt vmcnt(0)" ::: "memory");
    }
    __syncthreads();
}

namespace pg8 {
constexpr int BM = 256, BK = 64, HALF = 128, HTB = HALF * BK * 2, STAGE_BYTES = 8 * HTB;
__device__ __forceinline__ int lds_byte(int r, int c) { const int st = (r >> 4) * 2 + (c >> 5), rr = r & 15, cc = c & 31, ob = rr * 64 + cc * 2; return st * 1024 + (ob ^ (((ob >> 9) & 1) << 5)); }
__device__ __forceinline__ void stage_rc(int b, int& R, int& C) { const int st = b / 1024, sb = b % 1024, swz = sb ^ (((sb >> 9) & 1) << 5); R = (st >> 1) * 16 + swz / 64; C = (st & 1) * 32 + (swz % 64) / 2; }
__device__ __forceinline__ int perm32(int rho) { const int n = rho >> 4, i = rho & 15; return 8 * (i >> 2) + 4 * n + (i & 3); }
struct Unit { int pm, pn, sub; };

template <class Epi, class Sched>
__device__ __forceinline__ void gemm_phase(LAS unsigned char* lds, const int lda, const int ldb, const Sched& S, const Epi& E) {
    const int tid = threadIdx.x, wid = __builtin_amdgcn_readfirstlane(tid >> 6), lane = tid & 63, wr = wid >> 2, wc = wid & 3, fr = lane & 15, fq = lane >> 4;
    unsigned voffA[2], voffB[2];
#pragma unroll
    for (int i = 0; i < 2; ++i) { int R, C; stage_rc(tid * 16 + i * 8192, R, C); const int Rb = (R & ~31) + perm32(R & 31);
        voffA[i] = (unsigned)(R * lda + C) * 2u; voffB[i] = (unsigned)(Rb * ldb + C) * 2u; }
    const size_t kstep = (size_t)(BK * 2);
    const size_t hstepA = (size_t)HALF * lda * 2, hstepB = (size_t)HALF * ldb * 2;
    const unsigned ldsw = (unsigned)wid * 1024u;
    const int aoff = lds_byte(wr * 64 + fr, fq * 8), boff = lds_byte(wc * 32 + fr, fq * 8);
#define PG8_SA(b, h) (((b) * 2 + (h)) * HTB)
#define PG8_SB(b, h) ((4 + (b) * 2 + (h)) * HTB)
#define PG8_STAGE(bufoff, gbase, voff) do { _Pragma("unroll") for (int _i = 0; _i < 2; ++_i) \
        __builtin_amdgcn_global_load_lds((const unsigned*)((const char*)(gbase) + (voff)[_i]), (LAS unsigned*)(lds + (bufoff) + ldsw + _i * 8192), 16, 0, 0); } while (0)
#define PG8_LDA(dst, b, h) do { _Pragma("unroll") for (int m = 0; m < 4; ++m) _Pragma("unroll") for (int k = 0; k < 2; ++k) dst[m][k] = *(const LAS bf16x8*)(lds + PG8_SA(b, h) + aoff + m * 2048 + k * 1024); } while (0)
#define PG8_LDB(dst, b, h) do { _Pragma("unroll") for (int n = 0; n < 2; ++n) _Pragma("unroll") for (int k = 0; k < 2; ++k) dst[n][k] = *(const LAS bf16x8*)(lds + PG8_SB(b, h) + boff + n * 2048 + k * 1024); } while (0)
#define PG8_MMA(ai, bj, At, Bt) do { __builtin_amdgcn_s_setprio(1); _Pragma("unroll") for (int m = 0; m < 4; ++m) _Pragma("unroll") for (int n = 0; n < 2; ++n) _Pragma("unroll") for (int k = 0; k < 2; ++k) \
        acc[ai][bj][m][n] = __builtin_amdgcn_mfma_f32_16x16x32_bf16(Bt[n][k], At[m][k], acc[ai][bj][m][n], 0, 0, 0); __builtin_amdgcn_s_setprio(0); } while (0)
#define PG8_WAIT_V(n) asm volatile("s_waitcnt vmcnt(" #n ")" ::: "memory")
#define PG8_WAIT_L(n) asm volatile("s_waitcnt lgkmcnt(" #n ")" ::: "memory")
#define PG8_BAR __builtin_amdgcn_s_barrier()
#define PG8_SCHED __builtin_amdgcn_sched_barrier(0)
    Unit cur, nxt; int ui = 0;
    if (!S.next(0, cur)) return;
    f32x4 acc[2][2][4][2];
    bf16x8 At[4][2], B0[2][2], B1[2][2];
    const char* cA; const char* cB; int nt;
    S.ptrs(cur, cA, cB, nt);
    PG8_STAGE(PG8_SB(0, 0), cB, voffB); PG8_STAGE(PG8_SA(0, 0), cA, voffA); PG8_STAGE(PG8_SB(0, 1), cB + hstepB, voffB); PG8_STAGE(PG8_SA(0, 1), cA + hstepA, voffA);
    if (wr == 1) PG8_BAR;
    PG8_WAIT_V(4); PG8_BAR;
    PG8_STAGE(PG8_SB(1, 0), cB + kstep, voffB); PG8_STAGE(PG8_SA(1, 0), cA + kstep, voffA); PG8_STAGE(PG8_SB(1, 1), cB + hstepB + kstep, voffB);
    PG8_WAIT_V(6); PG8_BAR;
    PG8_SCHED;
#pragma unroll
    for (int a = 0; a < 2; ++a)
#pragma unroll
        for (int b = 0; b < 2; ++b)
#pragma unroll
            for (int m = 0; m < 4; ++m)
#pragma unroll
                for (int n = 0; n < 2; ++n) acc[a][b][m][n] = (f32x4){0.f, 0.f, 0.f, 0.f};
    for (;;) {
        const bool has_next = S.next(ui + 1, nxt);
        const char* nA = cA; const char* nB = cB; int nnt = nt;
        if (has_next) S.ptrs(nxt, nA, nB, nnt);
        for (int t = 0; t < nt; t += 2) {
            const bool last = (t == nt - 2);
            const char* a1 = cA + (size_t)(t + 1) * kstep;
            const char* a2 = last ? nA : cA + (size_t)(t + 2) * kstep; const char* b2 = last ? nB : cB + (size_t)(t + 2) * kstep;
            const char* a3 = a2 + kstep; const char* b3 = b2 + kstep;
            PG8_LDB(B0, 0, 0); PG8_SCHED; PG8_LDA(At, 0, 0); PG8_STAGE(PG8_SA(1, 1), a1 + hstepA, voffA);
            PG8_WAIT_L(8); PG8_BAR; PG8_WAIT_L(0); PG8_MMA(0, 0, At, B0); PG8_BAR; PG8_SCHED;
            PG8_LDB(B1, 0, 1); PG8_STAGE(PG8_SB(0, 0), b2, voffB);
            PG8_BAR; PG8_WAIT_L(0); PG8_MMA(0, 1, At, B1); PG8_BAR;
            PG8_LDA(At, 0, 1); PG8_STAGE(PG8_SA(0, 0), a2, voffA);
            PG8_BAR; PG8_WAIT_L(0); PG8_MMA(1, 0, At, B0); PG8_BAR; PG8_SCHED;
            PG8_STAGE(PG8_SB(0, 1), b2 + hstepB, voffB);
            PG8_WAIT_V(6); PG8_BAR; PG8_MMA(1, 1, At, B1); PG8_BAR;
            PG8_LDB(B0, 1, 0); PG8_SCHED; PG8_LDA(At, 1, 0); PG8_STAGE(PG8_SA(0, 1), a2 + hstepA, voffA);
            PG8_WAIT_L(8); PG8_BAR; PG8_WAIT_L(0); PG8_MMA(0, 0, At, B0); PG8_BAR; PG8_SCHED;
            PG8_LDB(B1, 1, 1); PG8_STAGE(PG8_SB(1, 0), b3, voffB);
            PG8_BAR; PG8_WAIT_L(0); PG8_MMA(0, 1, At, B1); PG8_BAR;
            PG8_LDA(At, 1, 1); PG8_STAGE(PG8_SA(1, 0), a3, voffA);
            PG8_BAR; PG8_WAIT_L(0); PG8_MMA(1, 0, At, B0); PG8_BAR; PG8_SCHED;
            PG8_STAGE(PG8_SB(1, 1), b3 + hstepB, voffB);
            PG8_WAIT_V(6); PG8_BAR; PG8_MMA(1, 1, At, B1); PG8_BAR;
        }
        __builtin_amdgcn_sched_barrier(0);
        E(acc, cur, wr, wc, fr, fq);
        __builtin_amdgcn_sched_barrier(0);
        if (!has_next) break;
        const float kf = S.keep(cur) ? 1.f : 0.f;
#pragma unroll
        for (int a = 0; a < 2; ++a)
#pragma unroll
            for (int b = 0; b < 2; ++b)
#pragma unroll
                for (int m = 0; m < 4; ++m)
#pragma unroll
                    for (int n = 0; n < 2; ++n) { if constexpr (Sched::HAS_KEEP) acc[a][b][m][n] *= kf; else acc[a][b][m][n] = (f32x4){0.f, 0.f, 0.f, 0.f}; }
        cur = nxt; cA = nA; cB = nB; nt = nnt; ++ui;
    }
    PG8_WAIT_V(0);
    if (wr == 0) PG8_BAR;
    PG8_BAR;
    if constexpr (Epi::HAS_POST) E.post(acc, cur, wr, wc, fr, fq);
#undef PG8_SA
#undef PG8_SB
#undef PG8_STAGE
#undef PG8_LDA
#undef PG8_LDB
#undef PG8_MMA
#undef PG8_WAIT_V
#undef PG8_WAIT_L
#undef PG8_BAR
#undef PG8_SCHED
}
}

struct SchedG1 {
    const char* A; const char* B; int G, c;
    __device__ __forceinline__ bool next(int i, pg8::Unit& u) const {
        const int L = i * G + c; if (L >= 1202) return false;
        if (L < 1170) {
            const int nM = 65, nN = 18, nwg = 1170;
            int wgid = L; { const int q = nwg / 8, r = nwg % 8, xcd = wgid % 8, off = wgid / 8; wgid = (xcd < r ? xcd * (q + 1) : r * (q + 1) + (xcd - r) * q) + off; }
            const int nig = 8 * nN, gid = wgid / nig, fm = gid * 8, gsz = (nM - fm) < 8 ? (nM - fm) : 8;
            u.pm = fm + ((wgid % nig) % gsz); u.pn = (wgid % nig) / gsz;
        } else { const int l2 = L - 1170; u.pm = 65 + (l2 >> 2); u.pn = 18 + (l2 & 3); }
        u.sub = 0; return true;
    }
    __device__ __forceinline__ void ptrs(const pg8::Unit& u, const char*& a, const char*& b, int& nt) const {
        a = A + (size_t)u.pm * 256 * LDA * 2; b = B + (size_t)u.pn * 256 * 1024 * 2; nt = 16;
    }
    static constexpr bool HAS_KEEP = false;
    __device__ __forceinline__ bool keep(const pg8::Unit&) const { return false; }
};
struct EpiG1 {
    static constexpr bool HAS_POST = false;
    bf16_t* proj; bf16_t* memkv; float* out;
    __device__ __forceinline__ void operator()(f32x4 (&acc)[2][2][4][2], const pg8::Unit& u, int wr, int wc, int fr, int fq) const {
        const int row0 = u.pm * 256 + wr * 64 + fr, col0 = u.pn * 256 + wc * 32 + 8 * fq;
        if (u.pn < 18) {
#pragma unroll
            for (int ai = 0; ai < 2; ++ai)
#pragma unroll
                for (int m = 0; m < 4; ++m) { bf16_t* rp = proj + (size_t)(row0 + ai * 128 + m * 16) * PLD + col0;
#pragma unroll
                    for (int bj = 0; bj < 2; ++bj) *(u32x4*)(rp + bj * 128) = pack8(acc[ai][bj][m][0], acc[ai][bj][m][1]); }
        } else {
            const int rr0 = row0 - HM0, cc0 = col0 - 4608;
#pragma unroll
            for (int ai = 0; ai < 2; ++ai)
#pragma unroll
                for (int m = 0; m < 4; ++m) { const int rr = rr0 + ai * 128 + m * 16;
#pragma unroll
                    for (int bj = 0; bj < 2; ++bj) { const int cc = cc0 + bj * 128;
                        *(u32x4*)(memkv + (size_t)rr * 1024 + cc) = pack8(acc[ai][bj][m][0], acc[ai][bj][m][1]);
                        float* op = out + (cc < 512 ? O_MKP + (size_t)rr * 512 + cc : O_MVP + (size_t)rr * 512 + (cc - 512));
                        *(f32x4*)op = acc[ai][bj][m][0]; *(f32x4*)(op + 4) = acc[ai][bj][m][1]; } }
        }
    }
};

struct SchedG3 {
    const char* A; const char* B; int G, c;
    __device__ __forceinline__ bool next(int i, pg8::Unit& u) const {
        const int r = i / 6, T = r * G + c; if (T >= 256) return false;
        const int xcd = T & 7, idx = T >> 3; u.pm = xcd * 8 + (idx >> 2); u.pn = idx & 3; u.sub = i - r * 6; return true;
    }
    __device__ __forceinline__ void ptrs(const pg8::Unit& u, const char*& a, const char*& b, int& nt) const {
        const int br = u.sub >> 1;
        const char* a0 = A + (size_t)u.pm * 256 * LDA * 2; const char* b0 = B + ((size_t)br * 1024 + (size_t)u.pn * 256) * 1536 * 2;
        if (u.sub & 1) { a = a0 + (A_YA + br * 512) * 2; b = b0 + 1024 * 2; nt = 8; } else { a = a0; b = b0; nt = 16; }
    }
    static constexpr bool HAS_KEEP = false;
    __device__ __forceinline__ bool keep(const pg8::Unit&) const { return false; }
};
__device__ __forceinline__ void unpack8(const u32x4 g, f32x4& g0, f32x4& g1) { g0 = (f32x4){bflo(g[0]), bfhi(g[0]), bflo(g[1]), bfhi(g[1])}; g1 = (f32x4){bflo(g[2]), bfhi(g[2]), bflo(g[3]), bfhi(g[3])}; }
struct EpiG3 {
    static constexpr bool HAS_POST = false;
    unsigned char* scr; bf16_t* merged; const float* b_gate;
    __device__ __forceinline__ void operator()(f32x4 (&acc)[2][2][4][2], const pg8::Unit& u, int wr, int wc, int fr, int fq) const {
        const int tid = threadIdx.x + opaque_zero();
        const int row0 = u.pm * 256 + wr * 64 + fr, col0 = u.pn * 256 + wc * 32 + 8 * fq + opaque_zero();
        const bool gate = (u.sub & 1) == 0; const int br = u.sub >> 1;
        GAS u32x4* s0 = (GAS u32x4*)scr + tid * 4;
        const int boff = 8192;
        const float* bp = b_gate + br * 1024 + col0;
        bf16_t* mp = merged + (size_t)row0 * 1024 + col0;
#pragma unroll
        for (int ai = 0; ai < 2; ++ai)
#pragma unroll
            for (int bj = 0; bj < 2; ++bj) {
                if (gate) {
                    const f32x4 b0 = *(const f32x4*)(bp + bj * 128), b1 = *(const f32x4*)(bp + bj * 128 + 4);
#pragma unroll
                    for (int m = 0; m < 4; ++m) { f32x4 g0, g1;
#pragma unroll
                        for (int e = 0; e < 4; ++e) { g0[e] = sigmoidf_(acc[ai][bj][m][0][e] + b0[e]); g1[e] = sigmoidf_(acc[ai][bj][m][1][e] + b1[e]); }
                        s0[boff + m] = pack8(g0, g1); }
                } else {
                    u32x4 gn[4], gm[4];
#pragma unroll
                    for (int m = 0; m < 4; ++m) { gn[m] = s0[boff + m]; gm[m] = gn[m]; }
                    if (br > 0) {
#pragma unroll
                        for (int m = 0; m < 4; ++m) gm[m] = s0[m];
                    }
#pragma unroll
                    for (int m = 0; m < 4; ++m) { f32x4 n0, n1, p0, p1; unpack8(gn[m], n0, n1); unpack8(gm[m], p0, p1);
                        f32x4 r0 = acc[ai][bj][m][0] * n0, r1 = acc[ai][bj][m][1] * n1;
                        if (br > 0) { r0 += p0; r1 += p1; }
                        const u32x4 pk = pack8(r0, r1);
                        if (br < 2) s0[m] = pk; else *(u32x4*)(mp + (size_t)(ai * 128 + m * 16) * 1024 + bj * 128) = pk; }
                }
                s0 += 2048; asm volatile("" : "+v"(s0)); __builtin_amdgcn_sched_barrier(0); }
    }
};

struct SchedG4 {
    const char* A; const char* B; int G, c;
    __device__ __forceinline__ bool next(int i, pg8::Unit& u) const {
        const int T = i * G + c; if (T >= 256) return false;
        const int xcd = T & 7, idx = T >> 3; u.pm = xcd * 8 + (idx >> 2); u.pn = idx & 3; u.sub = 0; return true;
    }
    __device__ __forceinline__ void ptrs(const pg8::Unit& u, const char*& a, const char*& b, int& nt) const {
        a = A + (size_t)u.pm * 256 * 1024 * 2; b = B + (size_t)u.pn * 256 * 1024 * 2; nt = 16;
    }
    static constexpr bool HAS_KEEP = false;
    __device__ __forceinline__ bool keep(const pg8::Unit&) const { return false; }
};
struct EpiG4 {
    static constexpr bool HAS_POST = true;
    const float* x; float* out; float* rowsq; const float* fg; unsigned* bar; unsigned epoch;
    __device__ __forceinline__ void operator()(f32x4 (&acc)[2][2][4][2], const pg8::Unit& u, int wr, int wc, int fr, int fq) const {
        const int row0 = u.pm * 256 + wr * 64 + fr + opaque_zero(), col0 = u.pn * 256 + wc * 32 + 8 * fq;
        const GAS float* xp = (const GAS float*)x + (size_t)row0 * 1024 + col0; float* rq = rowsq + row0;
#pragma unroll
        for (int ai = 0; ai < 2; ++ai) {
#pragma unroll
            for (int m = 0; m < 4; ++m) { float ss = 0.f;
#pragma unroll
                for (int bj = 0; bj < 2; ++bj) {
                    acc[ai][bj][m][0] += *(const GAS f32x4*)(xp + bj * 128); acc[ai][bj][m][1] += *(const GAS f32x4*)(xp + bj * 128 + 4);
#pragma unroll
                    for (int e = 0; e < 4; ++e) ss += acc[ai][bj][m][0][e] * acc[ai][bj][m][0][e] + acc[ai][bj][m][1][e] * acc[ai][bj][m][1][e]; }
                ss += __shfl_xor(ss, 16); ss += __shfl_xor(ss, 32);
                if (fq == 0) unsafeAtomicAdd(rq, ss);
                xp += 16 * 1024; rq += 16;
                if (m & 1) asm volatile("" : "+v"(xp), "+v"(rq)); }
            xp += 64 * 1024; rq += 64; }
    }
    __device__ __forceinline__ void post(f32x4 (&acc)[2][2][4][2], const pg8::Unit& u, int wr, int wc, int fr, int fq) const {
        fast_sync(bar, epoch);
        const int row0 = u.pm * 256 + wr * 64 + fr + opaque_zero(), col0 = u.pn * 256 + wc * 32 + 8 * fq;
        GAS float* op = (GAS float*)out + (size_t)row0 * 1024 + col0; const float* rq = rowsq + row0;
        f32x4 g[2][2];
#pragma unroll
        for (int bj = 0; bj < 2; ++bj) { g[bj][0] = *(const f32x4*)(fg + col0 + bj * 128); g[bj][1] = *(const f32x4*)(fg + col0 + bj * 128 + 4); }
#pragma unroll
        for (int ai = 0; ai < 2; ++ai) {
#pragma unroll
            for (int m = 0; m < 4; ++m) {
                const float rs = rsqrtf(__hip_atomic_load(rq, __ATOMIC_RELAXED, __HIP_MEMORY_SCOPE_AGENT) * (1.f / 1024.f) + EPS);
#pragma unroll
                for (int bj = 0; bj < 2; ++bj) { *(GAS f32x4*)(op + bj * 128) = acc[ai][bj][m][0] * rs * g[bj][0]; *(GAS f32x4*)(op + bj * 128 + 4) = acc[ai][bj][m][1] * rs * g[bj][1]; }
                op += 16 * 1024; rq += 16;
                if (m & 1) asm volatile("" : "+v"(op), "+v"(rq)); }
            op += 64 * 1024; rq += 64; }
    }
};

__device__ __forceinline__ void transpose_tile(const Params& p, LAS unsigned char* lds, int t) {
    const float* src; int sld, col0, ntn; bf16_t* dst; int dld;
    bf16_t* W1T = (bf16_t*)(p.ws + OFF_W1T); bf16_t* WG3 = (bf16_t*)(p.ws + OFF_WG3); bf16_t* WOUT = (bf16_t*)(p.ws + OFF_WOUT);
    if (t < 384) { src = p.w_in; sld = 7688; col0 = 0; ntn = 24; dst = W1T; dld = 1024; }
    else if (t < 1152) { t -= 384; src = p.w_in; sld = 7688; col0 = 1544; ntn = 48; dst = W1T + (size_t)1536 * 1024; dld = 1024; }
    else if (t < 1408) { t -= 1152; src = p.w_mem_kv; sld = 1024; col0 = 0; ntn = 16; dst = W1T + (size_t)4608 * 1024; dld = 1024; }
    else if (t < 2176) { t -= 1408; const int i = t >> 8; t &= 255; src = p.w_in; sld = 7688; col0 = 4616 + i * 1024; ntn = 16; dst = WG3 + (size_t)i * 1024 * 1536; dld = 1536; }
    else if (t < 2304) { t -= 2176; src = p.w_br_a; sld = 1024; col0 = 0; ntn = 16; dst = WG3 + 1024; dld = 1536; }
    else if (t < 2432) { t -= 2304; src = p.w_br_b; sld = 1024; col0 = 0; ntn = 16; dst = WG3 + (size_t)1 * 1024 * 1536 + 1024; dld = 1536; }
    else if (t < 2560) { t -= 2432; src = p.w_br_c; sld = 1024; col0 = 0; ntn = 16; dst = WG3 + (size_t)2 * 1024 * 1536 + 1024; dld = 1536; }
    else { t -= 2560; src = p.w_out; sld = 1024; col0 = 0; ntn = 16; dst = WOUT; dld = 1024; }
    const int k0 = (t / ntn) * 64, n0 = (t % ntn) * 64, tid = threadIdx.x;
    LAS float* tile = (LAS float*)lds;
    __syncthreads();
#pragma unroll
    for (int ps = 0; ps < 2; ++ps) { const int r = (tid >> 4) + ps * 32, c4 = (tid & 15) * 4;
        const f32x4 v = *(const f32x4*)(src + (size_t)(k0 + r) * sld + col0 + n0 + c4);
        tile[r * 65 + c4] = v[0]; tile[r * 65 + c4 + 1] = v[1]; tile[r * 65 + c4 + 2] = v[2]; tile[r * 65 + c4 + 3] = v[3]; }
    __syncthreads();
    const int n = tid >> 3, kc = (tid & 7) * 8;
    u32x4 o;
#pragma unroll
    for (int j = 0; j < 4; ++j) o[j] = cvt_pk_bf16(tile[(kc + 2 * j) * 65 + n], tile[(kc + 2 * j + 1) * 65 + n]);
    *(u32x4*)(dst + (size_t)(n0 + n) * dld + k0 + kc) = o;
}

static __device__ __forceinline__ void phase_prep(const Params& p, LAS unsigned char* lds) {
    const int tid = threadIdx.x, wg = blockIdx.x, G = gridDim.x, lane = tid & 63, wave = tid >> 6;
    float* rowsq = (float*)(p.ws + OFF_ROWSQ); unsigned* cnt = (unsigned*)(p.ws + OFF_CNT);
    for (int i = wg * 512 + tid; i < MROWS + 64; i += G * 512) { if (i < MROWS) rowsq[i] = 0.f; else cnt[i - MROWS] = 0u; }
    for (int t = wg; t < 2816; t += G) transpose_tile(p, lds, t);
    __syncthreads();
    LAS float* wb = (LAS float*)lds;
    for (int idx = tid; idx < 8192; idx += 512) { const int k = idx >> 3, j = idx & 7; wb[j * 1024 + k] = p.w_in[(size_t)k * 7688 + 1536 + j]; }
    __syncthreads();
    bf16_t* ACT = (bf16_t*)(p.ws + OFF_ACT); float* betag = (float*)(p.ws + OFF_BETAG);
    for (int row = wg * 8 + wave; row < 18560; row += G * 8) {
        const float* src; const float* gn; size_t drow;
        if (row < NP) { src = p.x_prompt + (size_t)row * 1024; gn = p.norm_g; drow = row; }
        else if (row < NP + NS) { src = p.x_sample + (size_t)(row - NP) * 1024; gn = p.norm_g; drow = row; }
        else { src = p.mem_prompt + (size_t)(row - NP - NS) * 1024; gn = p.mem_norm_g; drow = HM0 + (row - NP - NS); }
        f32x4 v[4]; float ss = 0.f;
#pragma unroll
        for (int q = 0; q < 4; ++q) { v[q] = *(const f32x4*)(src + q * 256 + lane * 4); ss += v[q][0] * v[q][0] + v[q][1] * v[q][1] + v[q][2] * v[q][2] + v[q][3] * v[q][3]; }
        ss = wave_sum(ss);
        const float rstd = rsqrtf(ss * (1.f / 1024.f) + EPS);
#pragma unroll
        for (int q = 0; q < 4; ++q) { const f32x4 g = *(const f32x4*)(gn + q * 256 + lane * 4); v[q] = v[q] * rstd * g;
            u32x2 o; o[0] = cvt_pk_bf16(v[q][0], v[q][1]); o[1] = cvt_pk_bf16(v[q][2], v[q][3]);
            *(u32x2*)(ACT + drow * LDA + q * 256 + lane * 4) = o; }
        if (row < NP + NS) {
            float d[8];
#pragma unroll
            for (int j = 0; j < 8; ++j) { float a = 0.f;
#pragma unroll
                for (int q = 0; q < 4; ++q) { const f32x4 w = *(const LAS f32x4*)(wb + j * 1024 + q * 256 + lane * 4); a += v[q][0] * w[0] + v[q][1] * w[1] + v[q][2] * w[2] + v[q][3] * w[3]; }
                d[j] = wave_sum(a); }
            float dl = d[0];
#pragma unroll
            for (int j = 1; j < 8; ++j) dl = (lane == j) ? d[j] : dl;
            if (lane < 4) betag[(size_t)row * 8 + lane] = sigmoidf_(dl);
            else if (lane < 8) { const int h = lane - 4; const float xx = dl + p.dt_bias[h]; const float sp = xx > 20.f ? xx : log1pf(expf(xx));
                betag[(size_t)row * 8 + lane] = -expf(p.a_log[h]) * sp; }
        }
    }
}

static __device__ __forceinline__ void delta_chunk_item(const Params& p, LAS unsigned char* lds, int ci) {
    const int tid = threadIdx.x, lane = tid & 63, wave = tid >> 6, l16 = lane & 15, quad = lane >> 4;
    const int bh = ci >> 5, n = ci & 31, b = bh >> 2, h = bh & 3;
    const bf16_t* PROJ = (const bf16_t*)(p.ws + OFF_PROJ); const float* betag = (const float*)(p.ws + OFF_BETAG);
    bf16_t* U = (bf16_t*)((unsigned char*)p.out + DO_U) + (size_t)ci * 8192; bf16_t* W = (bf16_t*)((unsigned char*)p.out + DO_W) + (size_t)ci * 8192;
    bf16_t* QD = (bf16_t*)((unsigned char*)p.out + DO_QD) + (size_t)ci * 8192; bf16_t* KDT = (bf16_t*)((unsigned char*)p.out + DO_KDT) + (size_t)ci * 8192;
    bf16_t* ATT = (bf16_t*)(p.ws + OFF_ATTN) + (size_t)ci * 4096; float* GL = (float*)(p.ws + OFF_GL);
    LAS bf16_t* Kb = (LAS bf16_t*)lds; LAS bf16_t* Qb = (LAS bf16_t*)(lds + 17408);
    LAS float* RHS = (LAS float*)(lds + 34816);
    LAS float* Lm = (LAS float*)(lds + 100352);
    LAS float* gcs = (LAS float*)(lds + 116736); LAS float* bts = gcs + 64;
    const int trow0 = b * 2048 + n * 64;
    __syncthreads();
    if (wave == 0) {
        float g = betag[(size_t)(trow0 + lane) * 8 + 4 + h];
#pragma unroll
        for (int o = 1; o < 64; o <<= 1) { const float t = __shfl_up(g, o); if (lane >= o) g += t; }
        gcs[lane] = g; bts[lane] = betag[(size_t)(trow0 + lane) * 8 + h];
        if (lane == 63) GL[ci] = __expf(g);
    }
    __syncthreads();
    {
        const int t = tid >> 3, cc = (tid & 7) * 16;
        const float gct = gcs[t], bet = bts[t], eg = __expf(gct);
#pragma unroll 1
        for (int sec = 0; sec < 3; ++sec) {
            const int col = sec * 512 + h * 128 + cc;
            float y[16];
#pragma unroll
            for (int e = 0; e < 16; ++e) y[e] = 0.f;
#pragma unroll
            for (int j = 0; j < 4; ++j) { const int tl = n * 64 + t - 3 + j;
                if (tl >= 0) { const bf16_t* rp = PROJ + (size_t)(b * 2048 + tl) * PLD + col; const u32x4 x0 = *(const u32x4*)rp, x1 = *(const u32x4*)(rp + 8);
                    const float* wp = p.conv_w + j * 1536 + col;
#pragma unroll
                    for (int e = 0; e < 4; ++e) { const f32x4 w = *(const f32x4*)(wp + e * 4); const unsigned ua = (e < 2 ? x0[2 * e] : x1[2 * e - 4]), ub = (e < 2 ? x0[2 * e + 1] : x1[2 * e - 3]);
                        y[e * 4] += bflo(ua) * w[0]; y[e * 4 + 1] += bfhi(ua) * w[1]; y[e * 4 + 2] += bflo(ub) * w[2]; y[e * 4 + 3] += bfhi(ub) * w[3]; } } }
            float ss = 0.f;
#pragma unroll
            for (int e = 0; e < 16; ++e) { y[e] = siluf_(y[e]); ss += y[e] * y[e]; }
            if (sec < 2) { ss += __shfl_xor(ss, 1); ss += __shfl_xor(ss, 2); ss += __shfl_xor(ss, 4);
                const float sc = rsqrtf(ss + EPS) * (sec == 0 ? 0.08838834764831845f : 1.f);
#pragma unroll
                for (int e = 0; e < 16; ++e) y[e] *= sc; }
            if (sec == 0) {
                u32x4 o0, o1, d0, d1;
#pragma unroll
                for (int e = 0; e < 4; ++e) { o0[e] = cvt_pk_bf16(y[2 * e], y[2 * e + 1]); o1[e] = cvt_pk_bf16(y[8 + 2 * e], y[9 + 2 * e]);
                    d0[e] = cvt_pk_bf16(y[2 * e] * eg, y[2 * e + 1] * eg); d1[e] = cvt_pk_bf16(y[8 + 2 * e] * eg, y[9 + 2 * e] * eg); }
                *(LAS u32x4*)(Qb + t * 136 + cc) = o0; *(LAS u32x4*)(Qb + t * 136 + cc + 8) = o1;
                *(u32x4*)(QD + t * 128 + cc) = d0; *(u32x4*)(QD + t * 128 + cc + 8) = d1;
            } else if (sec == 1) {
                u32x4 o0, o1;
#pragma unroll
                for (int e = 0; e < 4; ++e) { o0[e] = cvt_pk_bf16(y[2 * e], y[2 * e + 1]); o1[e] = cvt_pk_bf16(y[8 + 2 * e], y[9 + 2 * e]); }
                *(LAS u32x4*)(Kb + t * 136 + cc) = o0; *(LAS u32x4*)(Kb + t * 136 + cc + 8) = o1;
                const float s2 = bet * eg;
#pragma unroll
                for (int e = 0; e < 4; ++e) *(LAS f32x4*)(RHS + t * 256 + 128 + cc + e * 4) = (f32x4){y[e * 4] * s2, y[e * 4 + 1] * s2, y[e * 4 + 2] * s2, y[e * 4 + 3] * s2};
            } else {
#pragma unroll
                for (int e = 0; e < 4; ++e) *(LAS f32x4*)(RHS + t * 256 + cc + e * 4) = (f32x4){y[e * 4] * bet, y[e * 4 + 1] * bet, y[e * 4 + 2] * bet, y[e * 4 + 3] * bet};
            }
        }
    }
    __syncthreads();
    {
        const int sel = wave >> 2, it = wave & 3;
        LAS unsigned char* Xb = lds + (sel ? 17408 : 0);
        bf16x8 af[4];
#pragma unroll
        for (int ks = 0; ks < 4; ++ks) af[ks] = lds8(Xb, ((it * 16 + l16) * 136 + ks * 32 + quad * 8) * 2);
#pragma unroll
        for (int jt = 0; jt < 4; ++jt) {
            f32x4 a = {0.f, 0.f, 0.f, 0.f};
            if (jt <= it) {
#pragma unroll
                for (int ks = 0; ks < 4; ++ks) a = mfma16(af[ks], lds8(lds, ((jt * 16 + l16) * 136 + ks * 32 + quad * 8) * 2), a);
            }
            const int j = jt * 16 + l16; const float gj = gcs[j];
#pragma unroll
            for (int r = 0; r < 4; ++r) { const int i = it * 16 + quad * 4 + r;
                const float dec = (i >= j) ? __expf(gcs[i] - gj) : 0.f;
                if (sel == 0) Lm[i * 64 + j] = (i > j) ? bts[i] * a[r] * dec : 0.f;
                else ATT[i * 64 + j] = f2bf((i >= j) ? a[r] * dec : 0.f); }
        }
    }
    {
        const int d = tid >> 2, tq = (tid & 3) * 16; const float gl = gcs[63];
        u32x4 o0, o1;
#pragma unroll
        for (int e = 0; e < 8; ++e) { const int t0 = tq + 2 * e;
            const unsigned v = cvt_pk_bf16(bf2f(Kb[t0 * 136 + d]) * __expf(gl - gcs[t0]), bf2f(Kb[(t0 + 1) * 136 + d]) * __expf(gl - gcs[t0 + 1]));
            if (e < 4) o0[e] = v; else o1[e - 4] = v; }
        *(u32x4*)(KDT + d * 64 + tq) = o0; *(u32x4*)(KDT + d * 64 + tq + 8) = o1;
    }
    __syncthreads();
    if (wave < 4 && (p.mask & 32)) {
        const int col = tid;
        const LAS float* Lz = Lm + opaque_zero();
        float x[64];
#pragma unroll
        for (int i = 0; i < 64; ++i) {
            f32x4 lr[16];
#pragma unroll
            for (int j4 = 0; j4 < (i + 3) / 4; ++j4) lr[j4] = *(const LAS f32x4*)(Lz + i * 64 + j4 * 4);
            const float rcur = RHS[i * 256 + col];
            __builtin_amdgcn_sched_barrier(0);
            float s4[4] = {0.f, 0.f, 0.f, 0.f};
#pragma unroll
            for (int j4 = 0; j4 < (i + 3) / 4; ++j4) {
#pragma unroll
                for (int e = 0; e < 4; ++e) if (j4 * 4 + e < i) s4[e] += lr[j4][e] * x[j4 * 4 + e]; }
            x[i] = rcur - ((s4[0] + s4[1]) + (s4[2] + s4[3]));
            __builtin_amdgcn_sched_barrier(0);
        }
        bf16_t* dst = (col < 128) ? (U + col) : (W + (col - 128));
#pragma unroll
        for (int i = 0; i < 64; ++i) dst[i * 128] = f2bf(x[i]);
    }
}

static __device__ __forceinline__ void phase_delta_pre(const Params& p, LAS unsigned char* lds) {
    const int wg = blockIdx.x, G = gridDim.x, tid = threadIdx.x;
    const bf16_t* PROJ = (const bf16_t*)(p.ws + OFF_PROJ);
    for (int i = wg * 512 + tid; i < 8 * 3 * 1536; i += G * 512) { const int b = i / 4608, r = i % 4608, j = r / 1536, ch = r % 1536;
        p.out[O_SCP + i] = bf2f(PROJ[(size_t)(b * 2048 + 2045 + j) * PLD + ch]); }
    for (int ci = wg; ci < 1024; ci += G) delta_chunk_item(p, lds, ci);
}

struct ScanFr { bf16x8 w[4], qd[4], at[2], kd[2][2]; u32x2 u[2]; };
__device__ __forceinline__ void scan_load(ScanFr& f, const Params& p, int ci, int vb, int vp, int tt, int dtb, int l16, int quad) {
    const bf16_t* U = (const bf16_t*)((const unsigned char*)p.out + DO_U) + (size_t)ci * 8192; const bf16_t* W = (const bf16_t*)((const unsigned char*)p.out + DO_W) + (size_t)ci * 8192;
    const bf16_t* QD = (const bf16_t*)((const unsigned char*)p.out + DO_QD) + (size_t)ci * 8192; const bf16_t* KDT = (const bf16_t*)((const unsigned char*)p.out + DO_KDT) + (size_t)ci * 8192;
    const bf16_t* ATT = (const bf16_t*)(p.ws + OFF_ATTN) + (size_t)ci * 4096;
#pragma unroll
    for (int ks = 0; ks < 4; ++ks) { f.w[ks] = ldg8(W + (tt * 16 + l16) * 128 + ks * 32 + quad * 8); f.qd[ks] = ldg8(QD + (tt * 16 + l16) * 128 + ks * 32 + quad * 8); }
#pragma unroll
    for (int ks = 0; ks < 2; ++ks) { f.at[ks] = ldg8(ATT + (tt * 16 + l16) * 64 + ks * 32 + quad * 8);
#pragma unroll
        for (int d = 0; d < 2; ++d) f.kd[d][ks] = ldg8(KDT + ((dtb + d) * 16 + l16) * 64 + ks * 32 + quad * 8); }
#pragma unroll
    for (int j = 0; j < 2; ++j) f.u[j] = *(const u32x2*)(U + (tt * 16 + l16) * 128 + vb * 64 + (vp * 2 + j) * 16 + quad * 4);
}
static __device__ __forceinline__ void scan_unit(const Params& p, LAS unsigned char* lds, int unit) {
    const int tid = threadIdx.x, lane = tid & 63, wave = tid >> 6, l16 = lane & 15, quad = lane >> 4;
    const int bh = unit >> 1, vb = unit & 1, b = bh >> 2, h = bh & 3;
    const int vp = wave & 1, tt = wave >> 1, dtb = (wave >> 1) * 2;
    LAS bf16_t* STs = (LAS bf16_t*)lds;
    LAS bf16_t* vnT = (LAS bf16_t*)(lds + 17408);
    bf16_t* PROJ = (bf16_t*)(p.ws + OFF_PROJ); const float* GL = (const float*)(p.ws + OFF_GL);
    __syncthreads();
    for (int i = tid; i < 64 * 136 / 2; i += 512) ((LAS unsigned*)STs)[i] = 0u;
    f32x4 accS[2][2];
#pragma unroll
    for (int j = 0; j < 2; ++j)
#pragma unroll
        for (int d = 0; d < 2; ++d) accS[j][d] = (f32x4){0.f, 0.f, 0.f, 0.f};
    const int ci0 = bh * 32;
    const float glv = GL[ci0 + (lane & 31)];
    ScanFr cur, nxt;
    scan_load(cur, p, ci0, vb, vp, tt, dtb, l16, quad);
    nxt = cur;
    __syncthreads();
    for (int n = 0; n < 32; ++n) {
        if (n + 1 < 32) scan_load(nxt, p, ci0 + n + 1, vb, vp, tt, dtb, l16, quad);
        const float gl = __shfl(glv, n);
        f32x4 aW[2], aQ[2];
#pragma unroll
        for (int j = 0; j < 2; ++j) { aW[j] = (f32x4){0.f, 0.f, 0.f, 0.f}; aQ[j] = (f32x4){0.f, 0.f, 0.f, 0.f};
#pragma unroll
            for (int ks = 0; ks < 4; ++ks) { const bf16x8 a = lds8(lds, (((vp * 2 + j) * 16 + l16) * 136 + ks * 32 + quad * 8) * 2); aW[j] = mfma16(a, cur.w[ks], aW[j]); aQ[j] = mfma16(a, cur.qd[ks], aQ[j]); } }
#pragma unroll
        for (int j = 0; j < 2; ++j) { const int vr = (vp * 2 + j) * 16 + quad * 4, tc = tt * 16 + l16;
            vnT[(vr + 0) * 72 + tc] = f2bf(bflo(cur.u[j][0]) - aW[j][0]); vnT[(vr + 1) * 72 + tc] = f2bf(bfhi(cur.u[j][0]) - aW[j][1]);
            vnT[(vr + 2) * 72 + tc] = f2bf(bflo(cur.u[j][1]) - aW[j][2]); vnT[(vr + 3) * 72 + tc] = f2bf(bfhi(cur.u[j][1]) - aW[j][3]); }
        asm volatile("s_waitcnt lgkmcnt(0)" ::: "memory"); __builtin_amdgcn_s_barrier(); asm volatile("" ::: "memory");
#pragma unroll
        for (int j = 0; j < 2; ++j) { accS[j][0] *= gl; accS[j][1] *= gl;
#pragma unroll
            for (int ks = 0; ks < 2; ++ks) { const bf16x8 a = lds8(lds, 17408 + (((vp * 2 + j) * 16 + l16) * 72 + ks * 32 + quad * 8) * 2);
                aQ[j] = mfma16(a, cur.at[ks], aQ[j]); accS[j][0] = mfma16(a, cur.kd[0][ks], accS[j][0]); accS[j][1] = mfma16(a, cur.kd[1][ks], accS[j][1]); }
            u32x2 o; o[0] = cvt_pk_bf16(aQ[j][0], aQ[j][1]); o[1] = cvt_pk_bf16(aQ[j][2], aQ[j][3]);
            *(u32x2*)(PROJ + (size_t)(b * 2048 + n * 64 + tt * 16 + l16) * PLD + C_AQ + h * 128 + vb * 64 + (vp * 2 + j) * 16 + quad * 4) = o;
#pragma unroll
            for (int d = 0; d < 2; ++d)
#pragma unroll
                for (int r = 0; r < 4; ++r) STs[((vp * 2 + j) * 16 + quad * 4 + r) * 136 + (dtb + d) * 16 + l16] = f2bf(accS[j][d][r]); }
        asm volatile("s_waitcnt lgkmcnt(0)" ::: "memory"); __builtin_amdgcn_s_barrier(); asm volatile("" ::: "memory");
        cur = nxt;
    }
    float* sdp = p.out + O_SDP + (size_t)bh * 16384;
#pragma unroll
    for (int j = 0; j < 2; ++j)
#pragma unroll
        for (int d = 0; d < 2; ++d) *(f32x4*)(sdp + (size_t)((dtb + d) * 16 + l16) * 128 + vb * 64 + (vp * 2 + j) * 16 + quad * 4) = accS[j][d];
}

static __device__ __forceinline__ void sample_delta_item(const Params& p, LAS unsigned char* lds, int it) {
    const int tid = threadIdx.x, b = it >> 2, h = it & 3;
    const bf16_t* PROJ = (const bf16_t*)(p.ws + OFF_PROJ); const float* betag = (const float*)(p.ws + OFF_BETAG); bf16_t* ACT = (bf16_t*)(p.ws + OFF_ACT);
    LAS float* qkv = (LAS float*)lds;
    LAS float* red = (LAS float*)(lds + 2048);
    LAS float* fin = (LAS float*)(lds + 2048 + 16384);
    LAS float* sc = (LAS float*)(lds + 2048 + 16384 + 1024);
    const size_t prow = (size_t)(NP + b) * PLD;
    __syncthreads();
    float yv = 0.f;
    if (tid < 384) { const int sec = tid >> 7, c = tid & 127, ch = sec * 512 + h * 128 + c;
        const float b0 = p.state_conv[(size_t)(b * 3 + 0) * 1536 + ch], b1 = p.state_conv[(size_t)(b * 3 + 1) * 1536 + ch], b2 = p.state_conv[(size_t)(b * 3 + 2) * 1536 + ch];
        const float xn = bf2f(PROJ[prow + ch]);
        float y = b0 * p.conv_w[ch] + b1 * p.conv_w[1536 + ch] + b2 * p.conv_w[3072 + ch] + xn * p.conv_w[4608 + ch];
        yv = siluf_(y);
        float* scs = p.out + O_SCS + (size_t)b * 4608;
        scs[ch] = b1; scs[1536 + ch] = b2; scs[3072 + ch] = xn;
    }
    {
        float ss = wave_sum(yv * yv);
        if ((tid & 63) == 0) sc[8 + (tid >> 6)] = ss;
    }
    __syncthreads();
    if (tid < 384) { const int sec = tid >> 7, c = tid & 127;
        float v = yv;
        if (sec == 0) v *= rsqrtf(sc[8] + sc[9] + EPS) * 0.08838834764831845f;
        else if (sec == 1) v *= rsqrtf(sc[10] + sc[11] + EPS);
        qkv[sec * 128 + c] = v; }
    __syncthreads();
    const int dvq = tid & 31, dkg = tid >> 5;
    const float* S0 = p.state_delta + (size_t)it * 16384;
    f32x4 s[8]; f32x4 pk = {0.f, 0.f, 0.f, 0.f}, pq = {0.f, 0.f, 0.f, 0.f};
#pragma unroll
    for (int j = 0; j < 8; ++j) { const int dk = dkg * 8 + j; s[j] = *(const f32x4*)(S0 + (size_t)dk * 128 + dvq * 4); pk += s[j] * qkv[128 + dk]; pq += s[j] * qkv[dk]; }
    *(LAS f32x4*)(red + dkg * 256 + dvq * 4) = pk; *(LAS f32x4*)(red + dkg * 256 + 128 + dvq * 4) = pq;
    {
        float qk = (tid < 128) ? qkv[tid] * qkv[128 + tid] : 0.f; qk = wave_sum(qk);
        if (tid < 128 && (tid & 63) == 0) sc[tid >> 6] = qk;
    }
    __syncthreads();
    const float beta = betag[(size_t)(NP + b) * 8 + h], a = __expf(betag[(size_t)(NP + b) * 8 + 4 + h]);
    if (tid < 128) { float sk = 0.f, sq = 0.f;
#pragma unroll
        for (int g = 0; g < 16; ++g) { sk += red[g * 256 + tid]; sq += red[g * 256 + 128 + tid]; }
        const float vn = beta * (qkv[256 + tid] - a * sk); const float o = a * sq + (sc[0] + sc[1]) * vn;
        fin[tid] = vn; fin[128 + tid] = o;
        const float oo = wave_sum(o * o); if ((tid & 63) == 0) sc[4 + (tid >> 6)] = oo; }
    __syncthreads();
    const f32x4 vn4 = *(const LAS f32x4*)(fin + dvq * 4);
    float* Sn = p.out + O_SDS + (size_t)it * 16384;
#pragma unroll
    for (int j = 0; j < 8; ++j) { const int dk = dkg * 8 + j; *(f32x4*)(Sn + (size_t)dk * 128 + dvq * 4) = s[j] * a + vn4 * qkv[128 + dk]; }
    if (tid < 128) { const float rstd = rsqrtf((sc[4] + sc[5]) * (1.f / 128.f) + EPS);
        const float gt = bf2f(PROJ[prow + C_AGATE + h * 128 + tid]);
        ACT[(size_t)(NP + b) * LDA + A_YA + h * 128 + tid] = f2bf(fin[128 + tid] * rstd * p.a_norm_g[tid] * siluf_(gt)); }
}

static __device__ __forceinline__ void sample_xattn_item(const Params& p, LAS unsigned char* lds, int it) {
    const int tid = threadIdx.x, lane = tid & 63, wave = tid >> 6, b = it >> 2, h = it & 3;
    const bf16_t* PROJ = (const bf16_t*)(p.ws + OFF_PROJ); bf16_t* ACT = (bf16_t*)(p.ws + OFF_ACT);
    LAS float* scr = (LAS float*)lds;
    LAS float* red = (LAS float*)(lds + 1024);
    const int half = lane >> 5, dl = lane & 31;
    const size_t prow = (size_t)(NP + b) * PLD;
    f32x4 q; { const bf16_t* qp = PROJ + prow + C_CQ + h * 128 + dl * 4; const u32x2 u = *(const u32x2*)qp; q = (f32x4){bflo(u[0]), bfhi(u[0]), bflo(u[1]), bfhi(u[1])}; }
    const float* Kp = p.cache_k + ((size_t)(b * 256) * 4 + h) * 128 + dl * 4; const float* Vp = p.cache_v + ((size_t)(b * 256) * 4 + h) * 128 + dl * 4;
    __syncthreads();
    f32x4 kv[16];
#pragma unroll
    for (int i = 0; i < 16; ++i) { const int m = wave * 32 + i * 2 + half; kv[i] = *(const f32x4*)(Kp + (size_t)m * 512); }
#pragma unroll
    for (int i = 0; i < 16; ++i) { float d = kv[i][0] * q[0] + kv[i][1] * q[1] + kv[i][2] * q[2] + kv[i][3] * q[3];
#pragma unroll
        for (int o = 16; o >= 1; o >>= 1) d += __shfl_xor(d, o);
        if (dl == 0) scr[wave * 32 + i * 2 + half] = d * 0.08838834764831845f; }
#pragma unroll
    for (int i = 0; i < 16; ++i) { const int m = wave * 32 + i * 2 + half; kv[i] = *(const f32x4*)(Vp + (size_t)m * 512); }
    __syncthreads();
    float mx = -3.0e38f;
#pragma unroll
    for (int i = 0; i < 4; ++i) mx = fmaxf(mx, scr[lane + 64 * i]);
#pragma unroll
    for (int o = 32; o >= 1; o >>= 1) mx = fmaxf(mx, __shfl_xor(mx, o));
    float sm = 0.f;
#pragma unroll
    for (int i = 0; i < 4; ++i) sm += __expf(scr[lane + 64 * i] - mx);
    sm = wave_sum(sm);
    const float inv = 1.f / sm;
    f32x4 o = {0.f, 0.f, 0.f, 0.f};
#pragma unroll
    for (int i = 0; i < 16; ++i) { const float pr = __expf(scr[wave * 32 + i * 2 + half] - mx) * inv; o += kv[i] * pr; }
    *(LAS f32x4*)(red + (wave * 2 + half) * 128 + dl * 4) = o;
    __syncthreads();
    if (tid < 128) { float s = 0.f;
#pragma unroll
        for (int g = 0; g < 16; ++g) s += red[g * 128 + tid];
        const float gt = bf2f(PROJ[prow + C_CGATE + h * 128 + tid]);
        ACT[(size_t)(NP + b) * LDA + A_YC + h * 128 + tid] = f2bf(s * siluf_(gt)); }
}

static __device__ __forceinline__ void sample_mlp_item(const Params& p, int it) {
    const int tid = threadIdx.x, lane = tid & 63, wave = tid >> 6, b = it * 8 + wave;
    const bf16_t* PROJ = (const bf16_t*)(p.ws + OFF_PROJ); bf16_t* ACT = (bf16_t*)(p.ws + OFF_ACT);
    const size_t prow = (size_t)(NP + b) * PLD; const int c0 = lane * 8;
    const u32x4 xv = *(const u32x4*)(PROJ + prow + C_BV + c0), xu = *(const u32x4*)(PROJ + prow + C_BU + c0), xg = *(const u32x4*)(PROJ + prow + C_BGATE + c0);
    float v[8], s1 = 0.f, s2 = 0.f;
#pragma unroll
    for (int e = 0; e < 4; ++e) { v[2 * e] = bflo(xv[e]); v[2 * e + 1] = bfhi(xv[e]); }
#pragma unroll
    for (int e = 0; e < 8; ++e) s1 += v[e];
    s1 = wave_sum(s1); const float mu = s1 * (1.f / 512.f);
#pragma unroll
    for (int e = 0; e < 8; ++e) { v[e] -= mu; s2 += v[e] * v[e]; }
    s2 = wave_sum(s2); const float rstd = rsqrtf(s2 * (1.f / 512.f) + EPS);
    const int g = c0 >> 7; const float w00 = p.w_spatial[(size_t)g * 16384], bs = p.b_spatial[g * 128];
    float* cvs = p.out + O_CVS + (size_t)b * 512 + c0;
    u32x4 o;
#pragma unroll
    for (int e = 0; e < 4; ++e) { float r[2];
#pragma unroll
        for (int z = 0; z < 2; ++z) { const int c = c0 + 2 * e + z; const float vn = v[2 * e + z] * rstd * p.ln_v_g[c] + p.ln_v_b[c]; cvs[2 * e + z] = vn;
            const float uu = z ? bfhi(xu[e]) : bflo(xu[e]), gg = z ? bfhi(xg[e]) : bflo(xg[e]); r[z] = uu * (w00 * vn + bs) * siluf_(gg); }
        o[e] = cvt_pk_bf16(r[0], r[1]); }
    *(u32x4*)(ACT + (size_t)(NP + b) * LDA + A_YB + c0) = o;
}

static __device__ __forceinline__ void mlp_item(const Params& p, LAS unsigned char* lds, int it) {
    const int tid = threadIdx.x, lane = tid & 63, wave = tid >> 6, l16 = lane & 15, quad = lane >> 4;
    const int row0 = (it >> 4) * 2048 + (it & 15) * 128;
    const bf16_t* PROJ = (const bf16_t*)(p.ws + OFF_PROJ); bf16_t* ACT = (bf16_t*)(p.ws + OFF_ACT);
    LAS bf16_t* vnT = (LAS bf16_t*)lds;
    LAS bf16_t* Wsm = (LAS bf16_t*)(lds + 34816);
    LAS float* st = (LAS float*)(lds + 69632);
    __syncthreads();
    { const int r = tid >> 2, part = tid & 3; const bf16_t* rp = PROJ + (size_t)(row0 + r) * PLD + C_BV + part * 128; float s1 = 0.f, s2 = 0.f;
#pragma unroll
      for (int i = 0; i < 16; ++i) { const u32x4 x = *(const u32x4*)(rp + i * 8);
#pragma unroll
          for (int e = 0; e < 4; ++e) { const float a = bflo(x[e]), c = bfhi(x[e]); s1 += a + c; s2 += a * a + c * c; } }
      s1 += __shfl_xor(s1, 1); s1 += __shfl_xor(s1, 2); s2 += __shfl_xor(s2, 1); s2 += __shfl_xor(s2, 2);
      const float mu = s1 * (1.f / 512.f); const float var = fmaxf(s2 * (1.f / 512.f) - mu * mu, 0.f);
      if (part == 0) { st[r * 2] = mu; st[r * 2 + 1] = rsqrtf(var + EPS); } }
    __syncthreads();
#pragma unroll 1
    for (int g = 0; g < 4; ++g) {
        { const int s = lane + 64 * (wave & 1), cq = (wave >> 1) * 32; const float mu = st[s * 2], rstd = st[s * 2 + 1];
          const bf16_t* rp = PROJ + (size_t)(row0 + s) * PLD + C_BV + g * 128 + cq;
#pragma unroll
          for (int i = 0; i < 4; ++i) { const u32x4 x = *(const u32x4*)(rp + i * 8);
#pragma unroll
              for (int e = 0; e < 4; ++e) { const int c = cq + i * 8 + 2 * e; const int gc = g * 128 + c;
                  vnT[c * 136 + s] = f2bf((bflo(x[e]) - mu) * rstd * p.ln_v_g[gc] + p.ln_v_b[gc]);
                  vnT[(c + 1) * 136 + s] = f2bf((bfhi(x[e]) - mu) * rstd * p.ln_v_g[gc + 1] + p.ln_v_b[gc + 1]); } }
          const int t = tid >> 2, sq = (tid & 3) * 32; const float* wp = p.w_spatial + ((size_t)g * 128 + t) * 128 + sq;
#pragma unroll
          for (int i = 0; i < 4; ++i) { const f32x4 w0 = *(const f32x4*)(wp + i * 8), w1 = *(const f32x4*)(wp + i * 8 + 4); const int s0 = sq + i * 8;
              f32x4 m0, m1;
#pragma unroll
              for (int e = 0; e < 4; ++e) { m0[e] = (s0 + e <= t) ? w0[e] : 0.f; m1[e] = (s0 + 4 + e <= t) ? w1[e] : 0.f; }
              *(LAS u32x4*)(Wsm + t * 136 + s0) = pack8(m0, m1); } }
        __syncthreads();
        f32x4 acc[8];
#pragma unroll
        for (int ct = 0; ct < 8; ++ct) acc[ct] = (f32x4){0.f, 0.f, 0.f, 0.f};
        const int nks = (wave >> 1) + 1;
        for (int ks = 0; ks < nks; ++ks) { const bf16x8 bw = lds8(lds, 34816 + ((wave * 16 + l16) * 136 + ks * 32 + quad * 8) * 2);
#pragma unroll
            for (int ct = 0; ct < 8; ++ct) acc[ct] = mfma16(lds8(lds, ((ct * 16 + l16) * 136 + ks * 32 + quad * 8) * 2), bw, acc[ct]); }
        const int t = wave * 16 + l16; const size_t prow = (size_t)(row0 + t) * PLD; const float bs = p.b_spatial[g * 128 + t];
#pragma unroll
        for (int ct = 0; ct < 8; ++ct) { const int col = g * 128 + ct * 16 + quad * 4;
            const u32x2 xu = *(const u32x2*)(PROJ + prow + C_BU + col), xg = *(const u32x2*)(PROJ + prow + C_BGATE + col);
            u32x2 o; o[0] = cvt_pk_bf16(bflo(xu[0]) * (acc[ct][0] + bs) * siluf_(bflo(xg[0])), bfhi(xu[0]) * (acc[ct][1] + bs) * siluf_(bfhi(xg[0])));
            o[1] = cvt_pk_bf16(bflo(xu[1]) * (acc[ct][2] + bs) * siluf_(bflo(xg[1])), bfhi(xu[1]) * (acc[ct][3] + bs) * siluf_(bfhi(xg[1])));
            *(u32x2*)(ACT + (size_t)(row0 + t) * LDA + A_YB + col) = o; }
        __syncthreads();
    }
}

static __device__ __forceinline__ void xattn_item(const Params& p, LAS unsigned char* lds, int it) {
    const int tid = threadIdx.x, lane = tid & 63, wave = tid >> 6, l16 = lane & 15, quad = lane >> 4;
    const int b = it >> 6, h = (it >> 4) & 3, qt = it & 15;
    const bf16_t* PROJ = (const bf16_t*)(p.ws + OFF_PROJ); bf16_t* ACT = (bf16_t*)(p.ws + OFF_ACT); const bf16_t* MKV = (const bf16_t*)(p.ws + OFF_MEMKV);
    LAS bf16_t* Ks = (LAS bf16_t*)lds;
    LAS bf16_t* Vt = (LAS bf16_t*)(lds + 69632);
    __syncthreads();
#pragma unroll
    for (int i = 0; i < 8; ++i) { const int idx = wave * 8 + i, m = (idx & 3) * 64 + lane, dc = (idx >> 2) * 8; const bf16_t* sp = MKV + (size_t)(b * 256 + m) * 1024 + h * 128 + dc;
        *(LAS u32x4*)(Ks + m * 136 + dc) = *(const u32x4*)sp;
        const u32x4 v = *(const u32x4*)(sp + 512);
#pragma unroll
        for (int e = 0; e < 4; ++e) { Vt[(dc + 2 * e) * 264 + m] = (bf16_t)(v[e] & 0xffffu); Vt[(dc + 2 * e + 1) * 264 + m] = (bf16_t)(v[e] >> 16); } }
    const int q0 = b * 2048 + qt * 128 + wave * 16; const size_t prow = (size_t)(q0 + l16) * PLD;
    bf16x8 qf[4];
#pragma unroll
    for (int ks = 0; ks < 4; ++ks) qf[ks] = ldg8(PROJ + prow + C_CQ + h * 128 + ks * 32 + quad * 8);
    __syncthreads();
    f32x4 s[16];
#pragma unroll
    for (int mt = 0; mt < 16; ++mt) { s[mt] = (f32x4){0.f, 0.f, 0.f, 0.f};
#pragma unroll
        for (int ks = 0; ks < 4; ++ks) s[mt] = mfma16(lds8(lds, ((mt * 16 + l16) * 136 + ks * 32 + quad * 8) * 2), qf[ks], s[mt]); }
    float mx = -3.0e38f;
#pragma unroll
    for (int mt = 0; mt < 16; ++mt)
#pragma unroll
        for (int r = 0; r < 4; ++r) mx = fmaxf(mx, s[mt][r]);
    mx = fmaxf(mx, __shfl_xor(mx, 16)); mx = fmaxf(mx, __shfl_xor(mx, 32));
    const float sc = 0.08838834764831845f * 1.4426950408889634f; float sm = 0.f;
#pragma unroll
    for (int mt = 0; mt < 16; ++mt)
#pragma unroll
        for (int r = 0; r < 4; ++r) { s[mt][r] = exp2f((s[mt][r] - mx) * sc); sm += s[mt][r]; }
    sm += __shfl_xor(sm, 16); sm += __shfl_xor(sm, 32);
    const float inv = 1.f / sm;
    bf16x8 pb[8];
#pragma unroll
    for (int ss = 0; ss < 8; ++ss) { const u32x4 pu = pack8(s[2 * ss], s[2 * ss + 1]); pb[ss] = __builtin_bit_cast(bf16x8, pu); }
#pragma unroll 1
    for (int dt = 0; dt < 8; ++dt) {
        f32x4 o = {0.f, 0.f, 0.f, 0.f};
#pragma unroll
        for (int ss = 0; ss < 8; ++ss) { const bf16x4 v0 = *(const LAS bf16x4*)(Vt + (dt * 16 + l16) * 264 + ss * 32 + quad * 4), v1 = *(const LAS bf16x4*)(Vt + (dt * 16 + l16) * 264 + ss * 32 + 16 + quad * 4);
            o = mfma16(__builtin_shufflevector(v0, v1, 0, 1, 2, 3, 4, 5, 6, 7), pb[ss], o); }
        const int col = h * 128 + dt * 16 + quad * 4; const u32x2 xg = *(const u32x2*)(PROJ + prow + C_CGATE + col);
        u32x2 w; w[0] = cvt_pk_bf16(o[0] * inv * siluf_(bflo(xg[0])), o[1] * inv * siluf_(bfhi(xg[0])));
        w[1] = cvt_pk_bf16(o[2] * inv * siluf_(bflo(xg[1])), o[3] * inv * siluf_(bfhi(xg[1])));
        *(u32x2*)(ACT + (size_t)(q0 + l16) * LDA + A_YC + col) = w;
        __builtin_amdgcn_sched_barrier(0); }
}

static __device__ __forceinline__ void phase_mixers(const Params& p, LAS unsigned char* lds) {
    const int wg = blockIdx.x, G = gridDim.x, tid = threadIdx.x;
    if (p.mask & 1) for (int w = wg; w < 64; w += G) { const int xcd = w & 7, sl = w >> 3; scan_unit(p, lds, ((xcd * 4 + (sl >> 1)) << 1) | (sl & 1)); }
    if (G > 64) { for (int it = wg - 64; it >= 0 && it < 128; it += G - 64) mlp_item(p, lds, it); }
    else { for (int it = wg; it < 128; it += G) mlp_item(p, lds, it); }
    unsigned* cnt = (unsigned*)(p.ws + OFF_CNT);
    LAS unsigned* slot = (LAS unsigned*)(lds + LDS_ITEM);
    for (;;) {
        __syncthreads();
        if (tid == 0) *slot = atomicAdd(cnt, 1u);
        __syncthreads();
        const int it = (int)*slot;
        if (it >= 1552) break;
        if (it < 512) xattn_item(p, lds, it);
        else if (it < 1024) sample_delta_item(p, lds, it - 512);
        else if (it < 1536) sample_xattn_item(p, lds, it - 1024);
        else sample_mlp_item(p, it - 1536);
    }
}

static __device__ __forceinline__ void phase_ya(const Params& p) {
    const int tid = threadIdx.x, lane = tid & 63, wave = tid >> 6;
    const bf16_t* PROJ = (const bf16_t*)(p.ws + OFF_PROJ); bf16_t* ACT = (bf16_t*)(p.ws + OFF_ACT);
    const int c0 = lane * 8, d0 = c0 & 127, nw = gridDim.x * 8;
    f32x4 ng0 = *(const f32x4*)(p.a_norm_g + d0), ng1 = *(const f32x4*)(p.a_norm_g + d0 + 4);
    for (int row0 = blockIdx.x * 8 + wave; row0 < NP; row0 += nw * 4) {
        u32x4 xo[4], xg[4];
#pragma unroll
        for (int k = 0; k < 4; ++k) { const int row = row0 + k * nw; if (row < NP) { const size_t prow = (size_t)row * PLD; xo[k] = *(const u32x4*)(PROJ + prow + C_AQ + c0); xg[k] = *(const u32x4*)(PROJ + prow + C_AGATE + c0); } }
#pragma unroll
        for (int k = 0; k < 4; ++k) { const int row = row0 + k * nw; if (row < NP) {
            float v[8], ss = 0.f;
#pragma unroll
            for (int e = 0; e < 4; ++e) { v[2 * e] = bflo(xo[k][e]); v[2 * e + 1] = bfhi(xo[k][e]); ss += v[2 * e] * v[2 * e] + v[2 * e + 1] * v[2 * e + 1]; }
            ss += __shfl_xor(ss, 1); ss += __shfl_xor(ss, 2); ss += __shfl_xor(ss, 4); ss += __shfl_xor(ss, 8);
            const float rstd = rsqrtf(ss * (1.f / 128.f) + EPS);
            u32x4 o;
#pragma unroll
            for (int e = 0; e < 4; ++e) { const float g0 = e < 2 ? ng0[2 * e] : ng1[2 * e - 4], g1 = e < 2 ? ng0[2 * e + 1] : ng1[2 * e - 3];
                o[e] = cvt_pk_bf16(v[2 * e] * rstd * g0 * siluf_(bflo(xg[k][e])), v[2 * e + 1] * rstd * g1 * siluf_(bfhi(xg[k][e]))); }
            *(u32x4*)(ACT + (size_t)row * LDA + A_YA + c0) = o; } }
    }
}

template <int NKS> __device__ __forceinline__ f32x4 small_gemm(const bf16_t* Wt, const bf16_t* A) {
    bf16x8 wv[NKS], av[NKS];
#pragma unroll
    for (int ks = 0; ks < NKS; ++ks) { wv[ks] = ldg8(Wt + ks * 32); av[ks] = ldg8(A + ks * 32); }
    f32x4 acc = {0.f, 0.f, 0.f, 0.f};
#pragma unroll
    for (int ks = 0; ks < NKS; ++ks) acc = mfma16(wv[ks], av[ks], acc);
    return acc;
}
static __device__ __forceinline__ void sample_g3(const Params& p, LAS unsigned char* lds) {
    const int tid = threadIdx.x, lane = tid & 63, wave = tid >> 6, l16 = lane & 15, quad = lane >> 4, c = blockIdx.x;
    const int ct = c >> 2, rt = 2 * (c & 3) + (wave >> 2), kp = wave & 3;
    const bf16_t* ACT = (const bf16_t*)(p.ws + OFF_ACT); const bf16_t* WG3 = (const bf16_t*)(p.ws + OFF_WG3); bf16_t* MERGED = (bf16_t*)(p.ws + OFF_MERGED);
    const int r = NP + rt * 16 + l16 + opaque_zero(), n0 = ct * 16;
    LAS f32x4* red = (LAS f32x4*)lds;
#pragma unroll
    for (int br = 0; br < 3; ++br) {
        const bf16_t* wrow = WG3 + ((size_t)br * 1024 + n0 + l16) * 1536 + quad * 8; const bf16_t* arow = ACT + (size_t)r * LDA + quad * 8;
        red[(wave * 6 + 2 * br) * 64 + lane] = small_gemm<8>(wrow + kp * 256, arow + kp * 256);
        red[(wave * 6 + 2 * br + 1) * 64 + lane] = small_gemm<4>(wrow + 1024 + kp * 128, arow + A_YA + br * 512 + kp * 128);
    }
    __syncthreads();
    if (kp == 0) {
        f32x4 m = {0.f, 0.f, 0.f, 0.f};
#pragma unroll
        for (int br = 0; br < 3; ++br) {
            f32x4 ag = {0.f, 0.f, 0.f, 0.f}, at = {0.f, 0.f, 0.f, 0.f};
#pragma unroll
            for (int k = 0; k < 4; ++k) { ag += red[((wave + k) * 6 + 2 * br) * 64 + lane]; at += red[((wave + k) * 6 + 2 * br + 1) * 64 + lane]; }
            const f32x4 bg = *(const f32x4*)(p.b_gate + br * 1024 + n0 + quad * 4);
#pragma unroll
            for (int e = 0; e < 4; ++e) m[e] += sigmoidf_(ag[e] + bg[e]) * at[e];
        }
        u32x2 o; o[0] = cvt_pk_bf16(m[0], m[1]); o[1] = cvt_pk_bf16(m[2], m[3]);
        *(u32x2*)(MERGED + (size_t)r * 1024 + n0 + quad * 4) = o;
    }
}
static __device__ __forceinline__ void sample_g4(const Params& p, LAS unsigned char* lds) {
    const int tid = threadIdx.x, lane = tid & 63, wave = tid >> 6, l16 = lane & 15, quad = lane >> 4, c = blockIdx.x;
    const int ct = c >> 2, rt = 2 * (c & 3) + (wave >> 2), kp = wave & 3;
    const bf16_t* WOUT = (const bf16_t*)(p.ws + OFF_WOUT); const bf16_t* MERGED = (const bf16_t*)(p.ws + OFF_MERGED); float* rowsq = (float*)(p.ws + OFF_ROWSQ);
    const int rs = rt * 16 + l16 + opaque_zero(), n0 = ct * 16;
    LAS f32x4* red = (LAS f32x4*)lds;
    red[wave * 64 + lane] = small_gemm<8>(WOUT + (size_t)(n0 + l16) * 1024 + quad * 8 + kp * 256, MERGED + (size_t)(NP + rs) * 1024 + quad * 8 + kp * 256);
    __syncthreads();
    if (kp == 0) {
        f32x4 a = red[wave * 64 + lane] + red[(wave + 1) * 64 + lane] + red[(wave + 2) * 64 + lane] + red[(wave + 3) * 64 + lane];
        const f32x4 v = *(const f32x4*)(p.x_sample + (size_t)rs * 1024 + n0 + quad * 4) + a;
        *(f32x4*)(p.out + O_YS + (size_t)rs * 1024 + n0 + quad * 4) = v;
        float ss = v[0] * v[0] + v[1] * v[1] + v[2] * v[2] + v[3] * v[3];
        ss += __shfl_xor(ss, 16); ss += __shfl_xor(ss, 32);
        if (quad == 0) unsafeAtomicAdd(rowsq + NP + rs, ss);
    }
}

static __device__ __forceinline__ void sample_g4_finish(const Params& p) {
    const int tid = threadIdx.x, lane = tid & 63, wave = tid >> 6, l16 = lane & 15, quad = lane >> 4, c = blockIdx.x;
    const int ct = c >> 2, rt = 2 * (c & 3) + (wave >> 2), kp = wave & 3;
    const float* rowsq = (const float*)(p.ws + OFF_ROWSQ);
    if (kp == 0) { const int rs = rt * 16 + l16, n0 = ct * 16; float* op = p.out + O_YS + (size_t)rs * 1024 + n0 + quad * 4;
        const float r = rsqrtf(__hip_atomic_load(rowsq + NP + rs, __ATOMIC_RELAXED, __HIP_MEMORY_SCOPE_AGENT) * (1.f / 1024.f) + EPS);
        *(f32x4*)op = *(const f32x4*)op * r * *(const f32x4*)(p.final_norm_g + n0 + quad * 4); }
}
static __device__ __forceinline__ void phase_final(const Params& p) {
    const float* rowsq = (const float*)(p.ws + OFF_ROWSQ);
    const int total4 = (NP + NS) * 256, stride = gridDim.x * 512;
    for (int base = blockIdx.x * 512 + threadIdx.x; base < total4; base += stride * 8) {
        f32x4 v[8]; float rs[8];
#pragma unroll
        for (int k = 0; k < 8; ++k) { const int i = base + k * stride; if (i < total4) { v[k] = *(const f32x4*)(p.out + (size_t)i * 4); rs[k] = rowsq[i >> 8]; } }
#pragma unroll
        for (int k = 0; k < 8; ++k) { const int i = base + k * stride; if (i < total4) { const f32x4 g = *(const f32x4*)(p.final_norm_g + (i & 255) * 4);
            *(f32x4*)(p.out + (size_t)i * 4) = v[k] * rsqrtf(rs[k] * (1.f / 1024.f) + EPS) * g; } }
    }
}

__global__ void __launch_bounds__(512, 2) fwd_megakernel(Params p) {
    extern __shared__ __attribute__((aligned(16))) unsigned char shm[];
    LAS unsigned char* lds = (LAS unsigned char*)shm;
    cg::grid_group grid = cg::this_grid();
    const int G = gridDim.x, c = blockIdx.x;
    unsigned* bar = (unsigned*)(p.ws + OFF_BAR); unsigned ep = 0u;
#define PH_BEGIN(k) if (p.ph_lo <= (k) && (k) < p.ph_hi) { if ((k) > p.ph_lo) { if ((k) == 1) grid_sync_all(grid); else fast_sync(bar, ++ep); }
#define PH_END }
#if !defined(ONLY_PH) || ONLY_PH == 0
    PH_BEGIN(0) phase_prep(p, lds); PH_END
#endif
#if !defined(ONLY_PH) || ONLY_PH == 1
    PH_BEGIN(1) { SchedG1 S{(const char*)(p.ws + OFF_ACT), (const char*)(p.ws + OFF_W1T), G, c};
                  EpiG1 E{(bf16_t*)(p.ws + OFF_PROJ), (bf16_t*)(p.ws + OFF_MEMKV), p.out};
                  pg8::gemm_phase(lds, LDA, 1024, S, E); } PH_END
#endif
#if !defined(ONLY_PH) || ONLY_PH == 2
    PH_BEGIN(2) phase_delta_pre(p, lds); PH_END
#endif
#if !defined(ONLY_PH) || ONLY_PH == 3
    PH_BEGIN(3) phase_mixers(p, lds); PH_END
#endif
#if !defined(ONLY_PH) || ONLY_PH == 4
    PH_BEGIN(4) phase_ya(p); PH_END
#endif
#if !defined(ONLY_PH) || ONLY_PH == 5
    PH_BEGIN(5) { SchedG3 S{(const char*)(p.ws + OFF_ACT), (const char*)(p.ws + OFF_WG3), G, c};
                  EpiG3 E{p.ws + OFF_PROJ + (size_t)c * SCR_PER_WG, (bf16_t*)(p.ws + OFF_MERGED), p.b_gate};
                  pg8::gemm_phase(lds, LDA, 1536, S, E);
                  sample_g3(p, lds); } PH_END
#endif
#if !defined(ONLY_PH) || ONLY_PH == 6
    PH_BEGIN(6) { sample_g4(p, lds); __syncthreads();
                  SchedG4 S{(const char*)(p.ws + OFF_MERGED), (const char*)(p.ws + OFF_WOUT), G, c};
                  EpiG4 E{p.x_prompt, p.out, (float*)(p.ws + OFF_ROWSQ), p.final_norm_g, bar, ep + 1u};
                  pg8::gemm_phase(lds, 1024, 1024, S, E);
                  sample_g4_finish(p); } PH_END
#endif
#if !defined(ONLY_PH) || ONLY_PH == 7
#endif
}

extern "C" void kernel_launch(void* const* d_in, const int* in_sizes, int n_in, void* d_out, int out_size, void* d_ws, size_t ws_size, hipStream_t stream) {
    static int grid_blocks = 0;
    if (grid_blocks == 0) {
        if (n_in != 25 || ws_size < WS_END) { fprintf(stderr, "kernel_launch: unexpected n_in %d / ws_size %zu (need %zu)\n", n_in, ws_size, (size_t)WS_END); grid_blocks = -1; return; }
        int dev = 0, cus = 0, per_cu = 0;
        hipGetDevice(&dev);
        hipDeviceGetAttribute(&cus, hipDeviceAttributeMultiprocessorCount, dev);
        if (hipFuncSetAttribute((const void*)fwd_megakernel, hipFuncAttributeMaxDynamicSharedMemorySize, LDS_BYTES) != hipSuccess) { fprintf(stderr, "kernel_launch: hipFuncSetAttribute failed\n"); }
        if (hipOccupancyMaxActiveBlocksPerMultiprocessor(&per_cu, fwd_megakernel, 512, LDS_BYTES) != hipSuccess || per_cu < 1) { fprintf(stderr, "kernel_launch: occupancy query gave %d\n", per_cu); per_cu = 1; }
        (void)hipGetLastError();
        grid_blocks = cus * per_cu; if (grid_blocks > 256) grid_blocks = 256;
        if (grid_blocks != 256) { fprintf(stderr, "kernel_launch: this build needs exactly 256 co-resident workgroups (one output tile each in the fused out-projection epilogue); got %d\n", grid_blocks); grid_blocks = -1; return; }
    }
    if (grid_blocks < 0) return;
    Params p{};
    const float** f = (const float**)&p;
    for (int i = 0; i < 25; ++i) f[i] = (const float*)d_in[i];
    p.out = (float*)d_out; p.ws = (unsigned char*)d_ws; p.ph_lo = 0; p.ph_hi = 8; p.mask = 0xff;
    hipMemsetAsync((char*)d_ws + OFF_BAR, 0, 9 * 256, stream);
    void* args[] = {&p};
    hipError_t e = hipLaunchCooperativeKernel((const void*)fwd_megakernel, dim3(grid_blocks), dim3(512), args, LDS_BYTES, stream);
    if (e != hipSuccess) fprintf(stderr, "cooperative launch failed: %s (grid %d)\n", hipGetErrorString(e), grid_blocks);
}
```

```cpp
#include <hip/hip_runtime.h>
#include <hip/hip_cooperative_groups.h>
#include <cstdio>
namespace cg = cooperative_groups;

#define LAS __attribute__((address_space(3)))
#define GAS __attribute__((address_space(1)))
typedef unsigned short bf16_t;
typedef short bf16x8 __attribute__((ext_vector_type(8)));
typedef short bf16x4 __attribute__((ext_vector_type(4)));
typedef float f32x4 __attribute__((ext_vector_type(4)));
typedef unsigned u32x4 __attribute__((ext_vector_type(4)));
typedef unsigned u32x2 __attribute__((ext_vector_type(2)));

constexpr int NP = 16384, NS = 128, MROWS = 16640, HM0 = 16640, LDA = 2560, PLD = 4608;
constexpr int C_AQ = 0, C_AK = 512, C_AV = 1024, C_AGATE = 1536, C_BU = 2048, C_BV = 2560, C_BGATE = 3072, C_CQ = 3584, C_CGATE = 4096;
constexpr int A_H = 0, A_YA = 1024, A_YB = 1536, A_YC = 2048;
constexpr float EPS = 1e-6f;
constexpr size_t OFF_W1T = 0;
constexpr size_t OFF_WG3 = 11534336;
constexpr size_t OFF_WOUT = 20971520;
constexpr size_t OFF_ACT = 23068672;
constexpr size_t OFF_PROJ = 118751232;
constexpr size_t OFF_ATTN = 272105472;
constexpr size_t OFF_MEMKV = 280494080;
constexpr size_t OFF_BETAG = 284688384;
constexpr size_t OFF_ROWSQ = 285216768;
constexpr size_t OFF_GL = 285283328;
constexpr size_t OFF_CNT = 285287424;
constexpr size_t OFF_BAR = 285287680;
constexpr size_t WS_END = 285290240;
constexpr size_t SCR_PER_WG = 262144;
constexpr size_t OFF_MERGED = OFF_PROJ + 256 * SCR_PER_WG;
constexpr size_t DO_U = 0, DO_W = 16777216, DO_QD = 33554432, DO_KDT = 50331648;
constexpr size_t O_YS = 16777216, O_SDP = 16908288, O_SCP = 17432576, O_MKP = 17469440, O_MVP = 18518016, O_SDS = 19566592, O_SCS = 27955200, O_CVS = 28545024;
constexpr int LDS_BYTES = 143360;
constexpr int LDS_ITEM = 143344;

struct Params {
    const float *x_prompt, *x_sample, *cache_k, *cache_v, *state_delta, *state_conv, *mem_prompt, *norm_g, *w_in, *conv_w, *a_log, *dt_bias, *a_norm_g,
        *ln_v_g, *ln_v_b, *w_spatial, *b_spatial, *mem_norm_g, *w_mem_kv, *w_br_a, *w_br_b, *w_br_c, *b_gate, *w_out, *final_norm_g;
    float* out;
    unsigned char* ws;
    int ph_lo, ph_hi, mask, pad_;
};

typedef __bf16 bf16v2_t __attribute__((ext_vector_type(2)));
__device__ __forceinline__ unsigned cvt_pk_bf16(float lo, float hi) { bf16v2_t v; v[0] = (__bf16)lo; v[1] = (__bf16)hi; return __builtin_bit_cast(unsigned, v); }
__device__ __forceinline__ bf16_t f2bf(float f) { return (bf16_t)(cvt_pk_bf16(f, 0.f) & 0xffffu); }
__device__ __forceinline__ float bf2f(bf16_t b) { return __uint_as_float(((unsigned)b) << 16); }
__device__ __forceinline__ float bflo(unsigned u) { return __uint_as_float(u << 16); }
__device__ __forceinline__ float bfhi(unsigned u) { return __uint_as_float(u & 0xffff0000u); }
__device__ __forceinline__ float sigmoidf_(float x) { return __builtin_amdgcn_rcpf(1.f + __expf(-x)); }
__device__ __forceinline__ float siluf_(float x) { return x * __builtin_amdgcn_rcpf(1.f + __expf(-x)); }
__device__ __forceinline__ float wave_sum(float v) {
#pragma unroll
    for (int o = 32; o >= 1; o >>= 1) v += __shfl_xor(v, o);
    return v;
}
__device__ __forceinline__ int opaque_zero() { int z; asm volatile("v_mov_b32 %0, 0" : "=v"(z)); return z; }
__device__ __forceinline__ f32x4 mfma16(bf16x8 a, bf16x8 b, f32x4 c) { return __builtin_amdgcn_mfma_f32_16x16x32_bf16(a, b, c, 0, 0, 0); }
__device__ __forceinline__ bf16x8 ldg8(const bf16_t* p) { return *(const bf16x8*)p; }
__device__ __forceinline__ bf16x8 lds8(LAS unsigned char* l, int off) { return *(const LAS bf16x8*)(l + off); }
__device__ __forceinline__ u32x4 pack8(f32x4 a, f32x4 b) { u32x4 r; r[0] = cvt_pk_bf16(a[0], a[1]); r[1] = cvt_pk_bf16(a[2], a[3]); r[2] = cvt_pk_bf16(b[0], b[1]); r[3] = cvt_pk_bf16(b[2], b[3]); return r; }

__device__ __forceinline__ void grid_sync_all(cg::grid_group& grid) {
    asm volatile("s_waitcnt vmcnt(0)" ::: "memory");
    grid.sync();
    if (threadIdx.x < 64) { __builtin_amdgcn_fence(__ATOMIC_ACQUIRE, "agent"); asm volatile("s_waitcnt vmcnt(0)" ::: "memory"); }
    __syncthreads();
}

__device__ __forceinline__ void fast_sync(unsigned* bar, unsigned epoch) {
    asm volatile("s_waitcnt vmcnt(0)" ::: "memory");
    __syncthreads();
    if (threadIdx.x == 0) {
        __builtin_amdgcn_fence(__ATOMIC_RELEASE, "agent"); asm volatile("s_waitcnt vmcnt(0)" ::: "memory");
        const unsigned g = blockIdx.x & 7u, ng = (gridDim.x - g + 7u) / 8u, ngroups = gridDim.x < 8u ? gridDim.x : 8u;
        const unsigned old = __hip_atomic_fetch_add(bar + g * 64, 1u, __ATOMIC_RELAXED, __HIP_MEMORY_SCOPE_AGENT);
        if (old + 1u == epoch * ng) __hip_atomic_fetch_add(bar + 8 * 64, 1u, __ATOMIC_RELAXED, __HIP_MEMORY_SCOPE_AGENT);
        while (__hip_atomic_load(bar + 8 * 64, __ATOMIC_RELAXED, __HIP_MEMORY_SCOPE_AGENT) < epoch * ngroups) __builtin_amdgcn_s_sleep(1);
        __builtin_amdgcn_fence(__ATOMIC_ACQUIRE, "agent"); asm volatile("s_waitcnt vmcnt(0)" ::: "memory");
    }
    __syncthreads();
}

namespace pg8 {
constexpr int BM = 256, BK = 64, HALF = 128, HTB = HALF * BK * 2, STAGE_BYTES = 8 * HTB;
__device__ __forceinline__ int lds_byte(int r, int c) { const int st = (r >> 4) * 2 + (c >> 5), rr = r & 15, cc = c & 31, ob = rr * 64 + cc * 2; return st * 1024 + (ob ^ (((ob >> 9) & 1) << 5)); }
__device__ __forceinline__ void stage_rc(int b, int& R, int& C) { const int st = b / 1024, sb = b % 1024, swz = sb ^ (((sb >> 9) & 1) << 5); R = (st >> 1) * 16 + swz / 64; C = (st & 1) * 32 + (swz % 64) / 2; }
__device__ __forceinline__ int perm32(int rho) { const int n = rho >> 4, i = rho & 15; return 8 * (i >> 2) + 4 * n + (i & 3); }
struct Unit { int pm, pn, sub; };

template <class Epi, class Sched>
__device__ __forceinline__ void gemm_phase(LAS unsigned char* lds, const int lda, const int ldb, const Sched& S, const Epi& E) {
    const int tid = threadIdx.x, wid = __builtin_amdgcn_readfirstlane(tid >> 6), lane = tid & 63, wr = wid >> 2, wc = wid & 3, fr = lane & 15, fq = lane >> 4;
    unsigned voffA[2], voffB[2];
#pragma unroll
    for (int i = 0; i < 2; ++i) { int R, C; stage_rc(tid * 16 + i * 8192, R, C); const int Rb = (R & ~31) + perm32(R & 31);
        voffA[i] = (unsigned)(R * lda + C) * 2u; voffB[i] = (unsigned)(Rb * ldb + C) * 2u; }
    const size_t kstep = (size_t)(BK * 2);
    const size_t hstepA = (size_t)HALF * lda * 2, hstepB = (size_t)HALF * ldb * 2;
    const unsigned ldsw = (unsigned)wid * 1024u;
    const int aoff = lds_byte(wr * 64 + fr, fq * 8), boff = lds_byte(wc * 32 + fr, fq * 8);
#define PG8_SA(b, h) (((b) * 2 + (h)) * HTB)
#define PG8_SB(b, h) ((4 + (b) * 2 + (h)) * HTB)
#define PG8_STAGE(bufoff, gbase, voff) do { _Pragma("unroll") for (int _i = 0; _i < 2; ++_i) \
        __builtin_amdgcn_global_load_lds((const unsigned*)((const char*)(gbase) + (voff)[_i]), (LAS unsigned*)(lds + (bufoff) + ldsw + _i * 8192), 16, 0, 0); } while (0)
#define PG8_LDA(dst, b, h) do { _Pragma("unroll") for (int m = 0; m < 4; ++m) _Pragma("unroll") for (int k = 0; k < 2; ++k) dst[m][k] = *(const LAS bf16x8*)(lds + PG8_SA(b, h) + aoff + m * 2048 + k * 1024); } while (0)
#define PG8_LDB(dst, b, h) do { _Pragma("unroll") for (int n = 0; n < 2; ++n) _Pragma("unroll") for (int k = 0; k < 2; ++k) dst[n][k] = *(const LAS bf16x8*)(lds + PG8_SB(b, h) + boff + n * 2048 + k * 1024); } while (0)
#define PG8_MMA(ai, bj, At, Bt) do { __builtin_amdgcn_s_setprio(1); _Pragma("unroll") for (int m = 0; m < 4; ++m) _Pragma("unroll") for (int n = 0; n < 2; ++n) _Pragma("unroll") for (int k = 0; k < 2; ++k) \
        acc[ai][bj][m][n] = __builtin_amdgcn_mfma_f32_16x16x32_bf16(Bt[n][k], At[m][k], acc[ai][bj][m][n], 0, 0, 0); __builtin_amdgcn_s_setprio(0); } while (0)
#define PG8_WAIT_V(n) asm volatile("s_waitcnt vmcnt(" #n ")" ::: "memory")
#define PG8_WAIT_L(n) asm volatile("s_waitcnt lgkmcnt(" #n ")" ::: "memory")
#define PG8_BAR __builtin_amdgcn_s_barrier()
#define PG8_SCHED __builtin_amdgcn_sched_barrier(0)
    Unit cur, nxt; int ui = 0;
    if (!S.next(0, cur)) return;
    f32x4 acc[2][2][4][2];
    bf16x8 At[4][2], B0[2][2], B1[2][2];
    const char* cA; const char* cB; int nt;
    S.ptrs(cur, cA, cB, nt);
    PG8_STAGE(PG8_SB(0, 0), cB, voffB); PG8_STAGE(PG8_SA(0, 0), cA, voffA); PG8_STAGE(PG8_SB(0, 1), cB + hstepB, voffB); PG8_STAGE(PG8_SA(0, 1), cA + hstepA, voffA);
    if (wr == 1) PG8_BAR;
    PG8_WAIT_V(4); PG8_BAR;
    PG8_STAGE(PG8_SB(1, 0), cB + kstep, voffB); PG8_STAGE(PG8_SA(1, 0), cA + kstep, voffA); PG8_STAGE(PG8_SB(1, 1), cB + hstepB + kstep, voffB);
    PG8_WAIT_V(6); PG8_BAR;
    PG8_SCHED;
#pragma unroll
    for (int a = 0; a < 2; ++a)
#pragma unroll
        for (int b = 0; b < 2; ++b)
#pragma unroll
            for (int m = 0; m < 4; ++m)
#pragma unroll
                for (int n = 0; n < 2; ++n) acc[a][b][m][n] = (f32x4){0.f, 0.f, 0.f, 0.f};
    for (;;) {
        const bool has_next = S.next(ui + 1, nxt);
        const char* nA = cA; const char* nB = cB; int nnt = nt;
        if (has_next) S.ptrs(nxt, nA, nB, nnt);
        for (int t = 0; t < nt; t += 2) {
            const bool last = (t == nt - 2);
            const char* a1 = cA + (size_t)(t + 1) * kstep;
            const char* a2 = last ? nA : cA + (size_t)(t + 2) * kstep; const char* b2 = last ? nB : cB + (size_t)(t + 2) * kstep;
            const char* a3 = a2 + kstep; const char* b3 = b2 + kstep;
            PG8_LDB(B0, 0, 0); PG8_SCHED; PG8_LDA(At, 0, 0); PG8_STAGE(PG8_SA(1, 1), a1 + hstepA, voffA);
            PG8_WAIT_L(8); PG8_BAR; PG8_WAIT_L(0); PG8_MMA(0, 0, At, B0); PG8_BAR; PG8_SCHED;
            PG8_LDB(B1, 0, 1); PG8_STAGE(PG8_SB(0, 0), b2, voffB);
            PG8_BAR; PG8_WAIT_L(0); PG8_MMA(0, 1, At, B1); PG8_BAR;
            PG8_LDA(At, 0, 1); PG8_STAGE(PG8_SA(0, 0), a2, voffA);
            PG8_BAR; PG8_WAIT_L(0); PG8_MMA(1, 0, At, B0); PG8_BAR; PG8_SCHED;
            PG8_STAGE(PG8_SB(0, 1), b2 + hstepB, voffB);
            PG8_WAIT_V(6); PG8_BAR; PG8_MMA(1, 1, At, B1); PG8_BAR;
            PG8_LDB(B0, 1, 0); PG8_SCHED; PG8_LDA(At, 1, 0); PG8_STAGE(PG8_SA(0, 1), a2 + hstepA, voffA);
            PG8_WAIT_L(8); PG8_BAR; PG8_WAIT_L(0); PG8_MMA(0, 0, At, B0); PG8_BAR; PG8_SCHED;
            PG8_LDB(B1, 1, 1); PG8_STAGE(PG8_SB(1, 0), b3, voffB);
            PG8_BAR; PG8_WAIT_L(0); PG8_MMA(0, 1, At, B1); PG8_BAR;
            PG8_LDA(At, 1, 1); PG8_STAGE(PG8_SA(1, 0), a3, voffA);
            PG8_BAR; PG8_WAIT_L(0); PG8_MMA(1, 0, At, B0); PG8_BAR; PG8_SCHED;
            PG8_STAGE(PG8_SB(1, 1), b3 + hstepB, voffB);
            PG8_WAIT_V(6); PG8_BAR; PG8_MMA(1, 1, At, B1); PG8_BAR;
        }
        __builtin_amdgcn_sched_barrier(0);
        E(acc, cur, wr, wc, fr, fq);
        __builtin_amdgcn_sched_barrier(0);
        if (!has_next) break;
        const float kf = S.keep(cur) ? 1.f : 0.f;
#pragma unroll
        for (int a = 0; a < 2; ++a)
#pragma unroll
            for (int b = 0; b < 2; ++b)
#pragma unroll
                for (int m = 0; m < 4; ++m)
#pragma unroll
                    for (int n = 0; n < 2; ++n) { if constexpr (Sched::HAS_KEEP) acc[a][b][m][n] *= kf; else acc[a][b][m][n] = (f32x4){0.f, 0.f, 0.f, 0.f}; }
        cur = nxt; cA = nA; cB = nB; nt = nnt; ++ui;
    }
    PG8_WAIT_V(0);
    if (wr == 0) PG8_BAR;
    PG8_BAR;
    if constexpr (Epi::HAS_POST) E.post(acc, cur, wr, wc, fr, fq);
#undef PG8_SA
#undef PG8_SB
#undef PG8_STAGE
#undef PG8_LDA
#undef PG8_LDB
#undef PG8_MMA
#undef PG8_WAIT_V
#undef PG8_WAIT_L
#undef PG8_BAR
#undef PG8_SCHED
}
}

struct SchedG1 {
    const char* A; const char* B; int G, c;
    __device__ __forceinline__ bool next(int i, pg8::Unit& u) const {
        const int L = i * G + c; if (L >= 1202) return false;
        if (L < 1170) {
            const int nM = 65, nN = 18, nwg = 1170;
            int wgid = L; { const int q = nwg / 8, r = nwg % 8, xcd = wgid % 8, off = wgid / 8; wgid = (xcd < r ? xcd * (q + 1) : r * (q + 1) + (xcd - r) * q) + off; }
            const int nig = 8 * nN, gid = wgid / nig, fm = gid * 8, gsz = (nM - fm) < 8 ? (nM - fm) : 8;
            u.pm = fm + ((wgid % nig) % gsz); u.pn = (wgid % nig) / gsz;
        } else { const int l2 = L - 1170; u.pm = 65 + (l2 >> 2); u.pn = 18 + (l2 & 3); }
        u.sub = 0; return true;
    }
    __device__ __forceinline__ void ptrs(const pg8::Unit& u, const char*& a, const char*& b, int& nt) const {
        a = A + (size_t)u.pm * 256 * LDA * 2; b = B + (size_t)u.pn * 256 * 1024 * 2; nt = 16;
    }
    static constexpr bool HAS_KEEP = false;
    __device__ __forceinline__ bool keep(const pg8::Unit&) const { return false; }
};
struct EpiG1 {
    static constexpr bool HAS_POST = false;
    bf16_t* proj; bf16_t* memkv; float* out;
    __device__ __forceinline__ void operator()(f32x4 (&acc)[2][2][4][2], const pg8::Unit& u, int wr, int wc, int fr, int fq) const {
        const int row0 = u.pm * 256 + wr * 64 + fr, col0 = u.pn * 256 + wc * 32 + 8 * fq;
        if (u.pn < 18) {
#pragma unroll
            for (int ai = 0; ai < 2; ++ai)
#pragma unroll
                for (int m = 0; m < 4; ++m) { bf16_t* rp = proj + (size_t)(row0 + ai * 128 + m * 16) * PLD + col0;
#pragma unroll
                    for (int bj = 0; bj < 2; ++bj) *(u32x4*)(rp + bj * 128) = pack8(acc[ai][bj][m][0], acc[ai][bj][m][1]); }
        } else {
            const int rr0 = row0 - HM0, cc0 = col0 - 4608;
#pragma unroll
            for (int ai = 0; ai < 2; ++ai)
#pragma unroll
                for (int m = 0; m < 4; ++m) { const int rr = rr0 + ai * 128 + m * 16;
#pragma unroll
                    for (int bj = 0; bj < 2; ++bj) { const int cc = cc0 + bj * 128;
                        *(u32x4*)(memkv + (size_t)rr * 1024 + cc) = pack8(acc[ai][bj][m][0], acc[ai][bj][m][1]);
                        float* op = out + (cc < 512 ? O_MKP + (size_t)rr * 512 + cc : O_MVP + (size_t)rr * 512 + (cc - 512));
                        *(f32x4*)op = acc[ai][bj][m][0]; *(f32x4*)(op + 4) = acc[ai][bj][m][1]; } }
        }
    }
};

struct SchedG3 {
    const char* A; const char* B; int G, c;
    __device__ __forceinline__ bool next(int i, pg8::Unit& u) const {
        const int r = i / 6, T = r * G + c; if (T >= 256) return false;
        const int xcd = T & 7, idx = T >> 3; u.pm = xcd * 8 + (idx >> 2); u.pn = idx & 3; u.sub = i - r * 6; return true;
    }
    __device__ __forceinline__ void ptrs(const pg8::Unit& u, const char*& a, const char*& b, int& nt) const {
        const int br = u.sub >> 1;
        const char* a0 = A + (size_t)u.pm * 256 * LDA * 2; const char* b0 = B + ((size_t)br * 1024 + (size_t)u.pn * 256) * 1536 * 2;
        if (u.sub & 1) { a = a0 + (A_YA + br * 512) * 2; b = b0 + 1024 * 2; nt = 8; } else { a = a0; b = b0; nt = 16; }
    }
    static constexpr bool HAS_KEEP = false;
    __device__ __forceinline__ bool keep(const pg8::Unit&) const { return false; }
};
__device__ __forceinline__ void unpack8(const u32x4 g, f32x4& g0, f32x4& g1) { g0 = (f32x4){bflo(g[0]), bfhi(g[0]), bflo(g[1]), bfhi(g[1])}; g1 = (f32x4){bflo(g[2]), bfhi(g[2]), bflo(g[3]), bfhi(g[3])}; }
struct EpiG3 {
    static constexpr bool HAS_POST = false;
    unsigned char* scr; bf16_t* merged; const float* b_gate;
    __device__ __forceinline__ void operator()(f32x4 (&acc)[2][2][4][2], const pg8::Unit& u, int wr, int wc, int fr, int fq) const {
        const int tid = threadIdx.x + opaque_zero();
        const int row0 = u.pm * 256 + wr * 64 + fr, col0 = u.pn * 256 + wc * 32 + 8 * fq + opaque_zero();
        const bool gate = (u.sub & 1) == 0; const int br = u.sub >> 1;
        GAS u32x4* s0 = (GAS u32x4*)scr + tid * 4;
        const int boff = 8192;
        const float* bp = b_gate + br * 1024 + col0;
        bf16_t* mp = merged + (size_t)row0 * 1024 + col0;
#pragma unroll
        for (int ai = 0; ai < 2; ++ai)
#pragma unroll
            for (int bj = 0; bj < 2; ++bj) {
                if (gate) {
                    const f32x4 b0 = *(const f32x4*)(bp + bj * 128), b1 = *(const f32x4*)(bp + bj * 128 + 4);
#pragma unroll
                    for (int m = 0; m < 4; ++m) { f32x4 g0, g1;
#pragma unroll
                        for (int e = 0; e < 4; ++e) { g0[e] = sigmoidf_(acc[ai][bj][m][0][e] + b0[e]); g1[e] = sigmoidf_(acc[ai][bj][m][1][e] + b1[e]); }
                        s0[boff + m] = pack8(g0, g1); }
                } else {
                    u32x4 gn[4], gm[4];
#pragma unroll
                    for (int m = 0; m < 4; ++m) { gn[m] = s0[boff + m]; gm[m] = gn[m]; }
                    if (br > 0) {
#pragma unroll
                        for (int m = 0; m < 4; ++m) gm[m] = s0[m];
                    }
#pragma unroll
                    for (int m = 0; m < 4; ++m) { f32x4 n0, n1, p0, p1; unpack8(gn[m], n0, n1); unpack8(gm[m], p0, p1);
                        f32x4 r0 = acc[ai][bj][m][0] * n0, r1 = acc[ai][bj][m][1] * n1;
                        if (br > 0) { r0 += p0; r1 += p1; }
                        const u32x4 pk = pack8(r0, r1);
                        if (br < 2) s0[m] = pk; else *(u32x4*)(mp + (size_t)(ai * 128 + m * 16) * 1024 + bj * 128) = pk; }
                }
                s0 += 2048; asm volatile("" : "+v"(s0)); __builtin_amdgcn_sched_barrier(0); }
    }
};

struct SchedG4 {
    const char* A; const char* B; int G, c;
    __device__ __forceinline__ bool next(int i, pg8::Unit& u) const {
        const int T = i * G + c; if (T >= 256) return false;
        const int xcd = T & 7, idx = T >> 3; u.pm = xcd * 8 + (idx >> 2); u.pn = idx & 3; u.sub = 0; return true;
    }
    __device__ __forceinline__ void ptrs(const pg8::Unit& u, const char*& a, const char*& b, int& nt) const {
        a = A + (size_t)u.pm * 256 * 1024 * 2; b = B + (size_t)u.pn * 256 * 1024 * 2; nt = 16;
    }
    static constexpr bool HAS_KEEP = false;
    __device__ __forceinline__ bool keep(const pg8::Unit&) const { return false; }
};
struct EpiG4 {
    static constexpr bool HAS_POST = true;
    const float* x; float* out; float* rowsq; const float* fg; unsigned* bar; unsigned epoch;
    __device__ __forceinline__ void operator()(f32x4 (&acc)[2][2][4][2], const pg8::Unit& u, int wr, int wc, int fr, int fq) const {
        const int row0 = u.pm * 256 + wr * 64 + fr + opaque_zero(), col0 = u.pn * 256 + wc * 32 + 8 * fq;
        const GAS float* xp = (const GAS float*)x + (size_t)row0 * 1024 + col0; float* rq = rowsq + row0;
#pragma unroll
        for (int ai = 0; ai < 2; ++ai) {
#pragma unroll
            for (int m = 0; m < 4; ++m) { float ss = 0.f;
#pragma unroll
                for (int bj = 0; bj < 2; ++bj) {
                    acc[ai][bj][m][0] += *(const GAS f32x4*)(xp + bj * 128); acc[ai][bj][m][1] += *(const GAS f32x4*)(xp + bj * 128 + 4);
#pragma unroll
                    for (int e = 0; e < 4; ++e) ss += acc[ai][bj][m][0][e] * acc[ai][bj][m][0][e] + acc[ai][bj][m][1][e] * acc[ai][bj][m][1][e]; }
                ss += __shfl_xor(ss, 16); ss += __shfl_xor(ss, 32);
                if (fq == 0) unsafeAtomicAdd(rq, ss);
                xp += 16 * 1024; rq += 16;
                if (m & 1) asm volatile("" : "+v"(xp), "+v"(rq)); }
            xp += 64 * 1024; rq += 64; }
    }
    __device__ __forceinline__ void post(f32x4 (&acc)[2][2][4][2], const pg8::Unit& u, int wr, int wc, int fr, int fq) const {
        fast_sync(bar, epoch);
        const int row0 = u.pm * 256 + wr * 64 + fr + opaque_zero(), col0 = u.pn * 256 + wc * 32 + 8 * fq;
        GAS float* op = (GAS float*)out + (size_t)row0 * 1024 + col0; const float* rq = rowsq + row0;
        f32x4 g[2][2];
#pragma unroll
        for (int bj = 0; bj < 2; ++bj) { g[bj][0] = *(const f32x4*)(fg + col0 + bj * 128); g[bj][1] = *(const f32x4*)(fg + col0 + bj * 128 + 4); }
#pragma unroll
        for (int ai = 0; ai < 2; ++ai) {
#pragma unroll
            for (int m = 0; m < 4; ++m) {
                const float rs = rsqrtf(__hip_atomic_load(rq, __ATOMIC_RELAXED, __HIP_MEMORY_SCOPE_AGENT) * (1.f / 1024.f) + EPS);
#pragma unroll
                for (int bj = 0; bj < 2; ++bj) { *(GAS f32x4*)(op + bj * 128) = acc[ai][bj][m][0] * rs * g[bj][0]; *(GAS f32x4*)(op + bj * 128 + 4) = acc[ai][bj][m][1] * rs * g[bj][1]; }
                op += 16 * 1024; rq += 16;
                if (m & 1) asm volatile("" : "+v"(op), "+v"(rq)); }
            op += 64 * 1024; rq += 64; }
    }
};

__device__ __forceinline__ void transpose_tile(const Params& p, LAS unsigned char* lds, int t) {
    const float* src; int sld, col0, ntn; bf16_t* dst; int dld;
    bf16_t* W1T = (bf16_t*)(p.ws + OFF_W1T); bf16_t* WG3 = (bf16_t*)(p.ws + OFF_WG3); bf16_t* WOUT = (bf16_t*)(p.ws + OFF_WOUT);
    if (t < 384) { src = p.w_in; sld = 7688; col0 = 0; ntn = 24; dst = W1T; dld = 1024; }
    else if (t < 1152) { t -= 384; src = p.w_in; sld = 7688; col0 = 1544; ntn = 48; dst = W1T + (size_t)1536 * 1024; dld = 1024; }
    else if (t < 1408) { t -= 1152; src = p.w_mem_kv; sld = 1024; col0 = 0; ntn = 16; dst = W1T + (size_t)4608 * 1024; dld = 1024; }
    else if (t < 2176) { t -= 1408; const int i = t >> 8; t &= 255; src = p.w_in; sld = 7688; col0 = 4616 + i * 1024; ntn = 16; dst = WG3 + (size_t)i * 1024 * 1536; dld = 1536; }
    else if (t < 2304) { t -= 2176; src = p.w_br_a; sld = 1024; col0 = 0; ntn = 16; dst = WG3 + 1024; dld = 1536; }
    else if (t < 2432) { t -= 2304; src = p.w_br_b; sld = 1024; col0 = 0; ntn = 16; dst = WG3 + (size_t)1 * 1024 * 1536 + 1024; dld = 1536; }
    else if (t < 2560) { t -= 2432; src = p.w_br_c; sld = 1024; col0 = 0; ntn = 16; dst = WG3 + (size_t)2 * 1024 * 1536 + 1024; dld = 1536; }
    else { t -= 2560; src = p.w_out; sld = 1024; col0 = 0; ntn = 16; dst = WOUT; dld = 1024; }
    const int k0 = (t / ntn) * 64, n0 = (t % ntn) * 64, tid = threadIdx.x;
    LAS float* tile = (LAS float*)lds;
    __syncthreads();
#pragma unroll
    for (int ps = 0; ps < 2; ++ps) { const int r = (tid >> 4) + ps * 32, c4 = (tid & 15) * 4;
        const f32x4 v = *(const f32x4*)(src + (size_t)(k0 + r) * sld + col0 + n0 + c4);
        tile[r * 65 + c4] = v[0]; tile[r * 65 + c4 + 1] = v[1]; tile[r * 65 + c4 + 2] = v[2]; tile[r * 65 + c4 + 3] = v[3]; }
    __syncthreads();
    const int n = tid >> 3, kc = (tid & 7) * 8;
    u32x4 o;
#pragma unroll
    for (int j = 0; j < 4; ++j) o[j] = cvt_pk_bf16(tile[(kc + 2 * j) * 65 + n], tile[(kc + 2 * j + 1) * 65 + n]);
    *(u32x4*)(dst + (size_t)(n0 + n) * dld + k0 + kc) = o;
}

static __device__ __forceinline__ void phase_prep(const Params& p, LAS unsigned char* lds) {
    const int tid = threadIdx.x, wg = blockIdx.x, G = gridDim.x, lane = tid & 63, wave = tid >> 6;
    float* rowsq = (float*)(p.ws + OFF_ROWSQ); unsigned* cnt = (unsigned*)(p.ws + OFF_CNT);
    for (int i = wg * 512 + tid; i < MROWS + 64; i += G * 512) { if (i < MROWS) rowsq[i] = 0.f; else cnt[i - MROWS] = 0u; }
    for (int t = wg; t < 2816; t += G) transpose_tile(p, lds, t);
    __syncthreads();
    LAS float* wb = (LAS float*)lds;
    for (int idx = tid; idx < 8192; idx += 512) { const int k = idx >> 3, j = idx & 7; wb[j * 1024 + k] = p.w_in[(size_t)k * 7688 + 1536 + j]; }
    __syncthreads();
    bf16_t* ACT = (bf16_t*)(p.ws + OFF_ACT); float* betag = (float*)(p.ws + OFF_BETAG);
    for (int row = wg * 8 + wave; row < 18560; row += G * 8) {
        const float* src; const float* gn; size_t drow;
        if (row < NP) { src = p.x_prompt + (size_t)row * 1024; gn = p.norm_g; drow = row; }
        else if (row < NP + NS) { src = p.x_sample + (size_t)(row - NP) * 1024; gn = p.norm_g; drow = row; }
        else { src = p.mem_prompt + (size_t)(row - NP - NS) * 1024; gn = p.mem_norm_g; drow = HM0 + (row - NP - NS); }
        f32x4 v[4]; float ss = 0.f;
#pragma unroll
        for (int q = 0; q < 4; ++q) { v[q] = *(const f32x4*)(src + q * 256 + lane * 4); ss += v[q][0] * v[q][0] + v[q][1] * v[q][1] + v[q][2] * v[q][2] + v[q][3] * v[q][3]; }
        ss = wave_sum(ss);
        const float rstd = rsqrtf(ss * (1.f / 1024.f) + EPS);
#pragma unroll
        for (int q = 0; q < 4; ++q) { const f32x4 g = *(const f32x4*)(gn + q * 256 + lane * 4); v[q] = v[q] * rstd * g;
            u32x2 o; o[0] = cvt_pk_bf16(v[q][0], v[q][1]); o[1] = cvt_pk_bf16(v[q][2], v[q][3]);
            *(u32x2*)(ACT + drow * LDA + q * 256 + lane * 4) = o; }
        if (row < NP + NS) {
            float d[8];
#pragma unroll
            for (int j = 0; j < 8; ++j) { float a = 0.f;
#pragma unroll
                for (int q = 0; q < 4; ++q) { const f32x4 w = *(const LAS f32x4*)(wb + j * 1024 + q * 256 + lane * 4); a += v[q][0] * w[0] + v[q][1] * w[1] + v[q][2] * w[2] + v[q][3] * w[3]; }
                d[j] = wave_sum(a); }
            float dl = d[0];
#pragma unroll
            for (int j = 1; j < 8; ++j) dl = (lane == j) ? d[j] : dl;
            if (lane < 4) betag[(size_t)row * 8 + lane] = sigmoidf_(dl);
            else if (lane < 8) { const int h = lane - 4; const float xx = dl + p.dt_bias[h]; const float sp = xx > 20.f ? xx : log1pf(expf(xx));
                betag[(size_t)row * 8 + lane] = -expf(p.a_log[h]) * sp; }
        }
    }
}

static __device__ __forceinline__ void delta_chunk_item(const Params& p, LAS unsigned char* lds, int ci) {
    const int tid = threadIdx.x, lane = tid & 63, wave = tid >> 6, l16 = lane & 15, quad = lane >> 4;
    const int bh = ci >> 5, n = ci & 31, b = bh >> 2, h = bh & 3;
    const bf16_t* PROJ = (const bf16_t*)(p.ws + OFF_PROJ); const float* betag = (const float*)(p.ws + OFF_BETAG);
    bf16_t* U = (bf16_t*)((unsigned char*)p.out + DO_U) + (size_t)ci * 8192; bf16_t* W = (bf16_t*)((unsigned char*)p.out + DO_W) + (size_t)ci * 8192;
    bf16_t* QD = (bf16_t*)((unsigned char*)p.out + DO_QD) + (size_t)ci * 8192; bf16_t* KDT = (bf16_t*)((unsigned char*)p.out + DO_KDT) + (size_t)ci * 8192;
    bf16_t* ATT = (bf16_t*)(p.ws + OFF_ATTN) + (size_t)ci * 4096; float* GL = (float*)(p.ws + OFF_GL);
    LAS bf16_t* Kb = (LAS bf16_t*)lds; LAS bf16_t* Qb = (LAS bf16_t*)(lds + 17408);
    LAS float* RHS = (LAS float*)(lds + 34816);
    LAS float* Lm = (LAS float*)(lds + 100352);
    LAS float* gcs = (LAS float*)(lds + 116736); LAS float* bts = gcs + 64;
    const int trow0 = b * 2048 + n * 64;
    __syncthreads();
    if (wave == 0) {
        float g = betag[(size_t)(trow0 + lane) * 8 + 4 + h];
#pragma unroll
        for (int o = 1; o < 64; o <<= 1) { const float t = __shfl_up(g, o); if (lane >= o) g += t; }
        gcs[lane] = g; bts[lane] = betag[(size_t)(trow0 + lane) * 8 + h];
        if (lane == 63) GL[ci] = __expf(g);
    }
    __syncthreads();
    {
        const int t = tid >> 3, cc = (tid & 7) * 16;
        const float gct = gcs[t], bet = bts[t], eg = __expf(gct);
#pragma unroll 1
        for (int sec = 0; sec < 3; ++sec) {
            const int col = sec * 512 + h * 128 + cc;
            float y[16];
#pragma unroll
            for (int e = 0; e < 16; ++e) y[e] = 0.f;
#pragma unroll
            for (int j = 0; j < 4; ++j) { const int tl = n * 64 + t - 3 + j;
                if (tl >= 0) { const bf16_t* rp = PROJ + (size_t)(b * 2048 + tl) * PLD + col; const u32x4 x0 = *(const u32x4*)rp, x1 = *(const u32x4*)(rp + 8);
                    const float* wp = p.conv_w + j * 1536 + col;
#pragma unroll
                    for (int e = 0; e < 4; ++e) { const f32x4 w = *(const f32x4*)(wp + e * 4); const unsigned ua = (e < 2 ? x0[2 * e] : x1[2 * e - 4]), ub = (e < 2 ? x0[2 * e + 1] : x1[2 * e - 3]);
                        y[e * 4] += bflo(ua) * w[0]; y[e * 4 + 1] += bfhi(ua) * w[1]; y[e * 4 + 2] += bflo(ub) * w[2]; y[e * 4 + 3] += bfhi(ub) * w[3]; } } }
            float ss = 0.f;
#pragma unroll
            for (int e = 0; e < 16; ++e) { y[e] = siluf_(y[e]); ss += y[e] * y[e]; }
            if (sec < 2) { ss += __shfl_xor(ss, 1); ss += __shfl_xor(ss, 2); ss += __shfl_xor(ss, 4);
                const float sc = rsqrtf(ss + EPS) * (sec == 0 ? 0.08838834764831845f : 1.f);
#pragma unroll
                for (int e = 0; e < 16; ++e) y[e] *= sc; }
            if (sec == 0) {
                u32x4 o0, o1, d0, d1;
#pragma unroll
                for (int e = 0; e < 4; ++e) { o0[e] = cvt_pk_bf16(y[2 * e], y[2 * e + 1]); o1[e] = cvt_pk_bf16(y[8 + 2 * e], y[9 + 2 * e]);
                    d0[e] = cvt_pk_bf16(y[2 * e] * eg, y[2 * e + 1] * eg); d1[e] = cvt_pk_bf16(y[8 + 2 * e] * eg, y[9 + 2 * e] * eg); }
                *(LAS u32x4*)(Qb + t * 136 + cc) = o0; *(LAS u32x4*)(Qb + t * 136 + cc + 8) = o1;
                *(u32x4*)(QD + t * 128 + cc) = d0; *(u32x4*)(QD + t * 128 + cc + 8) = d1;
            } else if (sec == 1) {
                u32x4 o0, o1;
#pragma unroll
                for (int e = 0; e < 4; ++e) { o0[e] = cvt_pk_bf16(y[2 * e], y[2 * e + 1]); o1[e] = cvt_pk_bf16(y[8 + 2 * e], y[9 + 2 * e]); }
                *(LAS u32x4*)(Kb + t * 136 + cc) = o0; *(LAS u32x4*)(Kb + t * 136 + cc + 8) = o1;
                const float s2 = bet * eg;
#pragma unroll
                for (int e = 0; e < 4; ++e) *(LAS f32x4*)(RHS + t * 256 + 128 + cc + e * 4) = (f32x4){y[e * 4] * s2, y[e * 4 + 1] * s2, y[e * 4 + 2] * s2, y[e * 4 + 3] * s2};
            } else {
#pragma unroll
                for (int e = 0; e < 4; ++e) *(LAS f32x4*)(RHS + t * 256 + cc + e * 4) = (f32x4){y[e * 4] * bet, y[e * 4 + 1] * bet, y[e * 4 + 2] * bet, y[e * 4 + 3] * bet};
            }
        }
    }
    __syncthreads();
    {
        const int sel = wave >> 2, it = wave & 3;
        LAS unsigned char* Xb = lds + (sel ? 17408 : 0);
        bf16x8 af[4];
#pragma unroll
        for (int ks = 0; ks < 4; ++ks) af[ks] = lds8(Xb, ((it * 16 + l16) * 136 + ks * 32 + quad * 8) * 2);
#pragma unroll
        for (int jt = 0; jt < 4; ++jt) {
            f32x4 a = {0.f, 0.f, 0.f, 0.f};
            if (jt <= it) {
                if (sel == 0) {
#pragma unroll
                    for (int ks = 0; ks < 4; ++ks) a = mfma16(af[ks], lds8(lds, ((jt * 16 + l16) * 136 + ks * 32 + quad * 8) * 2), a);
                } else {
#pragma unroll
                    for (int ks = 0; ks < 4; ++ks) a = mfma16(lds8(lds, ((jt * 16 + l16) * 136 + ks * 32 + quad * 8) * 2), af[ks], a);
                }
            }
            if (sel == 0) {
                const int j = jt * 16 + l16; const float gj = gcs[j];
#pragma unroll
                for (int r = 0; r < 4; ++r) { const int i = it * 16 + quad * 4 + r;
                    const float dec = (i >= j) ? __expf(gcs[i] - gj) : 0.f;
                    Lm[i * 64 + j] = (i > j) ? bts[i] * a[r] * dec : 0.f; }
            } else {
                const int i = it * 16 + l16; const float gi = gcs[i]; float o4[4];
#pragma unroll
                for (int r = 0; r < 4; ++r) { const int j = jt * 16 + quad * 4 + r; o4[r] = (i >= j) ? a[r] * __expf(gi - gcs[j]) : 0.f; }
                u32x2 w; w[0] = cvt_pk_bf16(o4[0], o4[1]); w[1] = cvt_pk_bf16(o4[2], o4[3]);
                *(u32x2*)(ATT + i * 64 + jt * 16 + quad * 4) = w;
            }
        }
    }
    {
        const int d = tid >> 2, tq = (tid & 3) * 16; const float gl = gcs[63];
        u32x4 o0, o1;
#pragma unroll
        for (int e = 0; e < 8; ++e) { const int t0 = tq + 2 * e;
            const unsigned v = cvt_pk_bf16(bf2f(Kb[t0 * 136 + d]) * __expf(gl - gcs[t0]), bf2f(Kb[(t0 + 1) * 136 + d]) * __expf(gl - gcs[t0 + 1]));
            if (e < 4) o0[e] = v; else o1[e - 4] = v; }
        *(u32x4*)(KDT + d * 64 + tq) = o0; *(u32x4*)(KDT + d * 64 + tq + 8) = o1;
    }
    __syncthreads();
    if (wave < 4 && (p.mask & 32)) {
        const int col = tid;
        const LAS float* Lz = Lm + opaque_zero();
        float x[64];
#pragma unroll
        for (int i = 0; i < 64; ++i) {
            f32x4 lr[16];
#pragma unroll
            for (int j4 = 0; j4 < (i + 3) / 4; ++j4) lr[j4] = *(const LAS f32x4*)(Lz + i * 64 + j4 * 4);
            const float rcur = RHS[i * 256 + col];
            __builtin_amdgcn_sched_barrier(0);
            float s4[4] = {0.f, 0.f, 0.f, 0.f};
#pragma unroll
            for (int j4 = 0; j4 < (i + 3) / 4; ++j4) {
#pragma unroll
                for (int e = 0; e < 4; ++e) if (j4 * 4 + e < i) s4[e] += lr[j4][e] * x[j4 * 4 + e]; }
            x[i] = rcur - ((s4[0] + s4[1]) + (s4[2] + s4[3]));
            __builtin_amdgcn_sched_barrier(0);
        }
#pragma unroll
        for (int i = 0; i < 64; ++i) RHS[i * 256 + col] = x[i];
    }
    __syncthreads();
#pragma unroll
    for (int q = 0; q < 4; ++q) { const int idx = tid + 512 * q, which = idx >> 10, rem = idx & 1023, i = rem >> 4, c8 = (rem & 15) * 8;
        const f32x4 a = *(const LAS f32x4*)(RHS + i * 256 + which * 128 + c8), b = *(const LAS f32x4*)(RHS + i * 256 + which * 128 + c8 + 4);
        *(u32x4*)((which ? W : U) + i * 128 + c8) = pack8(a, b); }
}

static __device__ __forceinline__ void phase_delta_pre(const Params& p, LAS unsigned char* lds) {
    const int wg = blockIdx.x, G = gridDim.x, tid = threadIdx.x;
    const bf16_t* PROJ = (const bf16_t*)(p.ws + OFF_PROJ);
    for (int i = wg * 512 + tid; i < 8 * 3 * 1536; i += G * 512) { const int b = i / 4608, r = i % 4608, j = r / 1536, ch = r % 1536;
        p.out[O_SCP + i] = bf2f(PROJ[(size_t)(b * 2048 + 2045 + j) * PLD + ch]); }
    for (int ci = wg; ci < 1024; ci += G) delta_chunk_item(p, lds, ci);
}

struct ScanFr { bf16x8 w[4], qd[4], at[2], kd[2][2]; u32x2 u[2]; };
__device__ __forceinline__ void scan_load(ScanFr& f, const Params& p, int ci, int vb, int vp, int tt, int dtb, int l16, int quad) {
    const bf16_t* U = (const bf16_t*)((const unsigned char*)p.out + DO_U) + (size_t)ci * 8192; const bf16_t* W = (const bf16_t*)((const unsigned char*)p.out + DO_W) + (size_t)ci * 8192;
    const bf16_t* QD = (const bf16_t*)((const unsigned char*)p.out + DO_QD) + (size_t)ci * 8192; const bf16_t* KDT = (const bf16_t*)((const unsigned char*)p.out + DO_KDT) + (size_t)ci * 8192;
    const bf16_t* ATT = (const bf16_t*)(p.ws + OFF_ATTN) + (size_t)ci * 4096;
#pragma unroll
    for (int ks = 0; ks < 4; ++ks) { f.w[ks] = ldg8(W + (tt * 16 + l16) * 128 + ks * 32 + quad * 8); f.qd[ks] = ldg8(QD + (tt * 16 + l16) * 128 + ks * 32 + quad * 8); }
#pragma unroll
    for (int ks = 0; ks < 2; ++ks) { f.at[ks] = ldg8(ATT + (tt * 16 + l16) * 64 + ks * 32 + quad * 8);
#pragma unroll
        for (int d = 0; d < 2; ++d) f.kd[d][ks] = ldg8(KDT + ((dtb + d) * 16 + l16) * 64 + ks * 32 + quad * 8); }
#pragma unroll
    for (int j = 0; j < 2; ++j) f.u[j] = *(const u32x2*)(U + (tt * 16 + l16) * 128 + vb * 64 + (vp * 2 + j) * 16 + quad * 4);
}
static __device__ __forceinline__ void scan_unit(const Params& p, LAS unsigned char* lds, int unit) {
    const int tid = threadIdx.x, lane = tid & 63, wave = tid >> 6, l16 = lane & 15, quad = lane >> 4;
    const int bh = unit >> 1, vb = unit & 1, b = bh >> 2, h = bh & 3;
    const int vp = wave & 1, tt = wave >> 1, dtb = (wave >> 1) * 2;
    LAS bf16_t* STs = (LAS bf16_t*)lds;
    LAS bf16_t* vnT = (LAS bf16_t*)(lds + 17408);
    bf16_t* PROJ = (bf16_t*)(p.ws + OFF_PROJ); const float* GL = (const float*)(p.ws + OFF_GL);
    __syncthreads();
    for (int i = tid; i < 64 * 136 / 2; i += 512) ((LAS unsigned*)STs)[i] = 0u;
    f32x4 accS[2][2];
#pragma unroll
    for (int j = 0; j < 2; ++j)
#pragma unroll
        for (int d = 0; d < 2; ++d) accS[j][d] = (f32x4){0.f, 0.f, 0.f, 0.f};
    const int ci0 = bh * 32;
    const float glv = GL[ci0 + (lane & 31)];
    ScanFr cur, nxt;
    scan_load(cur, p, ci0, vb, vp, tt, dtb, l16, quad);
    nxt = cur;
    __syncthreads();
    for (int n = 0; n < 32; ++n) {
        if (n + 1 < 32) scan_load(nxt, p, ci0 + n + 1, vb, vp, tt, dtb, l16, quad);
        const float gl = __shfl(glv, n);
        f32x4 aW[2], aQ[2];
#pragma unroll
        for (int j = 0; j < 2; ++j) { aW[j] = (f32x4){0.f, 0.f, 0.f, 0.f}; aQ[j] = (f32x4){0.f, 0.f, 0.f, 0.f};
#pragma unroll
            for (int ks = 0; ks < 4; ++ks) { const bf16x8 a = lds8(lds, (((vp * 2 + j) * 16 + l16) * 136 + ks * 32 + quad * 8) * 2); aW[j] = mfma16(a, cur.w[ks], aW[j]); aQ[j] = mfma16(a, cur.qd[ks], aQ[j]); } }
#pragma unroll
        for (int j = 0; j < 2; ++j) { const int vr = (vp * 2 + j) * 16 + quad * 4, tc = tt * 16 + l16;
            vnT[(vr + 0) * 72 + tc] = f2bf(bflo(cur.u[j][0]) - aW[j][0]); vnT[(vr + 1) * 72 + tc] = f2bf(bfhi(cur.u[j][0]) - aW[j][1]);
            vnT[(vr + 2) * 72 + tc] = f2bf(bflo(cur.u[j][1]) - aW[j][2]); vnT[(vr + 3) * 72 + tc] = f2bf(bfhi(cur.u[j][1]) - aW[j][3]); }
        asm volatile("s_waitcnt lgkmcnt(0)" ::: "memory"); __builtin_amdgcn_s_barrier(); asm volatile("" ::: "memory");
#pragma unroll
        for (int j = 0; j < 2; ++j) { accS[j][0] *= gl; accS[j][1] *= gl;
#pragma unroll
            for (int ks = 0; ks < 2; ++ks) { const bf16x8 a = lds8(lds, 17408 + (((vp * 2 + j) * 16 + l16) * 72 + ks * 32 + quad * 8) * 2);
                aQ[j] = mfma16(a, cur.at[ks], aQ[j]); accS[j][0] = mfma16(a, cur.kd[0][ks], accS[j][0]); accS[j][1] = mfma16(a, cur.kd[1][ks], accS[j][1]); }
            u32x2 o; o[0] = cvt_pk_bf16(aQ[j][0], aQ[j][1]); o[1] = cvt_pk_bf16(aQ[j][2], aQ[j][3]);
            *(u32x2*)(PROJ + (size_t)(b * 2048 + n * 64 + tt * 16 + l16) * PLD + C_AQ + h * 128 + vb * 64 + (vp * 2 + j) * 16 + quad * 4) = o;
#pragma unroll
            for (int d = 0; d < 2; ++d)
#pragma unroll
                for (int r = 0; r < 4; ++r) STs[((vp * 2 + j) * 16 + quad * 4 + r) * 136 + (dtb + d) * 16 + l16] = f2bf(accS[j][d][r]); }
        asm volatile("s_waitcnt lgkmcnt(0)" ::: "memory"); __builtin_amdgcn_s_barrier(); asm volatile("" ::: "memory");
        cur = nxt;
    }
    float* sdp = p.out + O_SDP + (size_t)bh * 16384;
#pragma unroll
    for (int j = 0; j < 2; ++j)
#pragma unroll
        for (int d = 0; d < 2; ++d) *(f32x4*)(sdp + (size_t)((dtb + d) * 16 + l16) * 128 + vb * 64 + (vp * 2 + j) * 16 + quad * 4) = accS[j][d];
}

static __device__ __forceinline__ void sample_delta_item(const Params& p, LAS unsigned char* lds, int it) {
    const int tid = threadIdx.x, b = it >> 2, h = it & 3;
    const bf16_t* PROJ = (const bf16_t*)(p.ws + OFF_PROJ); const float* betag = (const float*)(p.ws + OFF_BETAG); bf16_t* ACT = (bf16_t*)(p.ws + OFF_ACT);
    LAS float* qkv = (LAS float*)lds;
    LAS float* red = (LAS float*)(lds + 2048);
    LAS float* fin = (LAS float*)(lds + 2048 + 16384);
    LAS float* sc = (LAS float*)(lds + 2048 + 16384 + 1024);
    const size_t prow = (size_t)(NP + b) * PLD;
    __syncthreads();
    float yv = 0.f;
    if (tid < 384) { const int sec = tid >> 7, c = tid & 127, ch = sec * 512 + h * 128 + c;
        const float b0 = p.state_conv[(size_t)(b * 3 + 0) * 1536 + ch], b1 = p.state_conv[(size_t)(b * 3 + 1) * 1536 + ch], b2 = p.state_conv[(size_t)(b * 3 + 2) * 1536 + ch];
        const float xn = bf2f(PROJ[prow + ch]);
        float y = b0 * p.conv_w[ch] + b1 * p.conv_w[1536 + ch] + b2 * p.conv_w[3072 + ch] + xn * p.conv_w[4608 + ch];
        yv = siluf_(y);
        float* scs = p.out + O_SCS + (size_t)b * 4608;
        scs[ch] = b1; scs[1536 + ch] = b2; scs[3072 + ch] = xn;
    }
    {
        float ss = wave_sum(yv * yv);
        if ((tid & 63) == 0) sc[8 + (tid >> 6)] = ss;
    }
    __syncthreads();
    if (tid < 384) { const int sec = tid >> 7, c = tid & 127;
        float v = yv;
        if (sec == 0) v *= rsqrtf(sc[8] + sc[9] + EPS) * 0.08838834764831845f;
        else if (sec == 1) v *= rsqrtf(sc[10] + sc[11] + EPS);
        qkv[sec * 128 + c] = v; }
    __syncthreads();
    const int dvq = tid & 31, dkg = tid >> 5;
    const float* S0 = p.state_delta + (size_t)it * 16384;
    f32x4 s[8]; f32x4 pk = {0.f, 0.f, 0.f, 0.f}, pq = {0.f, 0.f, 0.f, 0.f};
#pragma unroll
    for (int j = 0; j < 8; ++j) { const int dk = dkg * 8 + j; s[j] = *(const f32x4*)(S0 + (size_t)dk * 128 + dvq * 4); pk += s[j] * qkv[128 + dk]; pq += s[j] * qkv[dk]; }
    *(LAS f32x4*)(red + dkg * 256 + dvq * 4) = pk; *(LAS f32x4*)(red + dkg * 256 + 128 + dvq * 4) = pq;
    {
        float qk = (tid < 128) ? qkv[tid] * qkv[128 + tid] : 0.f; qk = wave_sum(qk);
        if (tid < 128 && (tid & 63) == 0) sc[tid >> 6] = qk;
    }
    __syncthreads();
    const float beta = betag[(size_t)(NP + b) * 8 + h], a = __expf(betag[(size_t)(NP + b) * 8 + 4 + h]);
    if (tid < 128) { float sk = 0.f, sq = 0.f;
#pragma unroll
        for (int g = 0; g < 16; ++g) { sk += red[g * 256 + tid]; sq += red[g * 256 + 128 + tid]; }
        const float vn = beta * (qkv[256 + tid] - a * sk); const float o = a * sq + (sc[0] + sc[1]) * vn;
        fin[tid] = vn; fin[128 + tid] = o;
        const float oo = wave_sum(o * o); if ((tid & 63) == 0) sc[4 + (tid >> 6)] = oo; }
    __syncthreads();
    const f32x4 vn4 = *(const LAS f32x4*)(fin + dvq * 4);
    float* Sn = p.out + O_SDS + (size_t)it * 16384;
#pragma unroll
    for (int j = 0; j < 8; ++j) { const int dk = dkg * 8 + j; *(f32x4*)(Sn + (size_t)dk * 128 + dvq * 4) = s[j] * a + vn4 * qkv[128 + dk]; }
    if (tid < 128) { const float rstd = rsqrtf((sc[4] + sc[5]) * (1.f / 128.f) + EPS);
        const float gt = bf2f(PROJ[prow + C_AGATE + h * 128 + tid]);
        ACT[(size_t)(NP + b) * LDA + A_YA + h * 128 + tid] = f2bf(fin[128 + tid] * rstd * p.a_norm_g[tid] * siluf_(gt)); }
}

static __device__ __forceinline__ void sample_xattn_item(const Params& p, LAS unsigned char* lds, int it) {
    const int tid = threadIdx.x, lane = tid & 63, wave = tid >> 6, b = it >> 2, h = it & 3;
    const bf16_t* PROJ = (const bf16_t*)(p.ws + OFF_PROJ); bf16_t* ACT = (bf16_t*)(p.ws + OFF_ACT);
    LAS float* scr = (LAS float*)lds;
    LAS float* red = (LAS float*)(lds + 1024);
    const int half = lane >> 5, dl = lane & 31;
    const size_t prow = (size_t)(NP + b) * PLD;
    f32x4 q; { const bf16_t* qp = PROJ + prow + C_CQ + h * 128 + dl * 4; const u32x2 u = *(const u32x2*)qp; q = (f32x4){bflo(u[0]), bfhi(u[0]), bflo(u[1]), bfhi(u[1])}; }
    const float* Kp = p.cache_k + ((size_t)(b * 256) * 4 + h) * 128 + dl * 4; const float* Vp = p.cache_v + ((size_t)(b * 256) * 4 + h) * 128 + dl * 4;
    __syncthreads();
    f32x4 kv[16];
#pragma unroll
    for (int i = 0; i < 16; ++i) { const int m = wave * 32 + i * 2 + half; kv[i] = *(const f32x4*)(Kp + (size_t)m * 512); }
#pragma unroll
    for (int i = 0; i < 16; ++i) { float d = kv[i][0] * q[0] + kv[i][1] * q[1] + kv[i][2] * q[2] + kv[i][3] * q[3];
#pragma unroll
        for (int o = 16; o >= 1; o >>= 1) d += __shfl_xor(d, o);
        if (dl == 0) scr[wave * 32 + i * 2 + half] = d * 0.08838834764831845f; }
#pragma unroll
    for (int i = 0; i < 16; ++i) { const int m = wave * 32 + i * 2 + half; kv[i] = *(const f32x4*)(Vp + (size_t)m * 512); }
    __syncthreads();
    float mx = -3.0e38f;
#pragma unroll
    for (int i = 0; i < 4; ++i) mx = fmaxf(mx, scr[lane + 64 * i]);
#pragma unroll
    for (int o = 32; o >= 1; o >>= 1) mx = fmaxf(mx, __shfl_xor(mx, o));
    float sm = 0.f;
#pragma unroll
    for (int i = 0; i < 4; ++i) sm += __expf(scr[lane + 64 * i] - mx);
    sm = wave_sum(sm);
    const float inv = 1.f / sm;
    f32x4 o = {0.f, 0.f, 0.f, 0.f};
#pragma unroll
    for (int i = 0; i < 16; ++i) { const float pr = __expf(scr[wave * 32 + i * 2 + half] - mx) * inv; o += kv[i] * pr; }
    *(LAS f32x4*)(red + (wave * 2 + half) * 128 + dl * 4) = o;
    __syncthreads();
    if (tid < 128) { float s = 0.f;
#pragma unroll
        for (int g = 0; g < 16; ++g) s += red[g * 128 + tid];
        const float gt = bf2f(PROJ[prow + C_CGATE + h * 128 + tid]);
        ACT[(size_t)(NP + b) * LDA + A_YC + h * 128 + tid] = f2bf(s * siluf_(gt)); }
}

static __device__ __forceinline__ void sample_mlp_item(const Params& p, int it) {
    const int tid = threadIdx.x, lane = tid & 63, wave = tid >> 6, b = it * 8 + wave;
    const bf16_t* PROJ = (const bf16_t*)(p.ws + OFF_PROJ); bf16_t* ACT = (bf16_t*)(p.ws + OFF_ACT);
    const size_t prow = (size_t)(NP + b) * PLD; const int c0 = lane * 8;
    const u32x4 xv = *(const u32x4*)(PROJ + prow + C_BV + c0), xu = *(const u32x4*)(PROJ + prow + C_BU + c0), xg = *(const u32x4*)(PROJ + prow + C_BGATE + c0);
    float v[8], s1 = 0.f, s2 = 0.f;
#pragma unroll
    for (int e = 0; e < 4; ++e) { v[2 * e] = bflo(xv[e]); v[2 * e + 1] = bfhi(xv[e]); }
#pragma unroll
    for (int e = 0; e < 8; ++e) s1 += v[e];
    s1 = wave_sum(s1); const float mu = s1 * (1.f / 512.f);
#pragma unroll
    for (int e = 0; e < 8; ++e) { v[e] -= mu; s2 += v[e] * v[e]; }
    s2 = wave_sum(s2); const float rstd = rsqrtf(s2 * (1.f / 512.f) + EPS);
    const int g = c0 >> 7; const float w00 = p.w_spatial[(size_t)g * 16384], bs = p.b_spatial[g * 128];
    float* cvs = p.out + O_CVS + (size_t)b * 512 + c0;
    u32x4 o;
#pragma unroll
    for (int e = 0; e < 4; ++e) { float r[2];
#pragma unroll
        for (int z = 0; z < 2; ++z) { const int c = c0 + 2 * e + z; const float vn = v[2 * e + z] * rstd * p.ln_v_g[c] + p.ln_v_b[c]; cvs[2 * e + z] = vn;
            const float uu = z ? bfhi(xu[e]) : bflo(xu[e]), gg = z ? bfhi(xg[e]) : bflo(xg[e]); r[z] = uu * (w00 * vn + bs) * siluf_(gg); }
        o[e] = cvt_pk_bf16(r[0], r[1]); }
    *(u32x4*)(ACT + (size_t)(NP + b) * LDA + A_YB + c0) = o;
}

static __device__ __forceinline__ void mlp_item(const Params& p, LAS unsigned char* lds, int it) {
    const int tid = threadIdx.x, lane = tid & 63, wave = tid >> 6, l16 = lane & 15, quad = lane >> 4;
    const int row0 = (it >> 4) * 2048 + (it & 15) * 128;
    const bf16_t* PROJ = (const bf16_t*)(p.ws + OFF_PROJ); bf16_t* ACT = (bf16_t*)(p.ws + OFF_ACT);
    LAS bf16_t* vnT = (LAS bf16_t*)lds;
    LAS bf16_t* Wsm = (LAS bf16_t*)(lds + 34816);
    LAS float* st = (LAS float*)(lds + 69632);
    __syncthreads();
    { const int r = tid >> 2, part = tid & 3; const bf16_t* rp = PROJ + (size_t)(row0 + r) * PLD + C_BV + part * 128; float s1 = 0.f, s2 = 0.f;
#pragma unroll
      for (int i = 0; i < 16; ++i) { const u32x4 x = *(const u32x4*)(rp + i * 8);
#pragma unroll
          for (int e = 0; e < 4; ++e) { const float a = bflo(x[e]), c = bfhi(x[e]); s1 += a + c; s2 += a * a + c * c; } }
      s1 += __shfl_xor(s1, 1); s1 += __shfl_xor(s1, 2); s2 += __shfl_xor(s2, 1); s2 += __shfl_xor(s2, 2);
      const float mu = s1 * (1.f / 512.f); const float var = fmaxf(s2 * (1.f / 512.f) - mu * mu, 0.f);
      if (part == 0) { st[r * 2] = mu; st[r * 2 + 1] = rsqrtf(var + EPS); } }
    __syncthreads();
#pragma unroll 1
    for (int g = 0; g < 4; ++g) {
        { const int s = lane + 64 * (wave & 1), cq = (wave >> 1) * 32; const float mu = st[s * 2], rstd = st[s * 2 + 1];
          const bf16_t* rp = PROJ + (size_t)(row0 + s) * PLD + C_BV + g * 128 + cq;
#pragma unroll
          for (int i = 0; i < 4; ++i) { const u32x4 x = *(const u32x4*)(rp + i * 8);
#pragma unroll
              for (int e = 0; e < 4; ++e) { const int c = cq + i * 8 + 2 * e; const int gc = g * 128 + c;
                  vnT[c * 136 + s] = f2bf((bflo(x[e]) - mu) * rstd * p.ln_v_g[gc] + p.ln_v_b[gc]);
                  vnT[(c + 1) * 136 + s] = f2bf((bfhi(x[e]) - mu) * rstd * p.ln_v_g[gc + 1] + p.ln_v_b[gc + 1]); } }
          const int t = tid >> 2, sq = (tid & 3) * 32; const float* wp = p.w_spatial + ((size_t)g * 128 + t) * 128 + sq;
#pragma unroll
          for (int i = 0; i < 4; ++i) { const f32x4 w0 = *(const f32x4*)(wp + i * 8), w1 = *(const f32x4*)(wp + i * 8 + 4); const int s0 = sq + i * 8;
              f32x4 m0, m1;
#pragma unroll
              for (int e = 0; e < 4; ++e) { m0[e] = (s0 + e <= t) ? w0[e] : 0.f; m1[e] = (s0 + 4 + e <= t) ? w1[e] : 0.f; }
              *(LAS u32x4*)(Wsm + t * 136 + s0) = pack8(m0, m1); } }
        __syncthreads();
        f32x4 acc[8];
#pragma unroll
        for (int ct = 0; ct < 8; ++ct) acc[ct] = (f32x4){0.f, 0.f, 0.f, 0.f};
        const int nks = (wave >> 1) + 1;
        for (int ks = 0; ks < nks; ++ks) { const bf16x8 bw = lds8(lds, 34816 + ((wave * 16 + l16) * 136 + ks * 32 + quad * 8) * 2);
#pragma unroll
            for (int ct = 0; ct < 8; ++ct) acc[ct] = mfma16(lds8(lds, ((ct * 16 + l16) * 136 + ks * 32 + quad * 8) * 2), bw, acc[ct]); }
        const int t = wave * 16 + l16; const size_t prow = (size_t)(row0 + t) * PLD; const float bs = p.b_spatial[g * 128 + t];
#pragma unroll
        for (int ct = 0; ct < 8; ++ct) { const int col = g * 128 + ct * 16 + quad * 4;
            const u32x2 xu = *(const u32x2*)(PROJ + prow + C_BU + col), xg = *(const u32x2*)(PROJ + prow + C_BGATE + col);
            u32x2 o; o[0] = cvt_pk_bf16(bflo(xu[0]) * (acc[ct][0] + bs) * siluf_(bflo(xg[0])), bfhi(xu[0]) * (acc[ct][1] + bs) * siluf_(bfhi(xg[0])));
            o[1] = cvt_pk_bf16(bflo(xu[1]) * (acc[ct][2] + bs) * siluf_(bflo(xg[1])), bfhi(xu[1]) * (acc[ct][3] + bs) * siluf_(bfhi(xg[1])));
            *(u32x2*)(ACT + (size_t)(row0 + t) * LDA + A_YB + col) = o; }
        __syncthreads();
    }
}

static __device__ __forceinline__ void xattn_item(const Params& p, LAS unsigned char* lds, int it) {
    const int tid = threadIdx.x, lane = tid & 63, wave = tid >> 6, l16 = lane & 15, quad = lane >> 4;
    const int b = it >> 6, h = (it >> 4) & 3, qt = it & 15;
    const bf16_t* PROJ = (const bf16_t*)(p.ws + OFF_PROJ); bf16_t* ACT = (bf16_t*)(p.ws + OFF_ACT); const bf16_t* MKV = (const bf16_t*)(p.ws + OFF_MEMKV);
    LAS bf16_t* Ks = (LAS bf16_t*)lds;
    LAS bf16_t* Vt = (LAS bf16_t*)(lds + 69632);
    __syncthreads();
#pragma unroll
    for (int i = 0; i < 8; ++i) { const int idx = wave * 8 + i, m = (idx & 3) * 64 + lane, dc = (idx >> 2) * 8; const bf16_t* sp = MKV + (size_t)(b * 256 + m) * 1024 + h * 128 + dc;
        *(LAS u32x4*)(Ks + m * 136 + dc) = *(const u32x4*)sp;
        const u32x4 v = *(const u32x4*)(sp + 512);
#pragma unroll
        for (int e = 0; e < 4; ++e) { Vt[(dc + 2 * e) * 264 + m] = (bf16_t)(v[e] & 0xffffu); Vt[(dc + 2 * e + 1) * 264 + m] = (bf16_t)(v[e] >> 16); } }
    const int q0 = b * 2048 + qt * 128 + wave * 16; const size_t prow = (size_t)(q0 + l16) * PLD;
    bf16x8 qf[4];
#pragma unroll
    for (int ks = 0; ks < 4; ++ks) qf[ks] = ldg8(PROJ + prow + C_CQ + h * 128 + ks * 32 + quad * 8);
    __syncthreads();
    f32x4 s[16];
#pragma unroll
    for (int mt = 0; mt < 16; ++mt) { s[mt] = (f32x4){0.f, 0.f, 0.f, 0.f};
#pragma unroll
        for (int ks = 0; ks < 4; ++ks) s[mt] = mfma16(lds8(lds, ((mt * 16 + l16) * 136 + ks * 32 + quad * 8) * 2), qf[ks], s[mt]); }
    float mx = -3.0e38f;
#pragma unroll
    for (int mt = 0; mt < 16; ++mt)
#pragma unroll
        for (int r = 0; r < 4; ++r) mx = fmaxf(mx, s[mt][r]);
    mx = fmaxf(mx, __shfl_xor(mx, 16)); mx = fmaxf(mx, __shfl_xor(mx, 32));
    const float sc = 0.08838834764831845f * 1.4426950408889634f; float sm = 0.f;
#pragma unroll
    for (int mt = 0; mt < 16; ++mt)
#pragma unroll
        for (int r = 0; r < 4; ++r) { s[mt][r] = exp2f((s[mt][r] - mx) * sc); sm += s[mt][r]; }
    sm += __shfl_xor(sm, 16); sm += __shfl_xor(sm, 32);
    const float inv = 1.f / sm;
    bf16x8 pb[8];
#pragma unroll
    for (int ss = 0; ss < 8; ++ss) { const u32x4 pu = pack8(s[2 * ss], s[2 * ss + 1]); pb[ss] = __builtin_bit_cast(bf16x8, pu); }
#pragma unroll 1
    for (int dt = 0; dt < 8; ++dt) {
        f32x4 o = {0.f, 0.f, 0.f, 0.f};
#pragma unroll
        for (int ss = 0; ss < 8; ++ss) { const bf16x4 v0 = *(const LAS bf16x4*)(Vt + (dt * 16 + l16) * 264 + ss * 32 + quad * 4), v1 = *(const LAS bf16x4*)(Vt + (dt * 16 + l16) * 264 + ss * 32 + 16 + quad * 4);
            o = mfma16(__builtin_shufflevector(v0, v1, 0, 1, 2, 3, 4, 5, 6, 7), pb[ss], o); }
        const int col = h * 128 + dt * 16 + quad * 4; const u32x2 xg = *(const u32x2*)(PROJ + prow + C_CGATE + col);
        u32x2 w; w[0] = cvt_pk_bf16(o[0] * inv * siluf_(bflo(xg[0])), o[1] * inv * siluf_(bfhi(xg[0])));
        w[1] = cvt_pk_bf16(o[2] * inv * siluf_(bflo(xg[1])), o[3] * inv * siluf_(bfhi(xg[1])));
        *(u32x2*)(ACT + (size_t)(q0 + l16) * LDA + A_YC + col) = w;
        __builtin_amdgcn_sched_barrier(0); }
}

static __device__ __forceinline__ void phase_mixers(const Params& p, LAS unsigned char* lds) {
    const int wg = blockIdx.x, G = gridDim.x, tid = threadIdx.x;
    if (p.mask & 1) for (int w = wg; w < 64; w += G) { const int xcd = w & 7, sl = w >> 3; scan_unit(p, lds, ((xcd * 4 + (sl >> 1)) << 1) | (sl & 1)); }
    if (G > 64) { for (int it = wg - 64; it >= 0 && it < 128; it += G - 64) mlp_item(p, lds, it); }
    else { for (int it = wg; it < 128; it += G) mlp_item(p, lds, it); }
    unsigned* cnt = (unsigned*)(p.ws + OFF_CNT);
    LAS unsigned* slot = (LAS unsigned*)(lds + LDS_ITEM);
    for (;;) {
        __syncthreads();
        if (tid == 0) *slot = atomicAdd(cnt, 1u);
        __syncthreads();
        const int it = (int)*slot;
        if (it >= 1552) break;
        if (it < 512) xattn_item(p, lds, it);
        else if (it < 1024) sample_delta_item(p, lds, it - 512);
        else if (it < 1536) sample_xattn_item(p, lds, it - 1024);
        else sample_mlp_item(p, it - 1536);
    }
}

static __device__ __forceinline__ void phase_ya(const Params& p) {
    const int tid = threadIdx.x, lane = tid & 63, wave = tid >> 6;
    const bf16_t* PROJ = (const bf16_t*)(p.ws + OFF_PROJ); bf16_t* ACT = (bf16_t*)(p.ws + OFF_ACT);
    const int c0 = lane * 8, d0 = c0 & 127, nw = gridDim.x * 8;
    f32x4 ng0 = *(const f32x4*)(p.a_norm_g + d0), ng1 = *(const f32x4*)(p.a_norm_g + d0 + 4);
    for (int row0 = blockIdx.x * 8 + wave; row0 < NP; row0 += nw * 4) {
        u32x4 xo[4], xg[4];
#pragma unroll
        for (int k = 0; k < 4; ++k) { const int row = row0 + k * nw; if (row < NP) { const size_t prow = (size_t)row * PLD; xo[k] = *(const u32x4*)(PROJ + prow + C_AQ + c0); xg[k] = *(const u32x4*)(PROJ + prow + C_AGATE + c0); } }
#pragma unroll
        for (int k = 0; k < 4; ++k) { const int row = row0 + k * nw; if (row < NP) {
            float v[8], ss = 0.f;
#pragma unroll
            for (int e = 0; e < 4; ++e) { v[2 * e] = bflo(xo[k][e]); v[2 * e + 1] = bfhi(xo[k][e]); ss += v[2 * e] * v[2 * e] + v[2 * e + 1] * v[2 * e + 1]; }
            ss += __shfl_xor(ss, 1); ss += __shfl_xor(ss, 2); ss += __shfl_xor(ss, 4); ss += __shfl_xor(ss, 8);
            const float rstd = rsqrtf(ss * (1.f / 128.f) + EPS);
            u32x4 o;
#pragma unroll
            for (int e = 0; e < 4; ++e) { const float g0 = e < 2 ? ng0[2 * e] : ng1[2 * e - 4], g1 = e < 2 ? ng0[2 * e + 1] : ng1[2 * e - 3];
                o[e] = cvt_pk_bf16(v[2 * e] * rstd * g0 * siluf_(bflo(xg[k][e])), v[2 * e + 1] * rstd * g1 * siluf_(bfhi(xg[k][e]))); }
            *(u32x4*)(ACT + (size_t)row * LDA + A_YA + c0) = o; } }
    }
}

template <int NKS> __device__ __forceinline__ f32x4 small_gemm(const bf16_t* Wt, const bf16_t* A) {
    bf16x8 wv[NKS], av[NKS];
#pragma unroll
    for (int ks = 0; ks < NKS; ++ks) { wv[ks] = ldg8(Wt + ks * 32); av[ks] = ldg8(A + ks * 32); }
    f32x4 acc = {0.f, 0.f, 0.f, 0.f};
#pragma unroll
    for (int ks = 0; ks < NKS; ++ks) acc = mfma16(wv[ks], av[ks], acc);
    return acc;
}
static __device__ __forceinline__ void sample_g3(const Params& p, LAS unsigned char* lds) {
    const int tid = threadIdx.x, lane = tid & 63, wave = tid >> 6, l16 = lane & 15, quad = lane >> 4, c = blockIdx.x;
    const int ct = c >> 2, rt = 2 * (c & 3) + (wave >> 2), kp = wave & 3;
    const bf16_t* ACT = (const bf16_t*)(p.ws + OFF_ACT); const bf16_t* WG3 = (const bf16_t*)(p.ws + OFF_WG3); bf16_t* MERGED = (bf16_t*)(p.ws + OFF_MERGED);
    const int r = NP + rt * 16 + l16 + opaque_zero(), n0 = ct * 16;
    LAS f32x4* red = (LAS f32x4*)lds;
#pragma unroll
    for (int br = 0; br < 3; ++br) {
        const bf16_t* wrow = WG3 + ((size_t)br * 1024 + n0 + l16) * 1536 + quad * 8; const bf16_t* arow = ACT + (size_t)r * LDA + quad * 8;
        red[(wave * 6 + 2 * br) * 64 + lane] = small_gemm<8>(wrow + kp * 256, arow + kp * 256);
        red[(wave * 6 + 2 * br + 1) * 64 + lane] = small_gemm<4>(wrow + 1024 + kp * 128, arow + A_YA + br * 512 + kp * 128);
    }
    __syncthreads();
    if (kp == 0) {
        f32x4 m = {0.f, 0.f, 0.f, 0.f};
#pragma unroll
        for (int br = 0; br < 3; ++br) {
            f32x4 ag = {0.f, 0.f, 0.f, 0.f}, at = {0.f, 0.f, 0.f, 0.f};
#pragma unroll
            for (int k = 0; k < 4; ++k) { ag += red[((wave + k) * 6 + 2 * br) * 64 + lane]; at += red[((wave + k) * 6 + 2 * br + 1) * 64 + lane]; }
            const f32x4 bg = *(const f32x4*)(p.b_gate + br * 1024 + n0 + quad * 4);
#pragma unroll
            for (int e = 0; e < 4; ++e) m[e] += sigmoidf_(ag[e] + bg[e]) * at[e];
        }
        u32x2 o; o[0] = cvt_pk_bf16(m[0], m[1]); o[1] = cvt_pk_bf16(m[2], m[3]);
        *(u32x2*)(MERGED + (size_t)r * 1024 + n0 + quad * 4) = o;
    }
}
static __device__ __forceinline__ void sample_g4(const Params& p, LAS unsigned char* lds) {
    const int tid = threadIdx.x, lane = tid & 63, wave = tid >> 6, l16 = lane & 15, quad = lane >> 4, c = blockIdx.x;
    const int ct = c >> 2, rt = 2 * (c & 3) + (wave >> 2), kp = wave & 3;
    const bf16_t* WOUT = (const bf16_t*)(p.ws + OFF_WOUT); const bf16_t* MERGED = (const bf16_t*)(p.ws + OFF_MERGED); float* rowsq = (float*)(p.ws + OFF_ROWSQ);
    const int rs = rt * 16 + l16 + opaque_zero(), n0 = ct * 16;
    LAS f32x4* red = (LAS f32x4*)lds;
    red[wave * 64 + lane] = small_gemm<8>(WOUT + (size_t)(n0 + l16) * 1024 + quad * 8 + kp * 256, MERGED + (size_t)(NP + rs) * 1024 + quad * 8 + kp * 256);
    __syncthreads();
    if (kp == 0) {
        f32x4 a = red[wave * 64 + lane] + red[(wave + 1) * 64 + lane] + red[(wave + 2) * 64 + lane] + red[(wave + 3) * 64 + lane];
        const f32x4 v = *(const f32x4*)(p.x_sample + (size_t)rs * 1024 + n0 + quad * 4) + a;
        *(f32x4*)(p.out + O_YS + (size_t)rs * 1024 + n0 + quad * 4) = v;
        float ss = v[0] * v[0] + v[1] * v[1] + v[2] * v[2] + v[3] * v[3];
        ss += __shfl_xor(ss, 16); ss += __shfl_xor(ss, 32);
        if (quad == 0) unsafeAtomicAdd(rowsq + NP + rs, ss);
    }
}

static __device__ __forceinline__ void sample_g4_finish(const Params& p) {
    const int tid = threadIdx.x, lane = tid & 63, wave = tid >> 6, l16 = lane & 15, quad = lane >> 4, c = blockIdx.x;
    const int ct = c >> 2, rt = 2 * (c & 3) + (wave >> 2), kp = wave & 3;
    const float* rowsq = (const float*)(p.ws + OFF_ROWSQ);
    if (kp == 0) { const int rs = rt * 16 + l16, n0 = ct * 16; float* op = p.out + O_YS + (size_t)rs * 1024 + n0 + quad * 4;
        const float r = rsqrtf(__hip_atomic_load(rowsq + NP + rs, __ATOMIC_RELAXED, __HIP_MEMORY_SCOPE_AGENT) * (1.f / 1024.f) + EPS);
        *(f32x4*)op = *(const f32x4*)op * r * *(const f32x4*)(p.final_norm_g + n0 + quad * 4); }
}
static __device__ __forceinline__ void phase_final(const Params& p) {
    const float* rowsq = (const float*)(p.ws + OFF_ROWSQ);
    const int total4 = (NP + NS) * 256, stride = gridDim.x * 512;
    for (int base = blockIdx.x * 512 + threadIdx.x; base < total4; base += stride * 8) {
        f32x4 v[8]; float rs[8];
#pragma unroll
        for (int k = 0; k < 8; ++k) { const int i = base + k * stride; if (i < total4) { v[k] = *(const f32x4*)(p.out + (size_t)i * 4); rs[k] = rowsq[i >> 8]; } }
#pragma unroll
        for (int k = 0; k < 8; ++k) { const int i = base + k * stride; if (i < total4) { const f32x4 g = *(const f32x4*)(p.final_norm_g + (i & 255) * 4);
            *(f32x4*)(p.out + (size_t)i * 4) = v[k] * rsqrtf(rs[k] * (1.f / 1024.f) + EPS) * g; } }
    }
}

__global__ void __launch_bounds__(512, 2) fwd_megakernel(Params p) {
    extern __shared__ __attribute__((aligned(16))) unsigned char shm[];
    LAS unsigned char* lds = (LAS unsigned char*)shm;
    cg::grid_group grid = cg::this_grid();
    const int G = gridDim.x, c = blockIdx.x;
    unsigned* bar = (unsigned*)(p.ws + OFF_BAR); unsigned ep = 0u;
#define PH_BEGIN(k) if (p.ph_lo <= (k) && (k) < p.ph_hi) { if ((k) > p.ph_lo) { if ((k) == 1) grid_sync_all(grid); else fast_sync(bar, ++ep); }
#define PH_END }
#if !defined(ONLY_PH) || ONLY_PH == 0
    PH_BEGIN(0) phase_prep(p, lds); PH_END
#endif
#if !defined(ONLY_PH) || ONLY_PH == 1
    PH_BEGIN(1) { SchedG1 S{(const char*)(p.ws + OFF_ACT), (const char*)(p.ws + OFF_W1T), G, c};
                  EpiG1 E{(bf16_t*)(p.ws + OFF_PROJ), (bf16_t*)(p.ws + OFF_MEMKV), p.out};
                  pg8::gemm_phase(lds, LDA, 1024, S, E); } PH_END
#endif
#if !defined(ONLY_PH) || ONLY_PH == 2
    PH_BEGIN(2) phase_delta_pre(p, lds); PH_END
#endif
#if !defined(ONLY_PH) || ONLY_PH == 3
    PH_BEGIN(3) phase_mixers(p, lds); PH_END
#endif
#if !defined(ONLY_PH) || ONLY_PH == 4
    PH_BEGIN(4) phase_ya(p); PH_END
#endif
#if !defined(ONLY_PH) || ONLY_PH == 5
    PH_BEGIN(5) { SchedG3 S{(const char*)(p.ws + OFF_ACT), (const char*)(p.ws + OFF_WG3), G, c};
                  EpiG3 E{p.ws + OFF_PROJ + (size_t)c * SCR_PER_WG, (bf16_t*)(p.ws + OFF_MERGED), p.b_gate};
                  pg8::gemm_phase(lds, LDA, 1536, S, E);
                  sample_g3(p, lds); } PH_END
#endif
#if !defined(ONLY_PH) || ONLY_PH == 6
    PH_BEGIN(6) { sample_g4(p, lds); __syncthreads();
                  SchedG4 S{(const char*)(p.ws + OFF_MERGED), (const char*)(p.ws + OFF_WOUT), G, c};
                  EpiG4 E{p.x_prompt, p.out, (float*)(p.ws + OFF_ROWSQ), p.final_norm_g, bar, ep + 1u};
                  pg8::gemm_phase(lds, 1024, 1024, S, E);
                  sample_g4_finish(p); } PH_END
#endif
#if !defined(ONLY_PH) || ONLY_PH == 7
#endif
}

extern "C" void kernel_launch(void* const* d_in, const int* in_sizes, int n_in, void* d_out, int out_size, void* d_ws, size_t ws_size, hipStream_t stream) {
    static int grid_blocks = 0;
    if (grid_blocks == 0) {
        if (n_in != 25 || ws_size < WS_END) { fprintf(stderr, "kernel_launch: unexpected n_in %d / ws_size %zu (need %zu)\n", n_in, ws_size, (size_t)WS_END); grid_blocks = -1; return; }
        int dev = 0, cus = 0, per_cu = 0;
        hipGetDevice(&dev);
        hipDeviceGetAttribute(&cus, hipDeviceAttributeMultiprocessorCount, dev);
        if (hipFuncSetAttribute((const void*)fwd_megakernel, hipFuncAttributeMaxDynamicSharedMemorySize, LDS_BYTES) != hipSuccess) { fprintf(stderr, "kernel_launch: hipFuncSetAttribute failed\n"); }
        if (hipOccupancyMaxActiveBlocksPerMultiprocessor(&per_cu, fwd_megakernel, 512, LDS_BYTES) != hipSuccess || per_cu < 1) { fprintf(stderr, "kernel_launch: occupancy query gave %d\n", per_cu); per_cu = 1; }
        (void)hipGetLastError();
        grid_blocks = cus * per_cu; if (grid_blocks > 256) grid_blocks = 256;
        if (grid_blocks != 256) { fprintf(stderr, "kernel_launch: this build needs exactly 256 co-resident workgroups (one output tile each in the fused out-projection epilogue); got %d\n", grid_blocks); grid_blocks = -1; return; }
    }
    if (grid_blocks < 0) return;
    Params p{};
    const float** f = (const float**)&p;
    for (int i = 0; i < 25; ++i) f[i] = (const float*)d_in[i];
    p.out = (float*)d_out; p.ws = (unsigned char*)d_ws; p.ph_lo = 0; p.ph_hi = 8; p.mask = 0xff;
    hipMemsetAsync((char*)d_ws + OFF_BAR, 0, 9 * 256, stream);
    void* args[] = {&p};
    hipError_t e = hipLaunchCooperativeKernel((const void*)fwd_megakernel, dim3(grid_blocks), dim3(512), args, LDS_BYTES, stream);
    if (e != hipSuccess) fprintf(stderr, "cooperative launch failed: %s (grid %d)\n", hipGetErrorString(e), grid_blocks);
}
```

```cpp
#include <hip/hip_runtime.h>
#include <hip/hip_cooperative_groups.h>
#include <cstdio>
namespace cg = cooperative_groups;

#define LAS __attribute__((address_space(3)))
#define GAS __attribute__((address_space(1)))
typedef unsigned short bf16_t;
typedef short bf16x8 __attribute__((ext_vector_type(8)));
typedef short bf16x4 __attribute__((ext_vector_type(4)));
typedef float f32x4 __attribute__((ext_vector_type(4)));
typedef unsigned u32x4 __attribute__((ext_vector_type(4)));
typedef unsigned u32x2 __attribute__((ext_vector_type(2)));

constexpr int NP = 16384, NS = 128, MROWS = 16640, HM0 = 16640, LDA = 2560, PLD = 4608;
constexpr int C_AQ = 0, C_AK = 512, C_AV = 1024, C_AGATE = 1536, C_BU = 2048, C_BV = 2560, C_BGATE = 3072, C_CQ = 3584, C_CGATE = 4096;
constexpr int A_H = 0, A_YA = 1024, A_YB = 1536, A_YC = 2048;
constexpr float EPS = 1e-6f;
constexpr size_t OFF_W1T = 0;
constexpr size_t OFF_WG3 = 11534336;
constexpr size_t OFF_WOUT = 20971520;
constexpr size_t OFF_ACT = 23068672;
constexpr size_t OFF_PROJ = 118751232;
constexpr size_t OFF_ATTN = 272105472;
constexpr size_t OFF_MEMKV = 280494080;
constexpr size_t OFF_BETAG = 284688384;
constexpr size_t OFF_ROWSQ = 285216768;
constexpr size_t OFF_GL = 285283328;
constexpr size_t OFF_CNT = 285287424;
constexpr size_t OFF_BAR = 285287680;
constexpr size_t WS_END = 285290240;
constexpr size_t SCR_PER_WG = 262144;
constexpr size_t OFF_MERGED = OFF_PROJ + 256 * SCR_PER_WG;
constexpr size_t DO_U = 0, DO_W = 16777216, DO_QD = 33554432, DO_KDT = 50331648;
constexpr size_t O_YS = 16777216, O_SDP = 16908288, O_SCP = 17432576, O_MKP = 17469440, O_MVP = 18518016, O_SDS = 19566592, O_SCS = 27955200, O_CVS = 28545024;
constexpr int LDS_BYTES = 143360;
constexpr int LDS_ITEM = 143344;

struct Params {
    const float *x_prompt, *x_sample, *cache_k, *cache_v, *state_delta, *state_conv, *mem_prompt, *norm_g, *w_in, *conv_w, *a_log, *dt_bias, *a_norm_g,
        *ln_v_g, *ln_v_b, *w_spatial, *b_spatial, *mem_norm_g, *w_mem_kv, *w_br_a, *w_br_b, *w_br_c, *b_gate, *w_out, *final_norm_g;
    float* out;
    unsigned char* ws;
    int ph_lo, ph_hi, mask, pad_;
};

typedef __bf16 bf16v2_t __attribute__((ext_vector_type(2)));
__device__ __forceinline__ unsigned cvt_pk_bf16(float lo, float hi) { bf16v2_t v; v[0] = (__bf16)lo; v[1] = (__bf16)hi; return __builtin_bit_cast(unsigned, v); }
__device__ __forceinline__ bf16_t f2bf(float f) { return (bf16_t)(cvt_pk_bf16(f, 0.f) & 0xffffu); }
__device__ __forceinline__ float bf2f(bf16_t b) { return __uint_as_float(((unsigned)b) << 16); }
__device__ __forceinline__ float bflo(unsigned u) { return __uint_as_float(u << 16); }
__device__ __forceinline__ float bfhi(unsigned u) { return __uint_as_float(u & 0xffff0000u); }
__device__ __forceinline__ float sigmoidf_(float x) { return __builtin_amdgcn_rcpf(1.f + __expf(-x)); }
__device__ __forceinline__ float siluf_(float x) { return x * __builtin_amdgcn_rcpf(1.f + __expf(-x)); }
__device__ __forceinline__ float wave_sum(float v) {
#pragma unroll
    for (int o = 32; o >= 1; o >>= 1) v += __shfl_xor(v, o);
    return v;
}
__device__ __forceinline__ int opaque_zero() { int z; asm volatile("v_mov_b32 %0, 0" : "=v"(z)); return z; }
__device__ __forceinline__ f32x4 mfma16(bf16x8 a, bf16x8 b, f32x4 c) { return __builtin_amdgcn_mfma_f32_16x16x32_bf16(a, b, c, 0, 0, 0); }
__device__ __forceinline__ bf16x8 ldg8(const bf16_t* p) { return *(const bf16x8*)p; }
__device__ __forceinline__ bf16x8 lds8(LAS unsigned char* l, int off) { return *(const LAS bf16x8*)(l + off); }
__device__ __forceinline__ u32x4 pack8(f32x4 a, f32x4 b) { u32x4 r; r[0] = cvt_pk_bf16(a[0], a[1]); r[1] = cvt_pk_bf16(a[2], a[3]); r[2] = cvt_pk_bf16(b[0], b[1]); r[3] = cvt_pk_bf16(b[2], b[3]); return r; }

__device__ __forceinline__ void grid_sync_all(cg::grid_group& grid) {
    asm volatile("s_waitcnt vmcnt(0)" ::: "memory");
    grid.sync();
    if (threadIdx.x < 64) { __builtin_amdgcn_fence(__ATOMIC_ACQUIRE, "agent"); asm volatile("s_waitcnt vmcnt(0)" ::: "memory"); }
    __syncthreads();
}

__device__ __forceinline__ void fast_sync(unsigned* bar, unsigned epoch) {
    asm volatile("s_waitcnt vmcnt(0)" ::: "memory");
    __syncthreads();
    if (threadIdx.x == 0) {
        __builtin_amdgcn_fence(__ATOMIC_RELEASE, "agent"); asm volatile("s_waitcnt vmcnt(0)" ::: "memory");
        const unsigned g = blockIdx.x & 7u, ng = (gridDim.x - g + 7u) / 8u, ngroups = gridDim.x < 8u ? gridDim.x : 8u;
        const unsigned old = __hip_atomic_fetch_add(bar + g * 64, 1u, __ATOMIC_RELAXED, __HIP_MEMORY_SCOPE_AGENT);
        if (old + 1u == epoch * ng) __hip_atomic_fetch_add(bar + 8 * 64, 1u, __ATOMIC_RELAXED, __HIP_MEMORY_SCOPE_AGENT);
        while (__hip_atomic_load(bar + 8 * 64, __ATOMIC_RELAXED, __HIP_MEMORY_SCOPE_AGENT) < epoch * ngroups) __builtin_amdgcn_s_sleep(1);
        __builtin_amdgcn_fence(__ATOMIC_ACQUIRE, "agent"); asm volatile("s_waitcnt vmcnt(0)" ::: "memory");
    }
    __syncthreads();
}

namespace pg8 {
constexpr int BM = 256, BK = 64, HALF = 128, HTB = HALF * BK * 2, STAGE_BYTES = 8 * HTB;
__device__ __forceinline__ int lds_byte(int r, int c) { const int st = (r >> 4) * 2 + (c >> 5), rr = r & 15, cc = c & 31, ob = rr * 64 + cc * 2; return st * 1024 + (ob ^ (((ob >> 9) & 1) << 5)); }
__device__ __forceinline__ void stage_rc(int b, int& R, int& C) { const int st = b / 1024, sb = b % 1024, swz = sb ^ (((sb >> 9) & 1) << 5); R = (st >> 1) * 16 + swz / 64; C = (st & 1) * 32 + (swz % 64) / 2; }
__device__ __forceinline__ int perm32(int rho) { const int n = rho >> 4, i = rho & 15; return 8 * (i >> 2) + 4 * n + (i & 3); }
struct Unit { int pm, pn, sub; };

template <class Epi, class Sched>
__device__ __forceinline__ void gemm_phase(LAS unsigned char* lds, const int lda, const int ldb, const Sched& S, const Epi& E) {
    const int tid = threadIdx.x, wid = __builtin_amdgcn_readfirstlane(tid >> 6), lane = tid & 63, wr = wid >> 2, wc = wid & 3, fr = lane & 15, fq = lane >> 4;
    unsigned voffA[2], voffB[2];
#pragma unroll
    for (int i = 0; i < 2; ++i) { int R, C; stage_rc(tid * 16 + i * 8192, R, C); const int Rb = (R & ~31) + perm32(R & 31);
        voffA[i] = (unsigned)(R * lda + C) * 2u; voffB[i] = (unsigned)(Rb * ldb + C) * 2u; }
    const size_t kstep = (size_t)(BK * 2);
    const size_t hstepA = (size_t)HALF * lda * 2, hstepB = (size_t)HALF * ldb * 2;
    const unsigned ldsw = (unsigned)wid * 1024u;
    const int aoff = lds_byte(wr * 64 + fr, fq * 8), boff = lds_byte(wc * 32 + fr, fq * 8);
#define PG8_SA(b, h) (((b) * 2 + (h)) * HTB)
#define PG8_SB(b, h) ((4 + (b) * 2 + (h)) * HTB)
#define PG8_STAGE(bufoff, gbase, voff) do { _Pragma("unroll") for (int _i = 0; _i < 2; ++_i) \
        __builtin_amdgcn_global_load_lds((const unsigned*)((const char*)(gbase) + (voff)[_i]), (LAS unsigned*)(lds + (bufoff) + ldsw + _i * 8192), 16, 0, 0); } while (0)
#define PG8_LDA(dst, b, h) do { _Pragma("unroll") for (int m = 0; m < 4; ++m) _Pragma("unroll") for (int k = 0; k < 2; ++k) dst[m][k] = *(const LAS bf16x8*)(lds + PG8_SA(b, h) + aoff + m * 2048 + k * 1024); } while (0)
#define PG8_LDB(dst, b, h) do { _Pragma("unroll") for (int n = 0; n < 2; ++n) _Pragma("unroll") for (int k = 0; k < 2; ++k) dst[n][k] = *(const LAS bf16x8*)(lds + PG8_SB(b, h) + boff + n * 2048 + k * 1024); } while (0)
#define PG8_MMA(ai, bj, At, Bt) do { __builtin_amdgcn_s_setprio(1); _Pragma("unroll") for (int m = 0; m < 4; ++m) _Pragma("unroll") for (int n = 0; n < 2; ++n) _Pragma("unroll") for (int k = 0; k < 2; ++k) \
        acc[ai][bj][m][n] = __builtin_amdgcn_mfma_f32_16x16x32_bf16(Bt[n][k], At[m][k], acc[ai][bj][m][n], 0, 0, 0); __builtin_amdgcn_s_setprio(0); } while (0)
#define PG8_WAIT_V(n) asm volatile("s_waitcnt vmcnt(" #n ")" ::: "memory")
#define PG8_WAIT_L(n) asm volatile("s_waitcnt lgkmcnt(" #n ")" ::: "memory")
#define PG8_BAR __builtin_amdgcn_s_barrier()
#define PG8_SCHED __builtin_amdgcn_sched_barrier(0)
    Unit cur, nxt; int ui = 0;
    if (!S.next(0, cur)) return;
    f32x4 acc[2][2][4][2];
    bf16x8 At[4][2], B0[2][2], B1[2][2];
    const char* cA; const char* cB; int nt;
    S.ptrs(cur, cA, cB, nt);
    PG8_STAGE(PG8_SB(0, 0), cB, voffB); PG8_STAGE(PG8_SA(0, 0), cA, voffA); PG8_STAGE(PG8_SB(0, 1), cB + hstepB, voffB); PG8_STAGE(PG8_SA(0, 1), cA + hstepA, voffA);
    if (wr == 1) PG8_BAR;
    PG8_WAIT_V(4); PG8_BAR;
    PG8_STAGE(PG8_SB(1, 0), cB + kstep, voffB); PG8_STAGE(PG8_SA(1, 0), cA + kstep, voffA); PG8_STAGE(PG8_SB(1, 1), cB + hstepB + kstep, voffB);
    PG8_WAIT_V(6); PG8_BAR;
    PG8_SCHED;
#pragma unroll
    for (int a = 0; a < 2; ++a)
#pragma unroll
        for (int b = 0; b < 2; ++b)
#pragma unroll
            for (int m = 0; m < 4; ++m)
#pragma unroll
                for (int n = 0; n < 2; ++n) acc[a][b][m][n] = (f32x4){0.f, 0.f, 0.f, 0.f};
    for (;;) {
        const bool has_next = S.next(ui + 1, nxt);
        const char* nA = cA; const char* nB = cB; int nnt = nt;
        if (has_next) S.ptrs(nxt, nA, nB, nnt);
        for (int t = 0; t < nt; t += 2) {
            const bool last = (t == nt - 2);
            const char* a1 = cA + (size_t)(t + 1) * kstep;
            const char* a2 = last ? nA : cA + (size_t)(t + 2) * kstep; const char* b2 = last ? nB : cB + (size_t)(t + 2) * kstep;
            const char* a3 = a2 + kstep; const char* b3 = b2 + kstep;
            PG8_LDB(B0, 0, 0); PG8_SCHED; PG8_LDA(At, 0, 0); PG8_STAGE(PG8_SA(1, 1), a1 + hstepA, voffA);
            PG8_WAIT_L(8); PG8_BAR; PG8_WAIT_L(0); PG8_MMA(0, 0, At, B0); PG8_BAR; PG8_SCHED;
            PG8_LDB(B1, 0, 1); PG8_STAGE(PG8_SB(0, 0), b2, voffB);
            PG8_BAR; PG8_WAIT_L(0); PG8_MMA(0, 1, At, B1); PG8_BAR;
            PG8_LDA(At, 0, 1); PG8_STAGE(PG8_SA(0, 0), a2, voffA);
            PG8_BAR; PG8_WAIT_L(0); PG8_MMA(1, 0, At, B0); PG8_BAR; PG8_SCHED;
            PG8_STAGE(PG8_SB(0, 1), b2 + hstepB, voffB);
            PG8_WAIT_V(6); PG8_BAR; PG8_MMA(1, 1, At, B1); PG8_BAR;
            PG8_LDB(B0, 1, 0); PG8_SCHED; PG8_LDA(At, 1, 0); PG8_STAGE(PG8_SA(0, 1), a2 + hstepA, voffA);
            PG8_WAIT_L(8); PG8_BAR; PG8_WAIT_L(0); PG8_MMA(0, 0, At, B0); PG8_BAR; PG8_SCHED;
            PG8_LDB(B1, 1, 1); PG8_STAGE(PG8_SB(1, 0), b3, voffB);
            PG8_BAR; PG8_WAIT_L(0); PG8_MMA(0, 1, At, B1); PG8_BAR;
            PG8_LDA(At, 1, 1); PG8_STAGE(PG8_SA(1, 0), a3, voffA);
            PG8_BAR; PG8_WAIT_L(0); PG8_MMA(1, 0, At, B0); PG8_BAR; PG8_SCHED;
            PG8_STAGE(PG8_SB(1, 1), b3 + hstepB, voffB);
            PG8_WAIT_V(6); PG8_BAR; PG8_MMA(1, 1, At, B1); PG8_BAR;
        }
        __builtin_amdgcn_sched_barrier(0);
        E(acc, cur, wr, wc, fr, fq);
        __builtin_amdgcn_sched_barrier(0);
        if (!has_next) break;
        const float kf = S.keep(cur) ? 1.f : 0.f;
#pragma unroll
        for (int a = 0; a < 2; ++a)
#pragma unroll
            for (int b = 0; b < 2; ++b)
#pragma unroll
                for (int m = 0; m < 4; ++m)
#pragma unroll
                    for (int n = 0; n < 2; ++n) { if constexpr (Sched::HAS_KEEP) acc[a][b][m][n] *= kf; else acc[a][b][m][n] = (f32x4){0.f, 0.f, 0.f, 0.f}; }
        cur = nxt; cA = nA; cB = nB; nt = nnt; ++ui;
    }
    PG8_WAIT_V(0);
    if (wr == 0) PG8_BAR;
    PG8_BAR;
    if constexpr (Epi::HAS_POST) E.post(acc, cur, wr, wc, fr, fq);
#undef PG8_SA
#undef PG8_SB
#undef PG8_STAGE
#undef PG8_LDA
#undef PG8_LDB
#undef PG8_MMA
#undef PG8_WAIT_V
#undef PG8_WAIT_L
#undef PG8_BAR
#undef PG8_SCHED
}
}

struct SchedG1 {
    const char* A; const char* B; int G, c;
    __device__ __forceinline__ bool next(int i, pg8::Unit& u) const {
        const int L = i * G + c; if (L >= 1202) return false;
        if (L < 1170) {
            const int nM = 65, nN = 18, nwg = 1170;
            int wgid = L; { const int q = nwg / 8, r = nwg % 8, xcd = wgid % 8, off = wgid / 8; wgid = (xcd < r ? xcd * (q + 1) : r * (q + 1) + (xcd - r) * q) + off; }
            const int nig = 8 * nN, gid = wgid / nig, fm = gid * 8, gsz = (nM - fm) < 8 ? (nM - fm) : 8;
            u.pm = fm + ((wgid % nig) % gsz); u.pn = (wgid % nig) / gsz;
        } else { const int l2 = L - 1170; u.pm = 65 + (l2 >> 2); u.pn = 18 + (l2 & 3); }
        u.sub = 0; return true;
    }
    __device__ __forceinline__ void ptrs(const pg8::Unit& u, const char*& a, const char*& b, int& nt) const {
        a = A + (size_t)u.pm * 256 * LDA * 2; b = B + (size_t)u.pn * 256 * 1024 * 2; nt = 16;
    }
    static constexpr bool HAS_KEEP = false;
    __device__ __forceinline__ bool keep(const pg8::Unit&) const { return false; }
};
struct EpiG1 {
    static constexpr bool HAS_POST = false;
    bf16_t* proj; bf16_t* memkv; float* out;
    __device__ __forceinline__ void operator()(f32x4 (&acc)[2][2][4][2], const pg8::Unit& u, int wr, int wc, int fr, int fq) const {
        const int row0 = u.pm * 256 + wr * 64 + fr, col0 = u.pn * 256 + wc * 32 + 8 * fq;
        if (u.pn < 18) {
#pragma unroll
            for (int ai = 0; ai < 2; ++ai)
#pragma unroll
                for (int m = 0; m < 4; ++m) { bf16_t* rp = proj + (size_t)(row0 + ai * 128 + m * 16) * PLD + col0;
#pragma unroll
                    for (int bj = 0; bj < 2; ++bj) *(u32x4*)(rp + bj * 128) = pack8(acc[ai][bj][m][0], acc[ai][bj][m][1]); }
        } else {
            const int rr0 = row0 - HM0, cc0 = col0 - 4608;
#pragma unroll
            for (int ai = 0; ai < 2; ++ai)
#pragma unroll
                for (int m = 0; m < 4; ++m) { const int rr = rr0 + ai * 128 + m * 16;
#pragma unroll
                    for (int bj = 0; bj < 2; ++bj) { const int cc = cc0 + bj * 128;
                        *(u32x4*)(memkv + (size_t)rr * 1024 + cc) = pack8(acc[ai][bj][m][0], acc[ai][bj][m][1]);
                        float* op = out + (cc < 512 ? O_MKP + (size_t)rr * 512 + cc : O_MVP + (size_t)rr * 512 + (cc - 512));
                        *(f32x4*)op = acc[ai][bj][m][0]; *(f32x4*)(op + 4) = acc[ai][bj][m][1]; } }
        }
    }
};

struct SchedG3 {
    const char* A; const char* B; int G, c;
    __device__ __forceinline__ bool next(int i, pg8::Unit& u) const {
        const int r = i / 6, T = r * G + c; if (T >= 256) return false;
        const int xcd = T & 7, idx = T >> 3; u.pm = xcd * 8 + (idx >> 2); u.pn = idx & 3; u.sub = i - r * 6; return true;
    }
    __device__ __forceinline__ void ptrs(const pg8::Unit& u, const char*& a, const char*& b, int& nt) const {
        const int br = u.sub >> 1;
        const char* a0 = A + (size_t)u.pm * 256 * LDA * 2; const char* b0 = B + ((size_t)br * 1024 + (size_t)u.pn * 256) * 1536 * 2;
        if (u.sub & 1) { a = a0 + (A_YA + br * 512) * 2; b = b0 + 1024 * 2; nt = 8; } else { a = a0; b = b0; nt = 16; }
    }
    static constexpr bool HAS_KEEP = false;
    __device__ __forceinline__ bool keep(const pg8::Unit&) const { return false; }
};
__device__ __forceinline__ void unpack8(const u32x4 g, f32x4& g0, f32x4& g1) { g0 = (f32x4){bflo(g[0]), bfhi(g[0]), bflo(g[1]), bfhi(g[1])}; g1 = (f32x4){bflo(g[2]), bfhi(g[2]), bflo(g[3]), bfhi(g[3])}; }
struct EpiG3 {
    static constexpr bool HAS_POST = false;
    unsigned char* scr; bf16_t* merged; const float* b_gate;
    __device__ __forceinline__ void operator()(f32x4 (&acc)[2][2][4][2], const pg8::Unit& u, int wr, int wc, int fr, int fq) const {
        const int tid = threadIdx.x + opaque_zero();
        const int row0 = u.pm * 256 + wr * 64 + fr, col0 = u.pn * 256 + wc * 32 + 8 * fq + opaque_zero();
        const bool gate = (u.sub & 1) == 0; const int br = u.sub >> 1;
        GAS u32x4* s0 = (GAS u32x4*)scr + tid * 4;
        const int boff = 8192;
        const float* bp = b_gate + br * 1024 + col0;
        bf16_t* mp = merged + (size_t)row0 * 1024 + col0;
#pragma unroll
        for (int ai = 0; ai < 2; ++ai)
#pragma unroll
            for (int bj = 0; bj < 2; ++bj) {
                if (gate) {
                    const f32x4 b0 = *(const f32x4*)(bp + bj * 128), b1 = *(const f32x4*)(bp + bj * 128 + 4);
#pragma unroll
                    for (int m = 0; m < 4; ++m) { f32x4 g0, g1;
#pragma unroll
                        for (int e = 0; e < 4; ++e) { g0[e] = sigmoidf_(acc[ai][bj][m][0][e] + b0[e]); g1[e] = sigmoidf_(acc[ai][bj][m][1][e] + b1[e]); }
                        s0[boff + m] = pack8(g0, g1); }
                } else {
                    u32x4 gn[4], gm[4];
#pragma unroll
                    for (int m = 0; m < 4; ++m) { gn[m] = s0[boff + m]; gm[m] = gn[m]; }
                    if (br > 0) {
#pragma unroll
                        for (int m = 0; m < 4; ++m) gm[m] = s0[m];
                    }
#pragma unroll
                    for (int m = 0; m < 4; ++m) { f32x4 n0, n1, p0, p1; unpack8(gn[m], n0, n1); unpack8(gm[m], p0, p1);
                        f32x4 r0 = acc[ai][bj][m][0] * n0, r1 = acc[ai][bj][m][1] * n1;
                        if (br > 0) { r0 += p0; r1 += p1; }
                        const u32x4 pk = pack8(r0, r1);
                        if (br < 2) s0[m] = pk; else *(u32x4*)(mp + (size_t)(ai * 128 + m * 16) * 1024 + bj * 128) = pk; }
                }
                s0 += 2048; asm volatile("" : "+v"(s0)); __builtin_amdgcn_sched_barrier(0); }
    }
};

struct SchedG4 {
    const char* A; const char* B; int G, c;
    __device__ __forceinline__ bool next(int i, pg8::Unit& u) const {
        const int T = i * G + c; if (T >= 256) return false;
        const int xcd = T & 7, idx = T >> 3; u.pm = xcd * 8 + (idx >> 2); u.pn = idx & 3; u.sub = 0; return true;
    }
    __device__ __forceinline__ void ptrs(const pg8::Unit& u, const char*& a, const char*& b, int& nt) const {
        a = A + (size_t)u.pm * 256 * 1024 * 2; b = B + (size_t)u.pn * 256 * 1024 * 2; nt = 16;
    }
    static constexpr bool HAS_KEEP = false;
    __device__ __forceinline__ bool keep(const pg8::Unit&) const { return false; }
};
struct EpiG4 {
    static constexpr bool HAS_POST = true;
    const float* x; float* out; float* rowsq; const float* fg; unsigned* bar; unsigned epoch;
    __device__ __forceinline__ void operator()(f32x4 (&acc)[2][2][4][2], const pg8::Unit& u, int wr, int wc, int fr, int fq) const {
        const int row0 = u.pm * 256 + wr * 64 + fr + opaque_zero(), col0 = u.pn * 256 + wc * 32 + 8 * fq;
        const GAS float* xp = (const GAS float*)x + (size_t)row0 * 1024 + col0; float* rq = rowsq + row0;
#pragma unroll
        for (int ai = 0; ai < 2; ++ai) {
#pragma unroll
            for (int m = 0; m < 4; ++m) { float ss = 0.f;
#pragma unroll
                for (int bj = 0; bj < 2; ++bj) {
                    acc[ai][bj][m][0] += *(const GAS f32x4*)(xp + bj * 128); acc[ai][bj][m][1] += *(const GAS f32x4*)(xp + bj * 128 + 4);
#pragma unroll
                    for (int e = 0; e < 4; ++e) ss += acc[ai][bj][m][0][e] * acc[ai][bj][m][0][e] + acc[ai][bj][m][1][e] * acc[ai][bj][m][1][e]; }
                ss += __shfl_xor(ss, 16); ss += __shfl_xor(ss, 32);
                if (fq == 0) unsafeAtomicAdd(rq, ss);
                xp += 16 * 1024; rq += 16;
                if (m & 1) asm volatile("" : "+v"(xp), "+v"(rq)); }
            xp += 64 * 1024; rq += 64; }
    }
    __device__ __forceinline__ void post(f32x4 (&acc)[2][2][4][2], const pg8::Unit& u, int wr, int wc, int fr, int fq) const {
        fast_sync(bar, epoch);
        const int row0 = u.pm * 256 + wr * 64 + fr + opaque_zero(), col0 = u.pn * 256 + wc * 32 + 8 * fq;
        GAS float* op = (GAS float*)out + (size_t)row0 * 1024 + col0; const float* rq = rowsq + row0;
        f32x4 g[2][2];
#pragma unroll
        for (int bj = 0; bj < 2; ++bj) { g[bj][0] = *(const f32x4*)(fg + col0 + bj * 128); g[bj][1] = *(const f32x4*)(fg + col0 + bj * 128 + 4); }
#pragma unroll
        for (int ai = 0; ai < 2; ++ai) {
#pragma unroll
            for (int m = 0; m < 4; ++m) {
                const float rs = rsqrtf(__hip_atomic_load(rq, __ATOMIC_RELAXED, __HIP_MEMORY_SCOPE_AGENT) * (1.f / 1024.f) + EPS);
#pragma unroll
                for (int bj = 0; bj < 2; ++bj) { *(GAS f32x4*)(op + bj * 128) = acc[ai][bj][m][0] * rs * g[bj][0]; *(GAS f32x4*)(op + bj * 128 + 4) = acc[ai][bj][m][1] * rs * g[bj][1]; }
                op += 16 * 1024; rq += 16;
                if (m & 1) asm volatile("" : "+v"(op), "+v"(rq)); }
            op += 64 * 1024; rq += 64; }
    }
};

__device__ __forceinline__ void transpose_tile(const Params& p, LAS unsigned char* lds, int t) {
    const float* src; int sld, col0, ntn; bf16_t* dst; int dld;
    bf16_t* W1T = (bf16_t*)(p.ws + OFF_W1T); bf16_t* WG3 = (bf16_t*)(p.ws + OFF_WG3); bf16_t* WOUT = (bf16_t*)(p.ws + OFF_WOUT);
    if (t < 384) { src = p.w_in; sld = 7688; col0 = 0; ntn = 24; dst = W1T; dld = 1024; }
    else if (t < 1152) { t -= 384; src = p.w_in; sld = 7688; col0 = 1544; ntn = 48; dst = W1T + (size_t)1536 * 1024; dld = 1024; }
    else if (t < 1408) { t -= 1152; src = p.w_mem_kv; sld = 1024; col0 = 0; ntn = 16; dst = W1T + (size_t)4608 * 1024; dld = 1024; }
    else if (t < 2176) { t -= 1408; const int i = t >> 8; t &= 255; src = p.w_in; sld = 7688; col0 = 4616 + i * 1024; ntn = 16; dst = WG3 + (size_t)i * 1024 * 1536; dld = 1536; }
    else if (t < 2304) { t -= 2176; src = p.w_br_a; sld = 1024; col0 = 0; ntn = 16; dst = WG3 + 1024; dld = 1536; }
    else if (t < 2432) { t -= 2304; src = p.w_br_b; sld = 1024; col0 = 0; ntn = 16; dst = WG3 + (size_t)1 * 1024 * 1536 + 1024; dld = 1536; }
    else if (t < 2560) { t -= 2432; src = p.w_br_c; sld = 1024; col0 = 0; ntn = 16; dst = WG3 + (size_t)2 * 1024 * 1536 + 1024; dld = 1536; }
    else { t -= 2560; src = p.w_out; sld = 1024; col0 = 0; ntn = 16; dst = WOUT; dld = 1024; }
    const int k0 = (t / ntn) * 64, n0 = (t % ntn) * 64, tid = threadIdx.x;
    LAS float* tile = (LAS float*)lds;
    __syncthreads();
#pragma unroll
    for (int ps = 0; ps < 2; ++ps) { const int r = (tid >> 4) + ps * 32, c4 = (tid & 15) * 4;
        const f32x4 v = *(const f32x4*)(src + (size_t)(k0 + r) * sld + col0 + n0 + c4);
        tile[r * 65 + c4] = v[0]; tile[r * 65 + c4 + 1] = v[1]; tile[r * 65 + c4 + 2] = v[2]; tile[r * 65 + c4 + 3] = v[3]; }
    __syncthreads();
    const int n = tid >> 3, kc = (tid & 7) * 8;
    u32x4 o;
#pragma unroll
    for (int j = 0; j < 4; ++j) o[j] = cvt_pk_bf16(tile[(kc + 2 * j) * 65 + n], tile[(kc + 2 * j + 1) * 65 + n]);
    *(u32x4*)(dst + (size_t)(n0 + n) * dld + k0 + kc) = o;
}

static __device__ __forceinline__ void phase_prep(const Params& p, LAS unsigned char* lds) {
    const int tid = threadIdx.x, wg = blockIdx.x, G = gridDim.x, lane = tid & 63, wave = tid >> 6;
    float* rowsq = (float*)(p.ws + OFF_ROWSQ); unsigned* cnt = (unsigned*)(p.ws + OFF_CNT);
    for (int i = wg * 512 + tid; i < MROWS + 64; i += G * 512) { if (i < MROWS) rowsq[i] = 0.f; else cnt[i - MROWS] = 0u; }
    if (wg == G - 1) { unsigned* bw = (unsigned*)(p.ws + OFF_BAR); for (int i = tid; i < 9 * 64; i += 512) bw[i] = 0u; }
    for (int t = wg; t < 2816; t += G) transpose_tile(p, lds, t);
    __syncthreads();
    LAS float* wb = (LAS float*)lds;
    for (int idx = tid; idx < 8192; idx += 512) { const int k = idx >> 3, j = idx & 7; wb[j * 1024 + k] = p.w_in[(size_t)k * 7688 + 1536 + j]; }
    __syncthreads();
    bf16_t* ACT = (bf16_t*)(p.ws + OFF_ACT); float* betag = (float*)(p.ws + OFF_BETAG);
    for (int row = wg * 8 + wave; row < 18560; row += G * 8) {
        const float* src; const float* gn; size_t drow;
        if (row < NP) { src = p.x_prompt + (size_t)row * 1024; gn = p.norm_g; drow = row; }
        else if (row < NP + NS) { src = p.x_sample + (size_t)(row - NP) * 1024; gn = p.norm_g; drow = row; }
        else { src = p.mem_prompt + (size_t)(row - NP - NS) * 1024; gn = p.mem_norm_g; drow = HM0 + (row - NP - NS); }
        f32x4 v[4]; float ss = 0.f;
#pragma unroll
        for (int q = 0; q < 4; ++q) { v[q] = *(const f32x4*)(src + q * 256 + lane * 4); ss += v[q][0] * v[q][0] + v[q][1] * v[q][1] + v[q][2] * v[q][2] + v[q][3] * v[q][3]; }
        ss = wave_sum(ss);
        const float rstd = rsqrtf(ss * (1.f / 1024.f) + EPS);
#pragma unroll
        for (int q = 0; q < 4; ++q) { const f32x4 g = *(const f32x4*)(gn + q * 256 + lane * 4); v[q] = v[q] * rstd * g;
            u32x2 o; o[0] = cvt_pk_bf16(v[q][0], v[q][1]); o[1] = cvt_pk_bf16(v[q][2], v[q][3]);
            *(u32x2*)(ACT + drow * LDA + q * 256 + lane * 4) = o; }
        if (row < NP + NS) {
            float d[8];
#pragma unroll
            for (int j = 0; j < 8; ++j) { float a = 0.f;
#pragma unroll
                for (int q = 0; q < 4; ++q) { const f32x4 w = *(const LAS f32x4*)(wb + j * 1024 + q * 256 + lane * 4); a += v[q][0] * w[0] + v[q][1] * w[1] + v[q][2] * w[2] + v[q][3] * w[3]; }
                d[j] = wave_sum(a); }
            float dl = d[0];
#pragma unroll
            for (int j = 1; j < 8; ++j) dl = (lane == j) ? d[j] : dl;
            if (lane < 4) betag[(size_t)row * 8 + lane] = sigmoidf_(dl);
            else if (lane < 8) { const int h = lane - 4; const float xx = dl + p.dt_bias[h]; const float sp = xx > 20.f ? xx : log1pf(expf(xx));
                betag[(size_t)row * 8 + lane] = -expf(p.a_log[h]) * sp; }
        }
    }
}

static __device__ __forceinline__ void delta_chunk_item(const Params& p, LAS unsigned char* lds, int ci) {
    const int tid = threadIdx.x, lane = tid & 63, wave = tid >> 6, l16 = lane & 15, quad = lane >> 4;
    const int bh = ci >> 5, n = ci & 31, b = bh >> 2, h = bh & 3;
    const bf16_t* PROJ = (const bf16_t*)(p.ws + OFF_PROJ); const float* betag = (const float*)(p.ws + OFF_BETAG);
    bf16_t* U = (bf16_t*)((unsigned char*)p.out + DO_U) + (size_t)ci * 8192; bf16_t* W = (bf16_t*)((unsigned char*)p.out + DO_W) + (size_t)ci * 8192;
    bf16_t* QD = (bf16_t*)((unsigned char*)p.out + DO_QD) + (size_t)ci * 8192; bf16_t* KDT = (bf16_t*)((unsigned char*)p.out + DO_KDT) + (size_t)ci * 8192;
    bf16_t* ATT = (bf16_t*)(p.ws + OFF_ATTN) + (size_t)ci * 4096; float* GL = (float*)(p.ws + OFF_GL);
    LAS bf16_t* Kb = (LAS bf16_t*)lds; LAS bf16_t* Qb = (LAS bf16_t*)(lds + 17408);
    LAS float* RHS = (LAS float*)(lds + 34816);
    LAS float* Lm = (LAS float*)(lds + 100352);
    LAS float* gcs = (LAS float*)(lds + 116736); LAS float* bts = gcs + 64;
    const int trow0 = b * 2048 + n * 64;
    __syncthreads();
    if (wave == 0) {
        float g = betag[(size_t)(trow0 + lane) * 8 + 4 + h];
#pragma unroll
        for (int o = 1; o < 64; o <<= 1) { const float t = __shfl_up(g, o); if (lane >= o) g += t; }
        gcs[lane] = g; bts[lane] = betag[(size_t)(trow0 + lane) * 8 + h];
        if (lane == 63) GL[ci] = __expf(g);
    }
    __syncthreads();
    {
        const int t = tid >> 3, cc = (tid & 7) * 16;
        const float gct = gcs[t], bet = bts[t], eg = __expf(gct);
#pragma unroll 1
        for (int sec = 0; sec < 3; ++sec) {
            const int col = sec * 512 + h * 128 + cc;
            float y[16];
#pragma unroll
            for (int e = 0; e < 16; ++e) y[e] = 0.f;
#pragma unroll
            for (int j = 0; j < 4; ++j) { const int tl = n * 64 + t - 3 + j;
                if (tl >= 0) { const bf16_t* rp = PROJ + (size_t)(b * 2048 + tl) * PLD + col; const u32x4 x0 = *(const u32x4*)rp, x1 = *(const u32x4*)(rp + 8);
                    const float* wp = p.conv_w + j * 1536 + col;
#pragma unroll
                    for (int e = 0; e < 4; ++e) { const f32x4 w = *(const f32x4*)(wp + e * 4); const unsigned ua = (e < 2 ? x0[2 * e] : x1[2 * e - 4]), ub = (e < 2 ? x0[2 * e + 1] : x1[2 * e - 3]);
                        y[e * 4] += bflo(ua) * w[0]; y[e * 4 + 1] += bfhi(ua) * w[1]; y[e * 4 + 2] += bflo(ub) * w[2]; y[e * 4 + 3] += bfhi(ub) * w[3]; } } }
            float ss = 0.f;
#pragma unroll
            for (int e = 0; e < 16; ++e) { y[e] = siluf_(y[e]); ss += y[e] * y[e]; }
            if (sec < 2) { ss += __shfl_xor(ss, 1); ss += __shfl_xor(ss, 2); ss += __shfl_xor(ss, 4);
                const float sc = rsqrtf(ss + EPS) * (sec == 0 ? 0.08838834764831845f : 1.f);
#pragma unroll
                for (int e = 0; e < 16; ++e) y[e] *= sc; }
            if (sec == 0) {
                u32x4 o0, o1, d0, d1;
#pragma unroll
                for (int e = 0; e < 4; ++e) { o0[e] = cvt_pk_bf16(y[2 * e], y[2 * e + 1]); o1[e] = cvt_pk_bf16(y[8 + 2 * e], y[9 + 2 * e]);
                    d0[e] = cvt_pk_bf16(y[2 * e] * eg, y[2 * e + 1] * eg); d1[e] = cvt_pk_bf16(y[8 + 2 * e] * eg, y[9 + 2 * e] * eg); }
                *(LAS u32x4*)(Qb + t * 136 + cc) = o0; *(LAS u32x4*)(Qb + t * 136 + cc + 8) = o1;
                *(u32x4*)(QD + t * 128 + cc) = d0; *(u32x4*)(QD + t * 128 + cc + 8) = d1;
            } else if (sec == 1) {
                u32x4 o0, o1;
#pragma unroll
                for (int e = 0; e < 4; ++e) { o0[e] = cvt_pk_bf16(y[2 * e], y[2 * e + 1]); o1[e] = cvt_pk_bf16(y[8 + 2 * e], y[9 + 2 * e]); }
                *(LAS u32x4*)(Kb + t * 136 + cc) = o0; *(LAS u32x4*)(Kb + t * 136 + cc + 8) = o1;
                const float s2 = bet * eg;
#pragma unroll
                for (int e = 0; e < 4; ++e) *(LAS f32x4*)(RHS + t * 256 + 128 + cc + e * 4) = (f32x4){y[e * 4] * s2, y[e * 4 + 1] * s2, y[e * 4 + 2] * s2, y[e * 4 + 3] * s2};
            } else {
#pragma unroll
                for (int e = 0; e < 4; ++e) *(LAS f32x4*)(RHS + t * 256 + cc + e * 4) = (f32x4){y[e * 4] * bet, y[e * 4 + 1] * bet, y[e * 4 + 2] * bet, y[e * 4 + 3] * bet};
            }
        }
    }
    __syncthreads();
    {
        const int sel = wave >> 2, it = wave & 3;
        LAS unsigned char* Xb = lds + (sel ? 17408 : 0);
        bf16x8 af[4];
#pragma unroll
        for (int ks = 0; ks < 4; ++ks) af[ks] = lds8(Xb, ((it * 16 + l16) * 136 + ks * 32 + quad * 8) * 2);
#pragma unroll
        for (int jt = 0; jt < 4; ++jt) {
            f32x4 a = {0.f, 0.f, 0.f, 0.f};
            if (jt <= it) {
                if (sel == 0) {
#pragma unroll
                    for (int ks = 0; ks < 4; ++ks) a = mfma16(af[ks], lds8(lds, ((jt * 16 + l16) * 136 + ks * 32 + quad * 8) * 2), a);
                } else {
#pragma unroll
                    for (int ks = 0; ks < 4; ++ks) a = mfma16(lds8(lds, ((jt * 16 + l16) * 136 + ks * 32 + quad * 8) * 2), af[ks], a);
                }
            }
            if (sel == 0) {
                const int j = jt * 16 + l16; const float gj = gcs[j];
#pragma unroll
                for (int r = 0; r < 4; ++r) { const int i = it * 16 + quad * 4 + r;
                    const float dec = (i >= j) ? __expf(gcs[i] - gj) : 0.f;
                    Lm[i * 64 + j] = (i > j) ? bts[i] * a[r] * dec : 0.f; }
            } else {
                const int i = it * 16 + l16; const float gi = gcs[i]; float o4[4];
#pragma unroll
                for (int r = 0; r < 4; ++r) { const int j = jt * 16 + quad * 4 + r; o4[r] = (i >= j) ? a[r] * __expf(gi - gcs[j]) : 0.f; }
                u32x2 w; w[0] = cvt_pk_bf16(o4[0], o4[1]); w[1] = cvt_pk_bf16(o4[2], o4[3]);
                *(u32x2*)(ATT + i * 64 + jt * 16 + quad * 4) = w;
            }
        }
    }
    {
        const int d = tid >> 2, tq = (tid & 3) * 16; const float gl = gcs[63];
        u32x4 o0, o1;
#pragma unroll
        for (int e = 0; e < 8; ++e) { const int t0 = tq + 2 * e;
            const unsigned v = cvt_pk_bf16(bf2f(Kb[t0 * 136 + d]) * __expf(gl - gcs[t0]), bf2f(Kb[(t0 + 1) * 136 + d]) * __expf(gl - gcs[t0 + 1]));
            if (e < 4) o0[e] = v; else o1[e - 4] = v; }
        *(u32x4*)(KDT + d * 64 + tq) = o0; *(u32x4*)(KDT + d * 64 + tq + 8) = o1;
    }
    __syncthreads();
    if (wave < 4 && (p.mask & 32)) {
        const int col = tid;
        const LAS float* Lz = Lm + opaque_zero();
        float x[64];
#pragma unroll
        for (int i = 0; i < 64; ++i) {
            f32x4 lr[16];
#pragma unroll
            for (int j4 = 0; j4 < (i + 3) / 4; ++j4) lr[j4] = *(const LAS f32x4*)(Lz + i * 64 + j4 * 4);
            const float rcur = RHS[i * 256 + col];
            __builtin_amdgcn_sched_barrier(0);
            float s4[4] = {0.f, 0.f, 0.f, 0.f};
#pragma unroll
            for (int j4 = 0; j4 < (i + 3) / 4; ++j4) {
#pragma unroll
                for (int e = 0; e < 4; ++e) if (j4 * 4 + e < i) s4[e] += lr[j4][e] * x[j4 * 4 + e]; }
            x[i] = rcur - ((s4[0] + s4[1]) + (s4[2] + s4[3]));
            __builtin_amdgcn_sched_barrier(0);
        }
#pragma unroll
        for (int i = 0; i < 64; ++i) RHS[i * 256 + col] = x[i];
    }
    __syncthreads();
#pragma unroll
    for (int q = 0; q < 4; ++q) { const int idx = tid + 512 * q, which = idx >> 10, rem = idx & 1023, i = rem >> 4, c8 = (rem & 15) * 8;
        const f32x4 a = *(const LAS f32x4*)(RHS + i * 256 + which * 128 + c8), b = *(const LAS f32x4*)(RHS + i * 256 + which * 128 + c8 + 4);
        *(u32x4*)((which ? W : U) + i * 128 + c8) = pack8(a, b); }
}

static __device__ __forceinline__ void phase_delta_pre(const Params& p, LAS unsigned char* lds) {
    const int wg = blockIdx.x, G = gridDim.x, tid = threadIdx.x;
    const bf16_t* PROJ = (const bf16_t*)(p.ws + OFF_PROJ);
    for (int i = wg * 512 + tid; i < 8 * 3 * 1536; i += G * 512) { const int b = i / 4608, r = i % 4608, j = r / 1536, ch = r % 1536;
        p.out[O_SCP + i] = bf2f(PROJ[(size_t)(b * 2048 + 2045 + j) * PLD + ch]); }
    for (int ci = wg; ci < 1024; ci += G) delta_chunk_item(p, lds, ci);
}

struct ScanFr { bf16x8 w[4], qd[4], at[2], kd[2][2]; u32x2 u[2]; };
__device__ __forceinline__ void scan_load(ScanFr& f, const Params& p, int ci, int vb, int vp, int tt, int dtb, int l16, int quad) {
    const bf16_t* U = (const bf16_t*)((const unsigned char*)p.out + DO_U) + (size_t)ci * 8192; const bf16_t* W = (const bf16_t*)((const unsigned char*)p.out + DO_W) + (size_t)ci * 8192;
    const bf16_t* QD = (const bf16_t*)((const unsigned char*)p.out + DO_QD) + (size_t)ci * 8192; const bf16_t* KDT = (const bf16_t*)((const unsigned char*)p.out + DO_KDT) + (size_t)ci * 8192;
    const bf16_t* ATT = (const bf16_t*)(p.ws + OFF_ATTN) + (size_t)ci * 4096;
#pragma unroll
    for (int ks = 0; ks < 4; ++ks) { f.w[ks] = ldg8(W + (tt * 16 + l16) * 128 + ks * 32 + quad * 8); f.qd[ks] = ldg8(QD + (tt * 16 + l16) * 128 + ks * 32 + quad * 8); }
#pragma unroll
    for (int ks = 0; ks < 2; ++ks) { f.at[ks] = ldg8(ATT + (tt * 16 + l16) * 64 + ks * 32 + quad * 8);
#pragma unroll
        for (int d = 0; d < 2; ++d) f.kd[d][ks] = ldg8(KDT + ((dtb + d) * 16 + l16) * 64 + ks * 32 + quad * 8); }
#pragma unroll
    for (int j = 0; j < 2; ++j) f.u[j] = *(const u32x2*)(U + (tt * 16 + l16) * 128 + vb * 64 + (vp * 2 + j) * 16 + quad * 4);
}
static __device__ __forceinline__ void scan_unit(const Params& p, LAS unsigned char* lds, int unit) {
    const int tid = threadIdx.x, lane = tid & 63, wave = tid >> 6, l16 = lane & 15, quad = lane >> 4;
    const int bh = unit >> 1, vb = unit & 1, b = bh >> 2, h = bh & 3;
    const int vp = wave & 1, tt = wave >> 1, dtb = (wave >> 1) * 2;
    LAS bf16_t* STs = (LAS bf16_t*)lds;
    LAS bf16_t* vnT = (LAS bf16_t*)(lds + 17408);
    bf16_t* PROJ = (bf16_t*)(p.ws + OFF_PROJ); const float* GL = (const float*)(p.ws + OFF_GL);
    __syncthreads();
    for (int i = tid; i < 64 * 136 / 2; i += 512) ((LAS unsigned*)STs)[i] = 0u;
    f32x4 accS[2][2];
#pragma unroll
    for (int j = 0; j < 2; ++j)
#pragma unroll
        for (int d = 0; d < 2; ++d) accS[j][d] = (f32x4){0.f, 0.f, 0.f, 0.f};
    const int ci0 = bh * 32;
    const float glv = GL[ci0 + (lane & 31)];
    ScanFr cur, nxt;
    scan_load(cur, p, ci0, vb, vp, tt, dtb, l16, quad);
    nxt = cur;
    __syncthreads();
    for (int n = 0; n < 32; ++n) {
        if (n + 1 < 32) scan_load(nxt, p, ci0 + n + 1, vb, vp, tt, dtb, l16, quad);
        const float gl = __shfl(glv, n);
        f32x4 aW[2], aQ[2];
#pragma unroll
        for (int j = 0; j < 2; ++j) { aW[j] = (f32x4){0.f, 0.f, 0.f, 0.f}; aQ[j] = (f32x4){0.f, 0.f, 0.f, 0.f};
#pragma unroll
            for (int ks = 0; ks < 4; ++ks) { const bf16x8 a = lds8(lds, (((vp * 2 + j) * 16 + l16) * 136 + ks * 32 + quad * 8) * 2); aW[j] = mfma16(a, cur.w[ks], aW[j]); aQ[j] = mfma16(a, cur.qd[ks], aQ[j]); } }
#pragma unroll
        for (int j = 0; j < 2; ++j) { const int vr = (vp * 2 + j) * 16 + quad * 4, tc = tt * 16 + l16;
            vnT[(vr + 0) * 72 + tc] = f2bf(bflo(cur.u[j][0]) - aW[j][0]); vnT[(vr + 1) * 72 + tc] = f2bf(bfhi(cur.u[j][0]) - aW[j][1]);
            vnT[(vr + 2) * 72 + tc] = f2bf(bflo(cur.u[j][1]) - aW[j][2]); vnT[(vr + 3) * 72 + tc] = f2bf(bfhi(cur.u[j][1]) - aW[j][3]); }
        asm volatile("s_waitcnt lgkmcnt(0)" ::: "memory"); __builtin_amdgcn_s_barrier(); asm volatile("" ::: "memory");
#pragma unroll
        for (int j = 0; j < 2; ++j) { accS[j][0] *= gl; accS[j][1] *= gl;
#pragma unroll
            for (int ks = 0; ks < 2; ++ks) { const bf16x8 a = lds8(lds, 17408 + (((vp * 2 + j) * 16 + l16) * 72 + ks * 32 + quad * 8) * 2);
                aQ[j] = mfma16(a, cur.at[ks], aQ[j]); accS[j][0] = mfma16(a, cur.kd[0][ks], accS[j][0]); accS[j][1] = mfma16(a, cur.kd[1][ks], accS[j][1]); }
            u32x2 o; o[0] = cvt_pk_bf16(aQ[j][0], aQ[j][1]); o[1] = cvt_pk_bf16(aQ[j][2], aQ[j][3]);
            *(u32x2*)(PROJ + (size_t)(b * 2048 + n * 64 + tt * 16 + l16) * PLD + C_AQ + h * 128 + vb * 64 + (vp * 2 + j) * 16 + quad * 4) = o;
#pragma unroll
            for (int d = 0; d < 2; ++d)
#pragma unroll
                for (int r = 0; r < 4; ++r) STs[((vp * 2 + j) * 16 + quad * 4 + r) * 136 + (dtb + d) * 16 + l16] = f2bf(accS[j][d][r]); }
        asm volatile("s_waitcnt lgkmcnt(0)" ::: "memory"); __builtin_amdgcn_s_barrier(); asm volatile("" ::: "memory");
        cur = nxt;
    }
    float* sdp = p.out + O_SDP + (size_t)bh * 16384;
#pragma unroll
    for (int j = 0; j < 2; ++j)
#pragma unroll
        for (int d = 0; d < 2; ++d) *(f32x4*)(sdp + (size_t)((dtb + d) * 16 + l16) * 128 + vb * 64 + (vp * 2 + j) * 16 + quad * 4) = accS[j][d];
}

static __device__ __forceinline__ void sample_delta_item(const Params& p, LAS unsigned char* lds, int it) {
    const int tid = threadIdx.x, b = it >> 2, h = it & 3;
    const bf16_t* PROJ = (const bf16_t*)(p.ws + OFF_PROJ); const float* betag = (const float*)(p.ws + OFF_BETAG); bf16_t* ACT = (bf16_t*)(p.ws + OFF_ACT);
    LAS float* qkv = (LAS float*)lds;
    LAS float* red = (LAS float*)(lds + 2048);
    LAS float* fin = (LAS float*)(lds + 2048 + 16384);
    LAS float* sc = (LAS float*)(lds + 2048 + 16384 + 1024);
    const size_t prow = (size_t)(NP + b) * PLD;
    __syncthreads();
    float yv = 0.f;
    if (tid < 384) { const int sec = tid >> 7, c = tid & 127, ch = sec * 512 + h * 128 + c;
        const float b0 = p.state_conv[(size_t)(b * 3 + 0) * 1536 + ch], b1 = p.state_conv[(size_t)(b * 3 + 1) * 1536 + ch], b2 = p.state_conv[(size_t)(b * 3 + 2) * 1536 + ch];
        const float xn = bf2f(PROJ[prow + ch]);
        float y = b0 * p.conv_w[ch] + b1 * p.conv_w[1536 + ch] + b2 * p.conv_w[3072 + ch] + xn * p.conv_w[4608 + ch];
        yv = siluf_(y);
        float* scs = p.out + O_SCS + (size_t)b * 4608;
        scs[ch] = b1; scs[1536 + ch] = b2; scs[3072 + ch] = xn;
    }
    {
        float ss = wave_sum(yv * yv);
        if ((tid & 63) == 0) sc[8 + (tid >> 6)] = ss;
    }
    __syncthreads();
    if (tid < 384) { const int sec = tid >> 7, c = tid & 127;
        float v = yv;
        if (sec == 0) v *= rsqrtf(sc[8] + sc[9] + EPS) * 0.08838834764831845f;
        else if (sec == 1) v *= rsqrtf(sc[10] + sc[11] + EPS);
        qkv[sec * 128 + c] = v; }
    __syncthreads();
    const int dvq = tid & 31, dkg = tid >> 5;
    const float* S0 = p.state_delta + (size_t)it * 16384;
    f32x4 s[8]; f32x4 pk = {0.f, 0.f, 0.f, 0.f}, pq = {0.f, 0.f, 0.f, 0.f};
#pragma unroll
    for (int j = 0; j < 8; ++j) { const int dk = dkg * 8 + j; s[j] = *(const f32x4*)(S0 + (size_t)dk * 128 + dvq * 4); pk += s[j] * qkv[128 + dk]; pq += s[j] * qkv[dk]; }
    *(LAS f32x4*)(red + dkg * 256 + dvq * 4) = pk; *(LAS f32x4*)(red + dkg * 256 + 128 + dvq * 4) = pq;
    {
        float qk = (tid < 128) ? qkv[tid] * qkv[128 + tid] : 0.f; qk = wave_sum(qk);
        if (tid < 128 && (tid & 63) == 0) sc[tid >> 6] = qk;
    }
    __syncthreads();
    const float beta = betag[(size_t)(NP + b) * 8 + h], a = __expf(betag[(size_t)(NP + b) * 8 + 4 + h]);
    if (tid < 128) { float sk = 0.f, sq = 0.f;
#pragma unroll
        for (int g = 0; g < 16; ++g) { sk += red[g * 256 + tid]; sq += red[g * 256 + 128 + tid]; }
        const float vn = beta * (qkv[256 + tid] - a * sk); const float o = a * sq + (sc[0] + sc[1]) * vn;
        fin[tid] = vn; fin[128 + tid] = o;
        const float oo = wave_sum(o * o); if ((tid & 63) == 0) sc[4 + (tid >> 6)] = oo; }
    __syncthreads();
    const f32x4 vn4 = *(const LAS f32x4*)(fin + dvq * 4);
    float* Sn = p.out + O_SDS + (size_t)it * 16384;
#pragma unroll
    for (int j = 0; j < 8; ++j) { const int dk = dkg * 8 + j; *(f32x4*)(Sn + (size_t)dk * 128 + dvq * 4) = s[j] * a + vn4 * qkv[128 + dk]; }
    if (tid < 128) { const float rstd = rsqrtf((sc[4] + sc[5]) * (1.f / 128.f) + EPS);
        const float gt = bf2f(PROJ[prow + C_AGATE + h * 128 + tid]);
        ACT[(size_t)(NP + b) * LDA + A_YA + h * 128 + tid] = f2bf(fin[128 + tid] * rstd * p.a_norm_g[tid] * siluf_(gt)); }
}

static __device__ __forceinline__ void sample_xattn_item(const Params& p, LAS unsigned char* lds, int it) {
    const int tid = threadIdx.x, lane = tid & 63, wave = tid >> 6, b = it >> 2, h = it & 3;
    const bf16_t* PROJ = (const bf16_t*)(p.ws + OFF_PROJ); bf16_t* ACT = (bf16_t*)(p.ws + OFF_ACT);
    LAS float* scr = (LAS float*)lds;
    LAS float* red = (LAS float*)(lds + 1024);
    const int half = lane >> 5, dl = lane & 31;
    const size_t prow = (size_t)(NP + b) * PLD;
    f32x4 q; { const bf16_t* qp = PROJ + prow + C_CQ + h * 128 + dl * 4; const u32x2 u = *(const u32x2*)qp; q = (f32x4){bflo(u[0]), bfhi(u[0]), bflo(u[1]), bfhi(u[1])}; }
    const float* Kp = p.cache_k + ((size_t)(b * 256) * 4 + h) * 128 + dl * 4; const float* Vp = p.cache_v + ((size_t)(b * 256) * 4 + h) * 128 + dl * 4;
    __syncthreads();
    f32x4 kv[16];
#pragma unroll
    for (int i = 0; i < 16; ++i) { const int m = wave * 32 + i * 2 + half; kv[i] = *(const f32x4*)(Kp + (size_t)m * 512); }
#pragma unroll
    for (int i = 0; i < 16; ++i) { float d = kv[i][0] * q[0] + kv[i][1] * q[1] + kv[i][2] * q[2] + kv[i][3] * q[3];
#pragma unroll
        for (int o = 16; o >= 1; o >>= 1) d += __shfl_xor(d, o);
        if (dl == 0) scr[wave * 32 + i * 2 + half] = d * 0.08838834764831845f; }
#pragma unroll
    for (int i = 0; i < 16; ++i) { const int m = wave * 32 + i * 2 + half; kv[i] = *(const f32x4*)(Vp + (size_t)m * 512); }
    __syncthreads();
    float mx = -3.0e38f;
#pragma unroll
    for (int i = 0; i < 4; ++i) mx = fmaxf(mx, scr[lane + 64 * i]);
#pragma unroll
    for (int o = 32; o >= 1; o >>= 1) mx = fmaxf(mx, __shfl_xor(mx, o));
    float sm = 0.f;
#pragma unroll
    for (int i = 0; i < 4; ++i) sm += __expf(scr[lane + 64 * i] - mx);
    sm = wave_sum(sm);
    const float inv = 1.f / sm;
    f32x4 o = {0.f, 0.f, 0.f, 0.f};
#pragma unroll
    for (int i = 0; i < 16; ++i) { const float pr = __expf(scr[wave * 32 + i * 2 + half] - mx) * inv; o += kv[i] * pr; }
    *(LAS f32x4*)(red + (wave * 2 + half) * 128 + dl * 4) = o;
    __syncthreads();
    if (tid < 128) { float s = 0.f;
#pragma unroll
        for (int g = 0; g < 16; ++g) s += red[g * 128 + tid];
        const float gt = bf2f(PROJ[prow + C_CGATE + h * 128 + tid]);
        ACT[(size_t)(NP + b) * LDA + A_YC + h * 128 + tid] = f2bf(s * siluf_(gt)); }
}

static __device__ __forceinline__ void sample_mlp_item(const Params& p, int it) {
    const int tid = threadIdx.x, lane = tid & 63, wave = tid >> 6, b = it * 8 + wave;
    const bf16_t* PROJ = (const bf16_t*)(p.ws + OFF_PROJ); bf16_t* ACT = (bf16_t*)(p.ws + OFF_ACT);
    const size_t prow = (size_t)(NP + b) * PLD; const int c0 = lane * 8;
    const u32x4 xv = *(const u32x4*)(PROJ + prow + C_BV + c0), xu = *(const u32x4*)(PROJ + prow + C_BU + c0), xg = *(const u32x4*)(PROJ + prow + C_BGATE + c0);
    float v[8], s1 = 0.f, s2 = 0.f;
#pragma unroll
    for (int e = 0; e < 4; ++e) { v[2 * e] = bflo(xv[e]); v[2 * e + 1] = bfhi(xv[e]); }
#pragma unroll
    for (int e = 0; e < 8; ++e) s1 += v[e];
    s1 = wave_sum(s1); const float mu = s1 * (1.f / 512.f);
#pragma unroll
    for (int e = 0; e < 8; ++e) { v[e] -= mu; s2 += v[e] * v[e]; }
    s2 = wave_sum(s2); const float rstd = rsqrtf(s2 * (1.f / 512.f) + EPS);
    const int g = c0 >> 7; const float w00 = p.w_spatial[(size_t)g * 16384], bs = p.b_spatial[g * 128];
    float* cvs = p.out + O_CVS + (size_t)b * 512 + c0;
    u32x4 o;
#pragma unroll
    for (int e = 0; e < 4; ++e) { float r[2];
#pragma unroll
        for (int z = 0; z < 2; ++z) { const int c = c0 + 2 * e + z; const float vn = v[2 * e + z] * rstd * p.ln_v_g[c] + p.ln_v_b[c]; cvs[2 * e + z] = vn;
            const float uu = z ? bfhi(xu[e]) : bflo(xu[e]), gg = z ? bfhi(xg[e]) : bflo(xg[e]); r[z] = uu * (w00 * vn + bs) * siluf_(gg); }
        o[e] = cvt_pk_bf16(r[0], r[1]); }
    *(u32x4*)(ACT + (size_t)(NP + b) * LDA + A_YB + c0) = o;
}

static __device__ __forceinline__ void mlp_item(const Params& p, LAS unsigned char* lds, int it) {
    const int tid = threadIdx.x, lane = tid & 63, wave = tid >> 6, l16 = lane & 15, quad = lane >> 4;
    const int row0 = (it >> 4) * 2048 + (it & 15) * 128;
    const bf16_t* PROJ = (const bf16_t*)(p.ws + OFF_PROJ); bf16_t* ACT = (bf16_t*)(p.ws + OFF_ACT);
    LAS bf16_t* vnT = (LAS bf16_t*)lds;
    LAS bf16_t* Wsm = (LAS bf16_t*)(lds + 34816);
    LAS float* st = (LAS float*)(lds + 69632);
    __syncthreads();
    { const int r = tid >> 2, part = tid & 3; const bf16_t* rp = PROJ + (size_t)(row0 + r) * PLD + C_BV + part * 128; float s1 = 0.f, s2 = 0.f;
#pragma unroll
      for (int i = 0; i < 16; ++i) { const u32x4 x = *(const u32x4*)(rp + i * 8);
#pragma unroll
          for (int e = 0; e < 4; ++e) { const float a = bflo(x[e]), c = bfhi(x[e]); s1 += a + c; s2 += a * a + c * c; } }
      s1 += __shfl_xor(s1, 1); s1 += __shfl_xor(s1, 2); s2 += __shfl_xor(s2, 1); s2 += __shfl_xor(s2, 2);
      const float mu = s1 * (1.f / 512.f); const float var = fmaxf(s2 * (1.f / 512.f) - mu * mu, 0.f);
      if (part == 0) { st[r * 2] = mu; st[r * 2 + 1] = rsqrtf(var + EPS); } }
    __syncthreads();
#pragma unroll 1
    for (int g = 0; g < 4; ++g) {
        { const int s = lane + 64 * (wave & 1), cq = (wave >> 1) * 32; const float mu = st[s * 2], rstd = st[s * 2 + 1];
          const bf16_t* rp = PROJ + (size_t)(row0 + s) * PLD + C_BV + g * 128 + cq;
#pragma unroll
          for (int i = 0; i < 4; ++i) { const u32x4 x = *(const u32x4*)(rp + i * 8);
#pragma unroll
              for (int e = 0; e < 4; ++e) { const int c = cq + i * 8 + 2 * e; const int gc = g * 128 + c;
                  vnT[c * 136 + s] = f2bf((bflo(x[e]) - mu) * rstd * p.ln_v_g[gc] + p.ln_v_b[gc]);
                  vnT[(c + 1) * 136 + s] = f2bf((bfhi(x[e]) - mu) * rstd * p.ln_v_g[gc + 1] + p.ln_v_b[gc + 1]); } }
          const int t = tid >> 2, sq = (tid & 3) * 32; const float* wp = p.w_spatial + ((size_t)g * 128 + t) * 128 + sq;
#pragma unroll
          for (int i = 0; i < 4; ++i) { const f32x4 w0 = *(const f32x4*)(wp + i * 8), w1 = *(const f32x4*)(wp + i * 8 + 4); const int s0 = sq + i * 8;
              f32x4 m0, m1;
#pragma unroll
              for (int e = 0; e < 4; ++e) { m0[e] = (s0 + e <= t) ? w0[e] : 0.f; m1[e] = (s0 + 4 + e <= t) ? w1[e] : 0.f; }
              *(LAS u32x4*)(Wsm + t * 136 + s0) = pack8(m0, m1); } }
        __syncthreads();
        f32x4 acc[8];
#pragma unroll
        for (int ct = 0; ct < 8; ++ct) acc[ct] = (f32x4){0.f, 0.f, 0.f, 0.f};
        const int nks = (wave >> 1) + 1;
        for (int ks = 0; ks < nks; ++ks) { const bf16x8 bw = lds8(lds, 34816 + ((wave * 16 + l16) * 136 + ks * 32 + quad * 8) * 2);
#pragma unroll
            for (int ct = 0; ct < 8; ++ct) acc[ct] = mfma16(lds8(lds, ((ct * 16 + l16) * 136 + ks * 32 + quad * 8) * 2), bw, acc[ct]); }
        const int t = wave * 16 + l16; const size_t prow = (size_t)(row0 + t) * PLD; const float bs = p.b_spatial[g * 128 + t];
#pragma unroll
        for (int ct = 0; ct < 8; ++ct) { const int col = g * 128 + ct * 16 + quad * 4;
            const u32x2 xu = *(const u32x2*)(PROJ + prow + C_BU + col), xg = *(const u32x2*)(PROJ + prow + C_BGATE + col);
            u32x2 o; o[0] = cvt_pk_bf16(bflo(xu[0]) * (acc[ct][0] + bs) * siluf_(bflo(xg[0])), bfhi(xu[0]) * (acc[ct][1] + bs) * siluf_(bfhi(xg[0])));
            o[1] = cvt_pk_bf16(bflo(xu[1]) * (acc[ct][2] + bs) * siluf_(bflo(xg[1])), bfhi(xu[1]) * (acc[ct][3] + bs) * siluf_(bfhi(xg[1])));
            *(u32x2*)(ACT + (size_t)(row0 + t) * LDA + A_YB + col) = o; }
        __syncthreads();
    }
}

static __device__ __forceinline__ void xattn_item(const Params& p, LAS unsigned char* lds, int it) {
    const int tid = threadIdx.x, lane = tid & 63, wave = tid >> 6, l16 = lane & 15, quad = lane >> 4;
    const int b = it >> 6, h = (it >> 4) & 3, qt = it & 15;
    const bf16_t* PROJ = (const bf16_t*)(p.ws + OFF_PROJ); bf16_t* ACT = (bf16_t*)(p.ws + OFF_ACT); const bf16_t* MKV = (const bf16_t*)(p.ws + OFF_MEMKV);
    LAS bf16_t* Ks = (LAS bf16_t*)lds;
    LAS bf16_t* Vt = (LAS bf16_t*)(lds + 69632);
    __syncthreads();
#pragma unroll
    for (int i = 0; i < 8; ++i) { const int idx = wave * 8 + i, m = (idx & 3) * 64 + lane, dc = (idx >> 2) * 8; const bf16_t* sp = MKV + (size_t)(b * 256 + m) * 1024 + h * 128 + dc;
        *(LAS u32x4*)(Ks + m * 136 + dc) = *(const u32x4*)sp;
        const u32x4 v = *(const u32x4*)(sp + 512);
#pragma unroll
        for (int e = 0; e < 4; ++e) { Vt[(dc + 2 * e) * 264 + m] = (bf16_t)(v[e] & 0xffffu); Vt[(dc + 2 * e + 1) * 264 + m] = (bf16_t)(v[e] >> 16); } }
    const int q0 = b * 2048 + qt * 128 + wave * 16; const size_t prow = (size_t)(q0 + l16) * PLD;
    bf16x8 qf[4];
#pragma unroll
    for (int ks = 0; ks < 4; ++ks) qf[ks] = ldg8(PROJ + prow + C_CQ + h * 128 + ks * 32 + quad * 8);
    __syncthreads();
    f32x4 s[16];
#pragma unroll
    for (int mt = 0; mt < 16; ++mt) { s[mt] = (f32x4){0.f, 0.f, 0.f, 0.f};
#pragma unroll
        for (int ks = 0; ks < 4; ++ks) s[mt] = mfma16(lds8(lds, ((mt * 16 + l16) * 136 + ks * 32 + quad * 8) * 2), qf[ks], s[mt]); }
    float mx = -3.0e38f;
#pragma unroll
    for (int mt = 0; mt < 16; ++mt)
#pragma unroll
        for (int r = 0; r < 4; ++r) mx = fmaxf(mx, s[mt][r]);
    mx = fmaxf(mx, __shfl_xor(mx, 16)); mx = fmaxf(mx, __shfl_xor(mx, 32));
    const float sc = 0.08838834764831845f * 1.4426950408889634f; float sm = 0.f;
#pragma unroll
    for (int mt = 0; mt < 16; ++mt)
#pragma unroll
        for (int r = 0; r < 4; ++r) { s[mt][r] = exp2f((s[mt][r] - mx) * sc); sm += s[mt][r]; }
    sm += __shfl_xor(sm, 16); sm += __shfl_xor(sm, 32);
    const float inv = 1.f / sm;
    bf16x8 pb[8];
#pragma unroll
    for (int ss = 0; ss < 8; ++ss) { const u32x4 pu = pack8(s[2 * ss], s[2 * ss + 1]); pb[ss] = __builtin_bit_cast(bf16x8, pu); }
#pragma unroll 1
    for (int dt = 0; dt < 8; ++dt) {
        f32x4 o = {0.f, 0.f, 0.f, 0.f};
#pragma unroll
        for (int ss = 0; ss < 8; ++ss) { const bf16x4 v0 = *(const LAS bf16x4*)(Vt + (dt * 16 + l16) * 264 + ss * 32 + quad * 4), v1 = *(const LAS bf16x4*)(Vt + (dt * 16 + l16) * 264 + ss * 32 + 16 + quad * 4);
            o = mfma16(__builtin_shufflevector(v0, v1, 0, 1, 2, 3, 4, 5, 6, 7), pb[ss], o); }
        const int col = h * 128 + dt * 16 + quad * 4; const u32x2 xg = *(const u32x2*)(PROJ + prow + C_CGATE + col);
        u32x2 w; w[0] = cvt_pk_bf16(o[0] * inv * siluf_(bflo(xg[0])), o[1] * inv * siluf_(bfhi(xg[0])));
        w[1] = cvt_pk_bf16(o[2] * inv * siluf_(bflo(xg[1])), o[3] * inv * siluf_(bfhi(xg[1])));
        *(u32x2*)(ACT + (size_t)(q0 + l16) * LDA + A_YC + col) = w;
        __builtin_amdgcn_sched_barrier(0); }
}

static __device__ __forceinline__ void phase_mixers(const Params& p, LAS unsigned char* lds) {
    const int wg = blockIdx.x, G = gridDim.x, tid = threadIdx.x;
    if (p.mask & 1) for (int w = wg; w < 64; w += G) { const int xcd = w & 7, sl = w >> 3; scan_unit(p, lds, ((xcd * 4 + (sl >> 1)) << 1) | (sl & 1)); }
    if (G > 64) { for (int it = wg - 64; it >= 0 && it < 128; it += G - 64) mlp_item(p, lds, it); }
    else { for (int it = wg; it < 128; it += G) mlp_item(p, lds, it); }
    unsigned* cnt = (unsigned*)(p.ws + OFF_CNT);
    LAS unsigned* slot = (LAS unsigned*)(lds + LDS_ITEM);
    for (;;) {
        __syncthreads();
        if (tid == 0) *slot = atomicAdd(cnt, 1u);
        __syncthreads();
        const int it = (int)*slot;
        if (it >= 1552) break;
        if (it < 512) xattn_item(p, lds, it);
        else if (it < 1024) sample_delta_item(p, lds, it - 512);
        else if (it < 1536) sample_xattn_item(p, lds, it - 1024);
        else sample_mlp_item(p, it - 1536);
    }
}

static __device__ __forceinline__ void phase_ya(const Params& p) {
    const int tid = threadIdx.x, lane = tid & 63, wave = tid >> 6;
    const bf16_t* PROJ = (const bf16_t*)(p.ws + OFF_PROJ); bf16_t* ACT = (bf16_t*)(p.ws + OFF_ACT);
    const int c0 = lane * 8, d0 = c0 & 127, nw = gridDim.x * 8;
    f32x4 ng0 = *(const f32x4*)(p.a_norm_g + d0), ng1 = *(const f32x4*)(p.a_norm_g + d0 + 4);
    for (int row0 = blockIdx.x * 8 + wave; row0 < NP; row0 += nw * 4) {
        u32x4 xo[4], xg[4];
#pragma unroll
        for (int k = 0; k < 4; ++k) { const int row = row0 + k * nw; if (row < NP) { const size_t prow = (size_t)row * PLD; xo[k] = *(const u32x4*)(PROJ + prow + C_AQ + c0); xg[k] = *(const u32x4*)(PROJ + prow + C_AGATE + c0); } }
#pragma unroll
        for (int k = 0; k < 4; ++k) { const int row = row0 + k * nw; if (row < NP) {
            float v[8], ss = 0.f;
#pragma unroll
            for (int e = 0; e < 4; ++e) { v[2 * e] = bflo(xo[k][e]); v[2 * e + 1] = bfhi(xo[k][e]); ss += v[2 * e] * v[2 * e] + v[2 * e + 1] * v[2 * e + 1]; }
            ss += __shfl_xor(ss, 1); ss += __shfl_xor(ss, 2); ss += __shfl_xor(ss, 4); ss += __shfl_xor(ss, 8);
            const float rstd = rsqrtf(ss * (1.f / 128.f) + EPS);
            u32x4 o;
#pragma unroll
            for (int e = 0; e < 4; ++e) { const float g0 = e < 2 ? ng0[2 * e] : ng1[2 * e - 4], g1 = e < 2 ? ng0[2 * e + 1] : ng1[2 * e - 3];
                o[e] = cvt_pk_bf16(v[2 * e] * rstd * g0 * siluf_(bflo(xg[k][e])), v[2 * e + 1] * rstd * g1 * siluf_(bfhi(xg[k][e]))); }
            *(u32x4*)(ACT + (size_t)row * LDA + A_YA + c0) = o; } }
    }
}

template <int NKS> __device__ __forceinline__ f32x4 small_gemm(const bf16_t* Wt, const bf16_t* A) {
    bf16x8 wv[NKS], av[NKS];
#pragma unroll
    for (int ks = 0; ks < NKS; ++ks) { wv[ks] = ldg8(Wt + ks * 32); av[ks] = ldg8(A + ks * 32); }
    f32x4 acc = {0.f, 0.f, 0.f, 0.f};
#pragma unroll
    for (int ks = 0; ks < NKS; ++ks) acc = mfma16(wv[ks], av[ks], acc);
    return acc;
}
static __device__ __forceinline__ void sample_g3(const Params& p, LAS unsigned char* lds) {
    const int tid = threadIdx.x, lane = tid & 63, wave = tid >> 6, l16 = lane & 15, quad = lane >> 4, c = blockIdx.x;
    const int ct = c >> 2, rt = 2 * (c & 3) + (wave >> 2), kp = wave & 3;
    const bf16_t* ACT = (const bf16_t*)(p.ws + OFF_ACT); const bf16_t* WG3 = (const bf16_t*)(p.ws + OFF_WG3); bf16_t* MERGED = (bf16_t*)(p.ws + OFF_MERGED);
    const int r = NP + rt * 16 + l16 + opaque_zero(), n0 = ct * 16;
    LAS f32x4* red = (LAS f32x4*)lds;
#pragma unroll
    for (int br = 0; br < 3; ++br) {
        const bf16_t* wrow = WG3 + ((size_t)br * 1024 + n0 + l16) * 1536 + quad * 8; const bf16_t* arow = ACT + (size_t)r * LDA + quad * 8;
        red[(wave * 6 + 2 * br) * 64 + lane] = small_gemm<8>(wrow + kp * 256, arow + kp * 256);
        red[(wave * 6 + 2 * br + 1) * 64 + lane] = small_gemm<4>(wrow + 1024 + kp * 128, arow + A_YA + br * 512 + kp * 128);
    }
    __syncthreads();
    if (kp == 0) {
        f32x4 m = {0.f, 0.f, 0.f, 0.f};
#pragma unroll
        for (int br = 0; br < 3; ++br) {
            f32x4 ag = {0.f, 0.f, 0.f, 0.f}, at = {0.f, 0.f, 0.f, 0.f};
#pragma unroll
            for (int k = 0; k < 4; ++k) { ag += red[((wave + k) * 6 + 2 * br) * 64 + lane]; at += red[((wave + k) * 6 + 2 * br + 1) * 64 + lane]; }
            const f32x4 bg = *(const f32x4*)(p.b_gate + br * 1024 + n0 + quad * 4);
#pragma unroll
            for (int e = 0; e < 4; ++e) m[e] += sigmoidf_(ag[e] + bg[e]) * at[e];
        }
        u32x2 o; o[0] = cvt_pk_bf16(m[0], m[1]); o[1] = cvt_pk_bf16(m[2], m[3]);
        *(u32x2*)(MERGED + (size_t)r * 1024 + n0 + quad * 4) = o;
    }
}
static __device__ __forceinline__ void sample_g4(const Params& p, LAS unsigned char* lds) {
    const int tid = threadIdx.x, lane = tid & 63, wave = tid >> 6, l16 = lane & 15, quad = lane >> 4, c = blockIdx.x;
    const int ct = c >> 2, rt = 2 * (c & 3) + (wave >> 2), kp = wave & 3;
    const bf16_t* WOUT = (const bf16_t*)(p.ws + OFF_WOUT); const bf16_t* MERGED = (const bf16_t*)(p.ws + OFF_MERGED); float* rowsq = (float*)(p.ws + OFF_ROWSQ);
    const int rs = rt * 16 + l16 + opaque_zero(), n0 = ct * 16;
    LAS f32x4* red = (LAS f32x4*)lds;
    red[wave * 64 + lane] = small_gemm<8>(WOUT + (size_t)(n0 + l16) * 1024 + quad * 8 + kp * 256, MERGED + (size_t)(NP + rs) * 1024 + quad * 8 + kp * 256);
    __syncthreads();
    if (kp == 0) {
        f32x4 a = red[wave * 64 + lane] + red[(wave + 1) * 64 + lane] + red[(wave + 2) * 64 + lane] + red[(wave + 3) * 64 + lane];
        const f32x4 v = *(const f32x4*)(p.x_sample + (size_t)rs * 1024 + n0 + quad * 4) + a;
        *(f32x4*)(p.out + O_YS + (size_t)rs * 1024 + n0 + quad * 4) = v;
        float ss = v[0] * v[0] + v[1] * v[1] + v[2] * v[2] + v[3] * v[3];
        ss += __shfl_xor(ss, 16); ss += __shfl_xor(ss, 32);
        if (quad == 0) unsafeAtomicAdd(rowsq + NP + rs, ss);
    }
}

static __device__ __forceinline__ void sample_g4_finish(const Params& p) {
    const int tid = threadIdx.x, lane = tid & 63, wave = tid >> 6, l16 = lane & 15, quad = lane >> 4, c = blockIdx.x;
    const int ct = c >> 2, rt = 2 * (c & 3) + (wave >> 2), kp = wave & 3;
    const float* rowsq = (const float*)(p.ws + OFF_ROWSQ);
    if (kp == 0) { const int rs = rt * 16 + l16, n0 = ct * 16; float* op = p.out + O_YS + (size_t)rs * 1024 + n0 + quad * 4;
        const float r = rsqrtf(__hip_atomic_load(rowsq + NP + rs, __ATOMIC_RELAXED, __HIP_MEMORY_SCOPE_AGENT) * (1.f / 1024.f) + EPS);
        *(f32x4*)op = *(const f32x4*)op * r * *(const f32x4*)(p.final_norm_g + n0 + quad * 4); }
}
static __device__ __forceinline__ void phase_final(const Params& p) {
    const float* rowsq = (const float*)(p.ws + OFF_ROWSQ);
    const int total4 = (NP + NS) * 256, stride = gridDim.x * 512;
    for (int base = blockIdx.x * 512 + threadIdx.x; base < total4; base += stride * 8) {
        f32x4 v[8]; float rs[8];
#pragma unroll
        for (int k = 0; k < 8; ++k) { const int i = base + k * stride; if (i < total4) { v[k] = *(const f32x4*)(p.out + (size_t)i * 4); rs[k] = rowsq[i >> 8]; } }
#pragma unroll
        for (int k = 0; k < 8; ++k) { const int i = base + k * stride; if (i < total4) { const f32x4 g = *(const f32x4*)(p.final_norm_g + (i & 255) * 4);
            *(f32x4*)(p.out + (size_t)i * 4) = v[k] * rsqrtf(rs[k] * (1.f / 1024.f) + EPS) * g; } }
    }
}

__global__ void __launch_bounds__(512, 2) fwd_megakernel(Params p) {
    extern __shared__ __attribute__((aligned(16))) unsigned char shm[];
    LAS unsigned char* lds = (LAS unsigned char*)shm;
    cg::grid_group grid = cg::this_grid();
    const int G = gridDim.x, c = blockIdx.x;
    unsigned* bar = (unsigned*)(p.ws + OFF_BAR); unsigned ep = 0u;
#define PH_BEGIN(k) if (p.ph_lo <= (k) && (k) < p.ph_hi) { if ((k) > p.ph_lo) { if ((k) == 1) grid_sync_all(grid); else fast_sync(bar, ++ep); }
#define PH_END }
#if !defined(ONLY_PH) || ONLY_PH == 0
    PH_BEGIN(0) phase_prep(p, lds); PH_END
#endif
#if !defined(ONLY_PH) || ONLY_PH == 1
    PH_BEGIN(1) { SchedG1 S{(const char*)(p.ws + OFF_ACT), (const char*)(p.ws + OFF_W1T), G, c};
                  EpiG1 E{(bf16_t*)(p.ws + OFF_PROJ), (bf16_t*)(p.ws + OFF_MEMKV), p.out};
                  pg8::gemm_phase(lds, LDA, 1024, S, E); } PH_END
#endif
#if !defined(ONLY_PH) || ONLY_PH == 2
    PH_BEGIN(2) phase_delta_pre(p, lds); PH_END
#endif
#if !defined(ONLY_PH) || ONLY_PH == 3
    PH_BEGIN(3) phase_mixers(p, lds); PH_END
#endif
#if !defined(ONLY_PH) || ONLY_PH == 4
    PH_BEGIN(4) phase_ya(p); PH_END
#endif
#if !defined(ONLY_PH) || ONLY_PH == 5
    PH_BEGIN(5) { SchedG3 S{(const char*)(p.ws + OFF_ACT), (const char*)(p.ws + OFF_WG3), G, c};
                  EpiG3 E{p.ws + OFF_PROJ + (size_t)c * SCR_PER_WG, (bf16_t*)(p.ws + OFF_MERGED), p.b_gate};
                  pg8::gemm_phase(lds, LDA, 1536, S, E);
                  sample_g3(p, lds); } PH_END
#endif
#if !defined(ONLY_PH) || ONLY_PH == 6
    PH_BEGIN(6) { sample_g4(p, lds); __syncthreads();
                  SchedG4 S{(const char*)(p.ws + OFF_MERGED), (const char*)(p.ws + OFF_WOUT), G, c};
                  EpiG4 E{p.x_prompt, p.out, (float*)(p.ws + OFF_ROWSQ), p.final_norm_g, bar, ep + 1u};
                  pg8::gemm_phase(lds, 1024, 1024, S, E);
                  sample_g4_finish(p); } PH_END
#endif
#if !defined(ONLY_PH) || ONLY_PH == 7
#endif
}

extern "C" void kernel_launch(void* const* d_in, const int* in_sizes, int n_in, void* d_out, int out_size, void* d_ws, size_t ws_size, hipStream_t stream) {
    static int grid_blocks = 0;
    if (grid_blocks == 0) {
        if (n_in != 25 || ws_size < WS_END) { fprintf(stderr, "kernel_launch: unexpected n_in %d / ws_size %zu (need %zu)\n", n_in, ws_size, (size_t)WS_END); grid_blocks = -1; return; }
        int dev = 0, cus = 0, per_cu = 0;
        hipGetDevice(&dev);
        hipDeviceGetAttribute(&cus, hipDeviceAttributeMultiprocessorCount, dev);
        if (hipFuncSetAttribute((const void*)fwd_megakernel, hipFuncAttributeMaxDynamicSharedMemorySize, LDS_BYTES) != hipSuccess) { fprintf(stderr, "kernel_launch: hipFuncSetAttribute failed\n"); }
        if (hipOccupancyMaxActiveBlocksPerMultiprocessor(&per_cu, fwd_megakernel, 512, LDS_BYTES) != hipSuccess || per_cu < 1) { fprintf(stderr, "kernel_launch: occupancy query gave %d\n", per_cu); per_cu = 1; }
        (void)hipGetLastError();
        grid_blocks = cus * per_cu; if (grid_blocks > 256) grid_blocks = 256;
        if (grid_blocks != 256) { fprintf(stderr, "kernel_launch: this build needs exactly 256 co-resident workgroups (one output tile each in the fused out-projection epilogue); got %d\n", grid_blocks); grid_blocks = -1; return; }
    }
    if (grid_blocks < 0) return;
    Params p{};
    const float** f = (const float**)&p;
    for (int i = 0; i < 25; ++i) f[i] = (const float*)d_in[i];
    p.out = (float*)d_out; p.ws = (unsigned char*)d_ws; p.ph_lo = 0; p.ph_hi = 8; p.mask = 0xff;
    void* args[] = {&p};
    hipError_t e = hipLaunchCooperativeKernel((const void*)fwd_megakernel, dim3(grid_blocks), dim3(512), args, LDS_BYTES, stream);
    if (e != hipSuccess) fprintf(stderr, "cooperative launch failed: %s (grid %d)\n", hipGetErrorString(e), grid_blocks);
}
```

```cpp
#include <hip/hip_runtime.h>
#include <hip/hip_cooperative_groups.h>
#include <cstdio>
namespace cg = cooperative_groups;

#define LAS __attribute__((address_space(3)))
#define GAS __attribute__((address_space(1)))
typedef unsigned short bf16_t;
typedef short bf16x8 __attribute__((ext_vector_type(8)));
typedef short bf16x4 __attribute__((ext_vector_type(4)));
typedef float f32x4 __attribute__((ext_vector_type(4)));
typedef unsigned u32x4 __attribute__((ext_vector_type(4)));
typedef unsigned u32x2 __attribute__((ext_vector_type(2)));

constexpr int NP = 16384, NS = 128, MROWS = 16640, HM0 = 16640, LDA = 2560, PLD = 4608;
constexpr int C_AQ = 0, C_AK = 512, C_AV = 1024, C_AGATE = 1536, C_BU = 2048, C_BV = 2560, C_BGATE = 3072, C_CQ = 3584, C_CGATE = 4096;
constexpr int A_H = 0, A_YA = 1024, A_YB = 1536, A_YC = 2048;
constexpr float EPS = 1e-6f;
constexpr size_t OFF_W1T = 0;
constexpr size_t OFF_WG3 = 11534336;
constexpr size_t OFF_WOUT = 20971520;
constexpr size_t OFF_ACT = 23068672;
constexpr size_t OFF_PROJ = 118751232;
constexpr size_t OFF_ATTN = 272105472;
constexpr size_t OFF_MEMKV = 280494080;
constexpr size_t OFF_BETAG = 284688384;
constexpr size_t OFF_ROWSQ = 285216768;
constexpr size_t OFF_GL = 285283328;
constexpr size_t OFF_CNT = 285287424;
constexpr size_t OFF_BAR = 285287680;
constexpr size_t WS_END = 285290240;
constexpr size_t SCR_PER_WG = 262144;
constexpr size_t OFF_MERGED = OFF_PROJ + 256 * SCR_PER_WG;
constexpr size_t DO_U = 0, DO_W = 16777216, DO_QD = 33554432, DO_KDT = 50331648;
constexpr size_t O_YS = 16777216, O_SDP = 16908288, O_SCP = 17432576, O_MKP = 17469440, O_MVP = 18518016, O_SDS = 19566592, O_SCS = 27955200, O_CVS = 28545024;
constexpr int LDS_BYTES = 143360;
constexpr int LDS_ITEM = 143344;

struct Params {
    const float *x_prompt, *x_sample, *cache_k, *cache_v, *state_delta, *state_conv, *mem_prompt, *norm_g, *w_in, *conv_w, *a_log, *dt_bias, *a_norm_g,
        *ln_v_g, *ln_v_b, *w_spatial, *b_spatial, *mem_norm_g, *w_mem_kv, *w_br_a, *w_br_b, *w_br_c, *b_gate, *w_out, *final_norm_g;
    float* out;
    unsigned char* ws;
    int ph_lo, ph_hi, mask, pad_;
};

typedef __bf16 bf16v2_t __attribute__((ext_vector_type(2)));
__device__ __forceinline__ unsigned cvt_pk_bf16(float lo, float hi) { bf16v2_t v; v[0] = (__bf16)lo; v[1] = (__bf16)hi; return __builtin_bit_cast(unsigned, v); }
__device__ __forceinline__ bf16_t f2bf(float f) { return (bf16_t)(cvt_pk_bf16(f, 0.f) & 0xffffu); }
__device__ __forceinline__ float bf2f(bf16_t b) { return __uint_as_float(((unsigned)b) << 16); }
__device__ __forceinline__ float bflo(unsigned u) { return __uint_as_float(u << 16); }
__device__ __forceinline__ float bfhi(unsigned u) { return __uint_as_float(u & 0xffff0000u); }
__device__ __forceinline__ float sigmoidf_(float x) { return __builtin_amdgcn_rcpf(1.f + __expf(-x)); }
__device__ __forceinline__ float siluf_(float x) { return x * __builtin_amdgcn_rcpf(1.f + __expf(-x)); }
__device__ __forceinline__ float wave_sum(float v) {
#pragma unroll
    for (int o = 32; o >= 1; o >>= 1) v += __shfl_xor(v, o);
    return v;
}
__device__ __forceinline__ int opaque_zero() { int z; asm volatile("v_mov_b32 %0, 0" : "=v"(z)); return z; }
__device__ __forceinline__ f32x4 mfma16(bf16x8 a, bf16x8 b, f32x4 c) { return __builtin_amdgcn_mfma_f32_16x16x32_bf16(a, b, c, 0, 0, 0); }
__device__ __forceinline__ bf16x8 ldg8(const bf16_t* p) { return *(const bf16x8*)p; }
__device__ __forceinline__ bf16x8 lds8(LAS unsigned char* l, int off) { return *(const LAS bf16x8*)(l + off); }
__device__ __forceinline__ u32x4 pack8(f32x4 a, f32x4 b) { u32x4 r; r[0] = cvt_pk_bf16(a[0], a[1]); r[1] = cvt_pk_bf16(a[2], a[3]); r[2] = cvt_pk_bf16(b[0], b[1]); r[3] = cvt_pk_bf16(b[2], b[3]); return r; }

__device__ __forceinline__ void grid_sync_all(cg::grid_group& grid) {
    asm volatile("s_waitcnt vmcnt(0)" ::: "memory");
    grid.sync();
    if (threadIdx.x < 64) { __builtin_amdgcn_fence(__ATOMIC_ACQUIRE, "agent"); asm volatile("s_waitcnt vmcnt(0)" ::: "memory"); }
    __syncthreads();
}

__device__ __forceinline__ void fast_sync(unsigned* bar, unsigned epoch) {
    asm volatile("s_waitcnt vmcnt(0)" ::: "memory");
    __syncthreads();
    if (threadIdx.x == 0) {
        __builtin_amdgcn_fence(__ATOMIC_RELEASE, "agent"); asm volatile("s_waitcnt vmcnt(0)" ::: "memory");
        const unsigned g = blockIdx.x & 7u, ng = (gridDim.x - g + 7u) / 8u, ngroups = gridDim.x < 8u ? gridDim.x : 8u;
        const unsigned old = __hip_atomic_fetch_add(bar + g * 64, 1u, __ATOMIC_RELAXED, __HIP_MEMORY_SCOPE_AGENT);
        if (old + 1u == epoch * ng) __hip_atomic_fetch_add(bar + 8 * 64, 1u, __ATOMIC_RELAXED, __HIP_MEMORY_SCOPE_AGENT);
        while (__hip_atomic_load(bar + 8 * 64, __ATOMIC_RELAXED, __HIP_MEMORY_SCOPE_AGENT) < epoch * ngroups) __builtin_amdgcn_s_sleep(1);
        __builtin_amdgcn_fence(__ATOMIC_ACQUIRE, "agent"); asm volatile("s_waitcnt vmcnt(0)" ::: "memory");
    }
    __syncthreads();
}

namespace pg8 {
constexpr int BM = 256, BK = 64, HALF = 128, HTB = HALF * BK * 2, STAGE_BYTES = 8 * HTB;
__device__ __forceinline__ int lds_byte(int r, int c) { const int st = (r >> 4) * 2 + (c >> 5), rr = r & 15, cc = c & 31, ob = rr * 64 + cc * 2; return st * 1024 + (ob ^ (((ob >> 9) & 1) << 5)); }
__device__ __forceinline__ void stage_rc(int b, int& R, int& C) { const int st = b / 1024, sb = b % 1024, swz = sb ^ (((sb >> 9) & 1) << 5); R = (st >> 1) * 16 + swz / 64; C = (st & 1) * 32 + (swz % 64) / 2; }
__device__ __forceinline__ int perm32(int rho) { const int n = rho >> 4, i = rho & 15; return 8 * (i >> 2) + 4 * n + (i & 3); }
struct Unit { int pm, pn, sub; };

template <class Epi, class Sched>
__device__ __forceinline__ void gemm_phase(LAS unsigned char* lds, const int lda, const int ldb, const Sched& S, const Epi& E) {
    const int tid = threadIdx.x, wid = __builtin_amdgcn_readfirstlane(tid >> 6), lane = tid & 63, wr = wid >> 2, wc = wid & 3, fr = lane & 15, fq = lane >> 4;
    unsigned voffA[2], voffB[2];
#pragma unroll
    for (int i = 0; i < 2; ++i) { int R, C; stage_rc(tid * 16 + i * 8192, R, C); const int Rb = (R & ~31) + perm32(R & 31);
        voffA[i] = (unsigned)(R * lda + C) * 2u; voffB[i] = (unsigned)(Rb * ldb + C) * 2u; }
    const size_t kstep = (size_t)(BK * 2);
    const size_t hstepA = (size_t)HALF * lda * 2, hstepB = (size_t)HALF * ldb * 2;
    const unsigned ldsw = (unsigned)wid * 1024u;
    const int aoff = lds_byte(wr * 64 + fr, fq * 8), boff = lds_byte(wc * 32 + fr, fq * 8);
#define PG8_SA(b, h) (((b) * 2 + (h)) * HTB)
#define PG8_SB(b, h) ((4 + (b) * 2 + (h)) * HTB)
#define PG8_STAGE(bufoff, gbase, voff) do { _Pragma("unroll") for (int _i = 0; _i < 2; ++_i) \
        __builtin_amdgcn_global_load_lds((const unsigned*)((const char*)(gbase) + (voff)[_i]), (LAS unsigned*)(lds + (bufoff) + ldsw + _i * 8192), 16, 0, 0); } while (0)
#define PG8_LDA(dst, b, h) do { _Pragma("unroll") for (int m = 0; m < 4; ++m) _Pragma("unroll") for (int k = 0; k < 2; ++k) dst[m][k] = *(const LAS bf16x8*)(lds + PG8_SA(b, h) + aoff + m * 2048 + k * 1024); } while (0)
#define PG8_LDB(dst, b, h) do { _Pragma("unroll") for (int n = 0; n < 2; ++n) _Pragma("unroll") for (int k = 0; k < 2; ++k) dst[n][k] = *(const LAS bf16x8*)(lds + PG8_SB(b, h) + boff + n * 2048 + k * 1024); } while (0)
#define PG8_MMA(ai, bj, At, Bt) do { __builtin_amdgcn_s_setprio(1); _Pragma("unroll") for (int m = 0; m < 4; ++m) _Pragma("unroll") for (int n = 0; n < 2; ++n) _Pragma("unroll") for (int k = 0; k < 2; ++k) \
        acc[ai][bj][m][n] = __builtin_amdgcn_mfma_f32_16x16x32_bf16(Bt[n][k], At[m][k], acc[ai][bj][m][n], 0, 0, 0); __builtin_amdgcn_s_setprio(0); } while (0)
#define PG8_WAIT_V(n) asm volatile("s_waitcnt vmcnt(" #n ")" ::: "memory")
#define PG8_WAIT_L(n) asm volatile("s_waitcnt lgkmcnt(" #n ")" ::: "memory")
#define PG8_BAR __builtin_amdgcn_s_barrier()
#define PG8_SCHED __builtin_amdgcn_sched_barrier(0)
    Unit cur, nxt; int ui = 0;
    if (!S.next(0, cur)) return;
    f32x4 acc[2][2][4][2];
    bf16x8 At[4][2], B0[2][2], B1[2][2];
    const char* cA; const char* cB; int nt;
    S.ptrs(cur, cA, cB, nt);
    PG8_STAGE(PG8_SB(0, 0), cB, voffB); PG8_STAGE(PG8_SA(0, 0), cA, voffA); PG8_STAGE(PG8_SB(0, 1), cB + hstepB, voffB); PG8_STAGE(PG8_SA(0, 1), cA + hstepA, voffA);
    if (wr == 1) PG8_BAR;
    PG8_WAIT_V(4); PG8_BAR;
    PG8_STAGE(PG8_SB(1, 0), cB + kstep, voffB); PG8_STAGE(PG8_SA(1, 0), cA + kstep, voffA); PG8_STAGE(PG8_SB(1, 1), cB + hstepB + kstep, voffB);
    PG8_WAIT_V(6); PG8_BAR;
    PG8_SCHED;
#pragma unroll
    for (int a = 0; a < 2; ++a)
#pragma unroll
        for (int b = 0; b < 2; ++b)
#pragma unroll
            for (int m = 0; m < 4; ++m)
#pragma unroll
                for (int n = 0; n < 2; ++n) acc[a][b][m][n] = (f32x4){0.f, 0.f, 0.f, 0.f};
    for (;;) {
        const bool has_next = S.next(ui + 1, nxt);
        const char* nA = cA; const char* nB = cB; int nnt = nt;
        if (has_next) S.ptrs(nxt, nA, nB, nnt);
        for (int t = 0; t < nt; t += 2) {
            const bool last = (t == nt - 2);
            const char* a1 = cA + (size_t)(t + 1) * kstep;
            const char* a2 = last ? nA : cA + (size_t)(t + 2) * kstep; const char* b2 = last ? nB : cB + (size_t)(t + 2) * kstep;
            const char* a3 = a2 + kstep; const char* b3 = b2 + kstep;
            PG8_LDB(B0, 0, 0); PG8_SCHED; PG8_LDA(At, 0, 0); PG8_STAGE(PG8_SA(1, 1), a1 + hstepA, voffA);
            PG8_WAIT_L(8); PG8_BAR; PG8_WAIT_L(0); PG8_MMA(0, 0, At, B0); PG8_BAR; PG8_SCHED;
            PG8_LDB(B1, 0, 1); PG8_STAGE(PG8_SB(0, 0), b2, voffB);
            PG8_BAR; PG8_WAIT_L(0); PG8_MMA(0, 1, At, B1); PG8_BAR;
            PG8_LDA(At, 0, 1); PG8_STAGE(PG8_SA(0, 0), a2, voffA);
            PG8_BAR; PG8_WAIT_L(0); PG8_MMA(1, 0, At, B0); PG8_BAR; PG8_SCHED;
            PG8_STAGE(PG8_SB(0, 1), b2 + hstepB, voffB);
            PG8_WAIT_V(6); PG8_BAR; PG8_MMA(1, 1, At, B1); PG8_BAR;
            PG8_LDB(B0, 1, 0); PG8_SCHED; PG8_LDA(At, 1, 0); PG8_STAGE(PG8_SA(0, 1), a2 + hstepA, voffA);
            PG8_WAIT_L(8); PG8_BAR; PG8_WAIT_L(0); PG8_MMA(0, 0, At, B0); PG8_BAR; PG8_SCHED;
            PG8_LDB(B1, 1, 1); PG8_STAGE(PG8_SB(1, 0), b3, voffB);
            PG8_BAR; PG8_WAIT_L(0); PG8_MMA(0, 1, At, B1); PG8_BAR;
            PG8_LDA(At, 1, 1); PG8_STAGE(PG8_SA(1, 0), a3, voffA);
            PG8_BAR; PG8_WAIT_L(0); PG8_MMA(1, 0, At, B0); PG8_BAR; PG8_SCHED;
            PG8_STAGE(PG8_SB(1, 1), b3 + hstepB, voffB);
            PG8_WAIT_V(6); PG8_BAR; PG8_MMA(1, 1, At, B1); PG8_BAR;
        }
        __builtin_amdgcn_sched_barrier(0);
        E(acc, cur, wr, wc, fr, fq);
        __builtin_amdgcn_sched_barrier(0);
        if (!has_next) break;
        const float kf = S.keep(cur) ? 1.f : 0.f;
#pragma unroll
        for (int a = 0; a < 2; ++a)
#pragma unroll
            for (int b = 0; b < 2; ++b)
#pragma unroll
                for (int m = 0; m < 4; ++m)
#pragma unroll
                    for (int n = 0; n < 2; ++n) { if constexpr (Sched::HAS_KEEP) acc[a][b][m][n] *= kf; else acc[a][b][m][n] = (f32x4){0.f, 0.f, 0.f, 0.f}; }
        cur = nxt; cA = nA; cB = nB; nt = nnt; ++ui;
    }
    PG8_WAIT_V(0);
    if (wr == 0) PG8_BAR;
    PG8_BAR;
    if constexpr (Epi::HAS_POST) E.post(acc, cur, wr, wc, fr, fq);
#undef PG8_SA
#undef PG8_SB
#undef PG8_STAGE
#undef PG8_LDA
#undef PG8_LDB
#undef PG8_MMA
#undef PG8_WAIT_V
#undef PG8_WAIT_L
#undef PG8_BAR
#undef PG8_SCHED
}
}

struct SchedG1 {
    const char* A; const char* B; int G, c;
    __device__ __forceinline__ bool next(int i, pg8::Unit& u) const {
        const int L = i * G + c; if (L >= 1202) return false;
        if (L < 1170) {
            const int nM = 65, nN = 18, nwg = 1170;
            int wgid = L; { const int q = nwg / 8, r = nwg % 8, xcd = wgid % 8, off = wgid / 8; wgid = (xcd < r ? xcd * (q + 1) : r * (q + 1) + (xcd - r) * q) + off; }
            const int nig = 8 * nN, gid = wgid / nig, fm = gid * 8, gsz = (nM - fm) < 8 ? (nM - fm) : 8;
            u.pm = fm + ((wgid % nig) % gsz); u.pn = (wgid % nig) / gsz;
        } else { const int l2 = L - 1170; u.pm = 65 + (l2 >> 2); u.pn = 18 + (l2 & 3); }
        u.sub = 0; return true;
    }
    __device__ __forceinline__ void ptrs(const pg8::Unit& u, const char*& a, const char*& b, int& nt) const {
        a = A + (size_t)u.pm * 256 * LDA * 2; b = B + (size_t)u.pn * 256 * 1024 * 2; nt = 16;
    }
    static constexpr bool HAS_KEEP = false;
    __device__ __forceinline__ bool keep(const pg8::Unit&) const { return false; }
};
struct EpiG1 {
    static constexpr bool HAS_POST = false;
    bf16_t* proj; bf16_t* memkv; float* out;
    __device__ __forceinline__ void operator()(f32x4 (&acc)[2][2][4][2], const pg8::Unit& u, int wr, int wc, int fr, int fq) const {
        const int row0 = u.pm * 256 + wr * 64 + fr, col0 = u.pn * 256 + wc * 32 + 8 * fq;
        if (u.pn < 18) {
#pragma unroll
            for (int ai = 0; ai < 2; ++ai)
#pragma unroll
                for (int m = 0; m < 4; ++m) { bf16_t* rp = proj + (size_t)(row0 + ai * 128 + m * 16) * PLD + col0;
#pragma unroll
                    for (int bj = 0; bj < 2; ++bj) *(u32x4*)(rp + bj * 128) = pack8(acc[ai][bj][m][0], acc[ai][bj][m][1]); }
        } else {
            const int rr0 = row0 - HM0, cc0 = col0 - 4608;
#pragma unroll
            for (int ai = 0; ai < 2; ++ai)
#pragma unroll
                for (int m = 0; m < 4; ++m) { const int rr = rr0 + ai * 128 + m * 16;
#pragma unroll
                    for (int bj = 0; bj < 2; ++bj) { const int cc = cc0 + bj * 128;
                        *(u32x4*)(memkv + (size_t)rr * 1024 + cc) = pack8(acc[ai][bj][m][0], acc[ai][bj][m][1]);
                        float* op = out + (cc < 512 ? O_MKP + (size_t)rr * 512 + cc : O_MVP + (size_t)rr * 512 + (cc - 512));
                        *(f32x4*)op = acc[ai][bj][m][0]; *(f32x4*)(op + 4) = acc[ai][bj][m][1]; } }
        }
    }
};

struct SchedG3 {
    const char* A; const char* B; int G, c;
    __device__ __forceinline__ bool next(int i, pg8::Unit& u) const {
        const int r = i / 6, T = r * G + c; if (T >= 256) return false;
        const int xcd = T & 7, idx = T >> 3; u.pm = xcd * 8 + (idx >> 2); u.pn = idx & 3; u.sub = i - r * 6; return true;
    }
    __device__ __forceinline__ void ptrs(const pg8::Unit& u, const char*& a, const char*& b, int& nt) const {
        const int br = u.sub >> 1;
        const char* a0 = A + (size_t)u.pm * 256 * LDA * 2; const char* b0 = B + ((size_t)br * 1024 + (size_t)u.pn * 256) * 1536 * 2;
        if (u.sub & 1) { a = a0 + (A_YA + br * 512) * 2; b = b0 + 1024 * 2; nt = 8; } else { a = a0; b = b0; nt = 16; }
    }
    static constexpr bool HAS_KEEP = false;
    __device__ __forceinline__ bool keep(const pg8::Unit&) const { return false; }
};
__device__ __forceinline__ void unpack8(const u32x4 g, f32x4& g0, f32x4& g1) { g0 = (f32x4){bflo(g[0]), bfhi(g[0]), bflo(g[1]), bfhi(g[1])}; g1 = (f32x4){bflo(g[2]), bfhi(g[2]), bflo(g[3]), bfhi(g[3])}; }
struct EpiG3 {
    static constexpr bool HAS_POST = false;
    unsigned char* scr; bf16_t* merged; const float* b_gate;
    __device__ __forceinline__ void operator()(f32x4 (&acc)[2][2][4][2], const pg8::Unit& u, int wr, int wc, int fr, int fq) const {
        const int tid = threadIdx.x + opaque_zero();
        const int row0 = u.pm * 256 + wr * 64 + fr, col0 = u.pn * 256 + wc * 32 + 8 * fq + opaque_zero();
        const bool gate = (u.sub & 1) == 0; const int br = u.sub >> 1;
        GAS u32x4* s0 = (GAS u32x4*)scr + tid * 4;
        const int boff = 8192;
        const float* bp = b_gate + br * 1024 + col0;
        bf16_t* mp = merged + (size_t)row0 * 1024 + col0;
#pragma unroll
        for (int ai = 0; ai < 2; ++ai)
#pragma unroll
            for (int bj = 0; bj < 2; ++bj) {
                if (gate) {
                    const f32x4 b0 = *(const f32x4*)(bp + bj * 128), b1 = *(const f32x4*)(bp + bj * 128 + 4);
#pragma unroll
                    for (int m = 0; m < 4; ++m) { f32x4 g0, g1;
#pragma unroll
                        for (int e = 0; e < 4; ++e) { g0[e] = sigmoidf_(acc[ai][bj][m][0][e] + b0[e]); g1[e] = sigmoidf_(acc[ai][bj][m][1][e] + b1[e]); }
                        s0[boff + m] = pack8(g0, g1); }
                } else {
                    u32x4 gn[4], gm[4];
#pragma unroll
                    for (int m = 0; m < 4; ++m) { gn[m] = s0[boff + m]; gm[m] = gn[m]; }
                    if (br > 0) {
#pragma unroll
                        for (int m = 0; m < 4; ++m) gm[m] = s0[m];
                    }
#pragma unroll
                    for (int m = 0; m < 4; ++m) { f32x4 n0, n1, p0, p1; unpack8(gn[m], n0, n1); unpack8(gm[m], p0, p1);
                        f32x4 r0 = acc[ai][bj][m][0] * n0, r1 = acc[ai][bj][m][1] * n1;
                        if (br > 0) { r0 += p0; r1 += p1; }
                        const u32x4 pk = pack8(r0, r1);
                        if (br < 2) s0[m] = pk; else *(u32x4*)(mp + (size_t)(ai * 128 + m * 16) * 1024 + bj * 128) = pk; }
                }
                s0 += 2048; asm volatile("" : "+v"(s0)); __builtin_amdgcn_sched_barrier(0); }
    }
};

struct SchedG4 {
    const char* A; const char* B; int G, c;
    __device__ __forceinline__ bool next(int i, pg8::Unit& u) const {
        const int T = i * G + c; if (T >= 256) return false;
        const int xcd = T & 7, idx = T >> 3; u.pm = xcd * 8 + (idx >> 2); u.pn = idx & 3; u.sub = 0; return true;
    }
    __device__ __forceinline__ void ptrs(const pg8::Unit& u, const char*& a, const char*& b, int& nt) const {
        a = A + (size_t)u.pm * 256 * 1024 * 2; b = B + (size_t)u.pn * 256 * 1024 * 2; nt = 16;
    }
    static constexpr bool HAS_KEEP = false;
    __device__ __forceinline__ bool keep(const pg8::Unit&) const { return false; }
};
struct EpiG4 {
    static constexpr bool HAS_POST = true;
    const float* x; float* out; float* rowsq; const float* fg; unsigned* bar; unsigned epoch;
    __device__ __forceinline__ void operator()(f32x4 (&acc)[2][2][4][2], const pg8::Unit& u, int wr, int wc, int fr, int fq) const {
        const int row0 = u.pm * 256 + wr * 64 + fr + opaque_zero(), col0 = u.pn * 256 + wc * 32 + 8 * fq;
        const GAS float* xp = (const GAS float*)x + (size_t)row0 * 1024 + col0; float* rq = rowsq + row0;
#pragma unroll
        for (int ai = 0; ai < 2; ++ai) {
#pragma unroll
            for (int m = 0; m < 4; ++m) { float ss = 0.f;
#pragma unroll
                for (int bj = 0; bj < 2; ++bj) {
                    acc[ai][bj][m][0] += *(const GAS f32x4*)(xp + bj * 128); acc[ai][bj][m][1] += *(const GAS f32x4*)(xp + bj * 128 + 4);
#pragma unroll
                    for (int e = 0; e < 4; ++e) ss += acc[ai][bj][m][0][e] * acc[ai][bj][m][0][e] + acc[ai][bj][m][1][e] * acc[ai][bj][m][1][e]; }
                ss += __shfl_xor(ss, 16); ss += __shfl_xor(ss, 32);
                if (fq == 0) unsafeAtomicAdd(rq, ss);
                xp += 16 * 1024; rq += 16;
                if (m & 1) asm volatile("" : "+v"(xp), "+v"(rq)); }
            xp += 64 * 1024; rq += 64; }
    }
    __device__ __forceinline__ void post(f32x4 (&acc)[2][2][4][2], const pg8::Unit& u, int wr, int wc, int fr, int fq) const {
        const int col0 = u.pn * 256 + wc * 32 + 8 * fq;
        f32x4 g[2][2];
#pragma unroll
        for (int bj = 0; bj < 2; ++bj) { g[bj][0] = *(const f32x4*)(fg + col0 + bj * 128); g[bj][1] = *(const f32x4*)(fg + col0 + bj * 128 + 4); }
        fast_sync(bar, epoch);
        const int row0 = u.pm * 256 + wr * 64 + fr + opaque_zero();
        GAS float* op = (GAS float*)out + (size_t)row0 * 1024 + col0; const float* rq = rowsq + row0;
        float rsv[2][4];
#pragma unroll
        for (int ai = 0; ai < 2; ++ai)
#pragma unroll
            for (int m = 0; m < 4; ++m) rsv[ai][m] = __hip_atomic_load(rq + ai * 128 + m * 16, __ATOMIC_RELAXED, __HIP_MEMORY_SCOPE_AGENT);
#pragma unroll
        for (int ai = 0; ai < 2; ++ai) {
#pragma unroll
            for (int m = 0; m < 4; ++m) {
                const float rs = rsqrtf(rsv[ai][m] * (1.f / 1024.f) + EPS);
#pragma unroll
                for (int bj = 0; bj < 2; ++bj) { *(GAS f32x4*)(op + bj * 128) = acc[ai][bj][m][0] * rs * g[bj][0]; *(GAS f32x4*)(op + bj * 128 + 4) = acc[ai][bj][m][1] * rs * g[bj][1]; }
                op += 16 * 1024;
                if (m & 1) asm volatile("" : "+v"(op)); }
            op += 64 * 1024; }
    }
};

__device__ __forceinline__ void transpose_tile(const Params& p, LAS unsigned char* lds, int t) {
    const float* src; int sld, col0, ntn; bf16_t* dst; int dld;
    bf16_t* W1T = (bf16_t*)(p.ws + OFF_W1T); bf16_t* WG3 = (bf16_t*)(p.ws + OFF_WG3); bf16_t* WOUT = (bf16_t*)(p.ws + OFF_WOUT);
    if (t < 384) { src = p.w_in; sld = 7688; col0 = 0; ntn = 24; dst = W1T; dld = 1024; }
    else if (t < 1152) { t -= 384; src = p.w_in; sld = 7688; col0 = 1544; ntn = 48; dst = W1T + (size_t)1536 * 1024; dld = 1024; }
    else if (t < 1408) { t -= 1152; src = p.w_mem_kv; sld = 1024; col0 = 0; ntn = 16; dst = W1T + (size_t)4608 * 1024; dld = 1024; }
    else if (t < 2176) { t -= 1408; const int i = t >> 8; t &= 255; src = p.w_in; sld = 7688; col0 = 4616 + i * 1024; ntn = 16; dst = WG3 + (size_t)i * 1024 * 1536; dld = 1536; }
    else if (t < 2304) { t -= 2176; src = p.w_br_a; sld = 1024; col0 = 0; ntn = 16; dst = WG3 + 1024; dld = 1536; }
    else if (t < 2432) { t -= 2304; src = p.w_br_b; sld = 1024; col0 = 0; ntn = 16; dst = WG3 + (size_t)1 * 1024 * 1536 + 1024; dld = 1536; }
    else if (t < 2560) { t -= 2432; src = p.w_br_c; sld = 1024; col0 = 0; ntn = 16; dst = WG3 + (size_t)2 * 1024 * 1536 + 1024; dld = 1536; }
    else { t -= 2560; src = p.w_out; sld = 1024; col0 = 0; ntn = 16; dst = WOUT; dld = 1024; }
    const int k0 = (t / ntn) * 64, n0 = (t % ntn) * 64, tid = threadIdx.x;
    LAS float* tile = (LAS float*)lds;
    __syncthreads();
#pragma unroll
    for (int ps = 0; ps < 2; ++ps) { const int r = (tid >> 4) + ps * 32, c4 = (tid & 15) * 4;
        const f32x4 v = *(const f32x4*)(src + (size_t)(k0 + r) * sld + col0 + n0 + c4);
        tile[r * 65 + c4] = v[0]; tile[r * 65 + c4 + 1] = v[1]; tile[r * 65 + c4 + 2] = v[2]; tile[r * 65 + c4 + 3] = v[3]; }
    __syncthreads();
    const int n = tid >> 3, kc = (tid & 7) * 8;
    u32x4 o;
#pragma unroll
    for (int j = 0; j < 4; ++j) o[j] = cvt_pk_bf16(tile[(kc + 2 * j) * 65 + n], tile[(kc + 2 * j + 1) * 65 + n]);
    *(u32x4*)(dst + (size_t)(n0 + n) * dld + k0 + kc) = o;
}

static __device__ __forceinline__ void phase_prep(const Params& p, LAS unsigned char* lds) {
    const int tid = threadIdx.x, wg = blockIdx.x, G = gridDim.x, lane = tid & 63, wave = tid >> 6;
    float* rowsq = (float*)(p.ws + OFF_ROWSQ); unsigned* cnt = (unsigned*)(p.ws + OFF_CNT);
    for (int i = wg * 512 + tid; i < MROWS + 64; i += G * 512) { if (i < MROWS) rowsq[i] = 0.f; else cnt[i - MROWS] = 0u; }
    if (wg == G - 1) { unsigned* bw = (unsigned*)(p.ws + OFF_BAR); for (int i = tid; i < 9 * 64; i += 512) bw[i] = 0u; }
    for (int t = wg; t < 2816; t += G) transpose_tile(p, lds, t);
    __syncthreads();
    LAS float* wb = (LAS float*)lds;
    for (int idx = tid; idx < 8192; idx += 512) { const int k = idx >> 3, j = idx & 7; wb[j * 1024 + k] = p.w_in[(size_t)k * 7688 + 1536 + j]; }
    __syncthreads();
    bf16_t* ACT = (bf16_t*)(p.ws + OFF_ACT); float* betag = (float*)(p.ws + OFF_BETAG);
    for (int row = wg * 8 + wave; row < 18560; row += G * 8) {
        const float* src; const float* gn; size_t drow;
        if (row < NP) { src = p.x_prompt + (size_t)row * 1024; gn = p.norm_g; drow = row; }
        else if (row < NP + NS) { src = p.x_sample + (size_t)(row - NP) * 1024; gn = p.norm_g; drow = row; }
        else { src = p.mem_prompt + (size_t)(row - NP - NS) * 1024; gn = p.mem_norm_g; drow = HM0 + (row - NP - NS); }
        f32x4 v[4]; float ss = 0.f;
#pragma unroll
        for (int q = 0; q < 4; ++q) { v[q] = *(const f32x4*)(src + q * 256 + lane * 4); ss += v[q][0] * v[q][0] + v[q][1] * v[q][1] + v[q][2] * v[q][2] + v[q][3] * v[q][3]; }
        ss = wave_sum(ss);
        const float rstd = rsqrtf(ss * (1.f / 1024.f) + EPS);
#pragma unroll
        for (int q = 0; q < 4; ++q) { const f32x4 g = *(const f32x4*)(gn + q * 256 + lane * 4); v[q] = v[q] * rstd * g;
            u32x2 o; o[0] = cvt_pk_bf16(v[q][0], v[q][1]); o[1] = cvt_pk_bf16(v[q][2], v[q][3]);
            *(u32x2*)(ACT + drow * LDA + q * 256 + lane * 4) = o; }
        if (row < NP + NS) {
            float d[8];
#pragma unroll
            for (int j = 0; j < 8; ++j) { float a = 0.f;
#pragma unroll
                for (int q = 0; q < 4; ++q) { const f32x4 w = *(const LAS f32x4*)(wb + j * 1024 + q * 256 + lane * 4); a += v[q][0] * w[0] + v[q][1] * w[1] + v[q][2] * w[2] + v[q][3] * w[3]; }
                d[j] = wave_sum(a); }
            float dl = d[0];
#pragma unroll
            for (int j = 1; j < 8; ++j) dl = (lane == j) ? d[j] : dl;
            if (lane < 4) betag[(size_t)row * 8 + lane] = sigmoidf_(dl);
            else if (lane < 8) { const int h = lane - 4; const float xx = dl + p.dt_bias[h]; const float sp = xx > 20.f ? xx : log1pf(expf(xx));
                betag[(size_t)row * 8 + lane] = -expf(p.a_log[h]) * sp; }
        }
    }
}

static __device__ __forceinline__ void delta_chunk_item(const Params& p, LAS unsigned char* lds, int ci) {
    const int tid = threadIdx.x, lane = tid & 63, wave = tid >> 6, l16 = lane & 15, quad = lane >> 4;
    const int bh = ci >> 5, n = ci & 31, b = bh >> 2, h = bh & 3;
    const bf16_t* PROJ = (const bf16_t*)(p.ws + OFF_PROJ); const float* betag = (const float*)(p.ws + OFF_BETAG);
    bf16_t* U = (bf16_t*)((unsigned char*)p.out + DO_U) + (size_t)ci * 8192; bf16_t* W = (bf16_t*)((unsigned char*)p.out + DO_W) + (size_t)ci * 8192;
    bf16_t* QD = (bf16_t*)((unsigned char*)p.out + DO_QD) + (size_t)ci * 8192; bf16_t* KDT = (bf16_t*)((unsigned char*)p.out + DO_KDT) + (size_t)ci * 8192;
    bf16_t* ATT = (bf16_t*)(p.ws + OFF_ATTN) + (size_t)ci * 4096; float* GL = (float*)(p.ws + OFF_GL);
    LAS bf16_t* Kb = (LAS bf16_t*)lds; LAS bf16_t* Qb = (LAS bf16_t*)(lds + 17408);
    LAS float* RHS = (LAS float*)(lds + 34816);
    LAS float* Lm = (LAS float*)(lds + 100352);
    LAS float* gcs = (LAS float*)(lds + 116736); LAS float* bts = gcs + 64;
    const int trow0 = b * 2048 + n * 64;
    __syncthreads();
    if (wave == 0) {
        float g = betag[(size_t)(trow0 + lane) * 8 + 4 + h];
#pragma unroll
        for (int o = 1; o < 64; o <<= 1) { const float t = __shfl_up(g, o); if (lane >= o) g += t; }
        gcs[lane] = g; bts[lane] = betag[(size_t)(trow0 + lane) * 8 + h];
        if (lane == 63) GL[ci] = __expf(g);
    }
    __syncthreads();
    {
        const int t = tid >> 3, cc = (tid & 7) * 16;
        const float gct = gcs[t], bet = bts[t], eg = __expf(gct);
#pragma unroll 1
        for (int sec = 0; sec < 3; ++sec) {
            const int col = sec * 512 + h * 128 + cc;
            float y[16];
#pragma unroll
            for (int e = 0; e < 16; ++e) y[e] = 0.f;
#pragma unroll
            for (int j = 0; j < 4; ++j) { const int tl = n * 64 + t - 3 + j;
                if (tl >= 0) { const bf16_t* rp = PROJ + (size_t)(b * 2048 + tl) * PLD + col; const u32x4 x0 = *(const u32x4*)rp, x1 = *(const u32x4*)(rp + 8);
                    const float* wp = p.conv_w + j * 1536 + col;
#pragma unroll
                    for (int e = 0; e < 4; ++e) { const f32x4 w = *(const f32x4*)(wp + e * 4); const unsigned ua = (e < 2 ? x0[2 * e] : x1[2 * e - 4]), ub = (e < 2 ? x0[2 * e + 1] : x1[2 * e - 3]);
                        y[e * 4] += bflo(ua) * w[0]; y[e * 4 + 1] += bfhi(ua) * w[1]; y[e * 4 + 2] += bflo(ub) * w[2]; y[e * 4 + 3] += bfhi(ub) * w[3]; } } }
            float ss = 0.f;
#pragma unroll
            for (int e = 0; e < 16; ++e) { y[e] = siluf_(y[e]); ss += y[e] * y[e]; }
            if (sec < 2) { ss += __shfl_xor(ss, 1); ss += __shfl_xor(ss, 2); ss += __shfl_xor(ss, 4);
                const float sc = rsqrtf(ss + EPS) * (sec == 0 ? 0.08838834764831845f : 1.f);
#pragma unroll
                for (int e = 0; e < 16; ++e) y[e] *= sc; }
            if (sec == 0) {
                u32x4 o0, o1, d0, d1;
#pragma unroll
                for (int e = 0; e < 4; ++e) { o0[e] = cvt_pk_bf16(y[2 * e], y[2 * e + 1]); o1[e] = cvt_pk_bf16(y[8 + 2 * e], y[9 + 2 * e]);
                    d0[e] = cvt_pk_bf16(y[2 * e] * eg, y[2 * e + 1] * eg); d1[e] = cvt_pk_bf16(y[8 + 2 * e] * eg, y[9 + 2 * e] * eg); }
                *(LAS u32x4*)(Qb + t * 136 + cc) = o0; *(LAS u32x4*)(Qb + t * 136 + cc + 8) = o1;
                *(u32x4*)(QD + t * 128 + cc) = d0; *(u32x4*)(QD + t * 128 + cc + 8) = d1;
            } else if (sec == 1) {
                u32x4 o0, o1;
#pragma unroll
                for (int e = 0; e < 4; ++e) { o0[e] = cvt_pk_bf16(y[2 * e], y[2 * e + 1]); o1[e] = cvt_pk_bf16(y[8 + 2 * e], y[9 + 2 * e]); }
                *(LAS u32x4*)(Kb + t * 136 + cc) = o0; *(LAS u32x4*)(Kb + t * 136 + cc + 8) = o1;
                const float s2 = bet * eg;
#pragma unroll
                for (int e = 0; e < 4; ++e) *(LAS f32x4*)(RHS + t * 256 + 128 + cc + e * 4) = (f32x4){y[e * 4] * s2, y[e * 4 + 1] * s2, y[e * 4 + 2] * s2, y[e * 4 + 3] * s2};
            } else {
#pragma unroll
                for (int e = 0; e < 4; ++e) *(LAS f32x4*)(RHS + t * 256 + cc + e * 4) = (f32x4){y[e * 4] * bet, y[e * 4 + 1] * bet, y[e * 4 + 2] * bet, y[e * 4 + 3] * bet};
            }
        }
    }
    __syncthreads();
    {
        const int sel = wave >> 2, it = wave & 3;
        LAS unsigned char* Xb = lds + (sel ? 17408 : 0);
        bf16x8 af[4];
#pragma unroll
        for (int ks = 0; ks < 4; ++ks) af[ks] = lds8(Xb, ((it * 16 + l16) * 136 + ks * 32 + quad * 8) * 2);
#pragma unroll
        for (int jt = 0; jt < 4; ++jt) {
            f32x4 a = {0.f, 0.f, 0.f, 0.f};
            if (jt <= it) {
                if (sel == 0) {
#pragma unroll
                    for (int ks = 0; ks < 4; ++ks) a = mfma16(af[ks], lds8(lds, ((jt * 16 + l16) * 136 + ks * 32 + quad * 8) * 2), a);
                } else {
#pragma unroll
                    for (int ks = 0; ks < 4; ++ks) a = mfma16(lds8(lds, ((jt * 16 + l16) * 136 + ks * 32 + quad * 8) * 2), af[ks], a);
                }
            }
            if (sel == 0) {
                const int j = jt * 16 + l16; const float gj = gcs[j];
#pragma unroll
                for (int r = 0; r < 4; ++r) { const int i = it * 16 + quad * 4 + r;
                    const float dec = (i >= j) ? __expf(gcs[i] - gj) : 0.f;
                    Lm[i * 64 + j] = (i > j) ? bts[i] * a[r] * dec : 0.f; }
            } else {
                const int i = it * 16 + l16; const float gi = gcs[i]; float o4[4];
#pragma unroll
                for (int r = 0; r < 4; ++r) { const int j = jt * 16 + quad * 4 + r; o4[r] = (i >= j) ? a[r] * __expf(gi - gcs[j]) : 0.f; }
                u32x2 w; w[0] = cvt_pk_bf16(o4[0], o4[1]); w[1] = cvt_pk_bf16(o4[2], o4[3]);
                *(u32x2*)(ATT + i * 64 + jt * 16 + quad * 4) = w;
            }
        }
    }
    {
        const int d = tid >> 2, tq = (tid & 3) * 16; const float gl = gcs[63];
        u32x4 o0, o1;
#pragma unroll
        for (int e = 0; e < 8; ++e) { const int t0 = tq + 2 * e;
            const unsigned v = cvt_pk_bf16(bf2f(Kb[t0 * 136 + d]) * __expf(gl - gcs[t0]), bf2f(Kb[(t0 + 1) * 136 + d]) * __expf(gl - gcs[t0 + 1]));
            if (e < 4) o0[e] = v; else o1[e - 4] = v; }
        *(u32x4*)(KDT + d * 64 + tq) = o0; *(u32x4*)(KDT + d * 64 + tq + 8) = o1;
    }
    __syncthreads();
    if (wave < 4 && (p.mask & 32)) {
        const int col = tid;
        const LAS float* Lz = Lm + opaque_zero();
        float x[64];
#pragma unroll
        for (int i = 0; i < 64; ++i) {
            f32x4 lr[16];
#pragma unroll
            for (int j4 = 0; j4 < (i + 3) / 4; ++j4) lr[j4] = *(const LAS f32x4*)(Lz + i * 64 + j4 * 4);
            const float rcur = RHS[i * 256 + col];
            __builtin_amdgcn_sched_barrier(0);
            float s4[4] = {0.f, 0.f, 0.f, 0.f};
#pragma unroll
            for (int j4 = 0; j4 < (i + 3) / 4; ++j4) {
#pragma unroll
                for (int e = 0; e < 4; ++e) if (j4 * 4 + e < i) s4[e] += lr[j4][e] * x[j4 * 4 + e]; }
            x[i] = rcur - ((s4[0] + s4[1]) + (s4[2] + s4[3]));
            __builtin_amdgcn_sched_barrier(0);
        }
#pragma unroll
        for (int i = 0; i < 64; ++i) RHS[i * 256 + col] = x[i];
    }
    __syncthreads();
#pragma unroll
    for (int q = 0; q < 4; ++q) { const int idx = tid + 512 * q, which = idx >> 10, rem = idx & 1023, i = rem >> 4, c8 = (rem & 15) * 8;
        const f32x4 a = *(const LAS f32x4*)(RHS + i * 256 + which * 128 + c8), b = *(const LAS f32x4*)(RHS + i * 256 + which * 128 + c8 + 4);
        *(u32x4*)((which ? W : U) + i * 128 + c8) = pack8(a, b); }
}

static __device__ __forceinline__ void phase_delta_pre(const Params& p, LAS unsigned char* lds) {
    const int wg = blockIdx.x, G = gridDim.x, tid = threadIdx.x;
    const bf16_t* PROJ = (const bf16_t*)(p.ws + OFF_PROJ);
    for (int i = wg * 512 + tid; i < 8 * 3 * 1536; i += G * 512) { const int b = i / 4608, r = i % 4608, j = r / 1536, ch = r % 1536;
        p.out[O_SCP + i] = bf2f(PROJ[(size_t)(b * 2048 + 2045 + j) * PLD + ch]); }
    for (int ci = wg; ci < 1024; ci += G) delta_chunk_item(p, lds, ci);
}

struct ScanFr { bf16x8 w[4], qd[4], at[2], kd[2][2]; u32x2 u[2]; };
__device__ __forceinline__ void scan_load(ScanFr& f, const Params& p, int ci, int vb, int vp, int tt, int dtb, int l16, int quad) {
    const bf16_t* U = (const bf16_t*)((const unsigned char*)p.out + DO_U) + (size_t)ci * 8192; const bf16_t* W = (const bf16_t*)((const unsigned char*)p.out + DO_W) + (size_t)ci * 8192;
    const bf16_t* QD = (const bf16_t*)((const unsigned char*)p.out + DO_QD) + (size_t)ci * 8192; const bf16_t* KDT = (const bf16_t*)((const unsigned char*)p.out + DO_KDT) + (size_t)ci * 8192;
    const bf16_t* ATT = (const bf16_t*)(p.ws + OFF_ATTN) + (size_t)ci * 4096;
#pragma unroll
    for (int ks = 0; ks < 4; ++ks) { f.w[ks] = ldg8(W + (tt * 16 + l16) * 128 + ks * 32 + quad * 8); f.qd[ks] = ldg8(QD + (tt * 16 + l16) * 128 + ks * 32 + quad * 8); }
#pragma unroll
    for (int ks = 0; ks < 2; ++ks) { f.at[ks] = ldg8(ATT + (tt * 16 + l16) * 64 + ks * 32 + quad * 8);
#pragma unroll
        for (int d = 0; d < 2; ++d) f.kd[d][ks] = ldg8(KDT + ((dtb + d) * 16 + l16) * 64 + ks * 32 + quad * 8); }
#pragma unroll
    for (int j = 0; j < 2; ++j) f.u[j] = *(const u32x2*)(U + (tt * 16 + l16) * 128 + vb * 64 + (vp * 2 + j) * 16 + quad * 4);
}
static __device__ __forceinline__ void scan_unit(const Params& p, LAS unsigned char* lds, int unit) {
    const int tid = threadIdx.x, lane = tid & 63, wave = tid >> 6, l16 = lane & 15, quad = lane >> 4;
    const int bh = unit >> 1, vb = unit & 1, b = bh >> 2, h = bh & 3;
    const int vp = wave & 1, tt = wave >> 1, dtb = (wave >> 1) * 2;
    LAS bf16_t* STs = (LAS bf16_t*)lds;
    LAS bf16_t* vnT = (LAS bf16_t*)(lds + 17408);
    bf16_t* PROJ = (bf16_t*)(p.ws + OFF_PROJ); const float* GL = (const float*)(p.ws + OFF_GL);
    __syncthreads();
    for (int i = tid; i < 64 * 136 / 2; i += 512) ((LAS unsigned*)STs)[i] = 0u;
    f32x4 accS[2][2];
#pragma unroll
    for (int j = 0; j < 2; ++j)
#pragma unroll
        for (int d = 0; d < 2; ++d) accS[j][d] = (f32x4){0.f, 0.f, 0.f, 0.f};
    const int ci0 = bh * 32;
    const float glv = GL[ci0 + (lane & 31)];
    ScanFr cur, nxt;
    scan_load(cur, p, ci0, vb, vp, tt, dtb, l16, quad);
    nxt = cur;
    __syncthreads();
    for (int n = 0; n < 32; ++n) {
        if (n + 1 < 32) scan_load(nxt, p, ci0 + n + 1, vb, vp, tt, dtb, l16, quad);
        const float gl = __shfl(glv, n);
        f32x4 aW[2], aQ[2];
#pragma unroll
        for (int j = 0; j < 2; ++j) { aW[j] = (f32x4){0.f, 0.f, 0.f, 0.f}; aQ[j] = (f32x4){0.f, 0.f, 0.f, 0.f};
#pragma unroll
            for (int ks = 0; ks < 4; ++ks) { const bf16x8 a = lds8(lds, (((vp * 2 + j) * 16 + l16) * 136 + ks * 32 + quad * 8) * 2); aW[j] = mfma16(a, cur.w[ks], aW[j]); aQ[j] = mfma16(a, cur.qd[ks], aQ[j]); } }
#pragma unroll
        for (int j = 0; j < 2; ++j) { const int vr = (vp * 2 + j) * 16 + quad * 4, tc = tt * 16 + l16;
            vnT[(vr + 0) * 72 + tc] = f2bf(bflo(cur.u[j][0]) - aW[j][0]); vnT[(vr + 1) * 72 + tc] = f2bf(bfhi(cur.u[j][0]) - aW[j][1]);
            vnT[(vr + 2) * 72 + tc] = f2bf(bflo(cur.u[j][1]) - aW[j][2]); vnT[(vr + 3) * 72 + tc] = f2bf(bfhi(cur.u[j][1]) - aW[j][3]); }
        asm volatile("s_waitcnt lgkmcnt(0)" ::: "memory"); __builtin_amdgcn_s_barrier(); asm volatile("" ::: "memory");
#pragma unroll
        for (int j = 0; j < 2; ++j) { accS[j][0] *= gl; accS[j][1] *= gl;
#pragma unroll
            for (int ks = 0; ks < 2; ++ks) { const bf16x8 a = lds8(lds, 17408 + (((vp * 2 + j) * 16 + l16) * 72 + ks * 32 + quad * 8) * 2);
                aQ[j] = mfma16(a, cur.at[ks], aQ[j]); accS[j][0] = mfma16(a, cur.kd[0][ks], accS[j][0]); accS[j][1] = mfma16(a, cur.kd[1][ks], accS[j][1]); }
            u32x2 o; o[0] = cvt_pk_bf16(aQ[j][0], aQ[j][1]); o[1] = cvt_pk_bf16(aQ[j][2], aQ[j][3]);
            *(u32x2*)(PROJ + (size_t)(b * 2048 + n * 64 + tt * 16 + l16) * PLD + C_AQ + h * 128 + vb * 64 + (vp * 2 + j) * 16 + quad * 4) = o;
#pragma unroll
            for (int d = 0; d < 2; ++d)
#pragma unroll
                for (int r = 0; r < 4; ++r) STs[((vp * 2 + j) * 16 + quad * 4 + r) * 136 + (dtb + d) * 16 + l16] = f2bf(accS[j][d][r]); }
        asm volatile("s_waitcnt lgkmcnt(0)" ::: "memory"); __builtin_amdgcn_s_barrier(); asm volatile("" ::: "memory");
        cur = nxt;
    }
    float* sdp = p.out + O_SDP + (size_t)bh * 16384;
#pragma unroll
    for (int j = 0; j < 2; ++j)
#pragma unroll
        for (int d = 0; d < 2; ++d) *(f32x4*)(sdp + (size_t)((dtb + d) * 16 + l16) * 128 + vb * 64 + (vp * 2 + j) * 16 + quad * 4) = accS[j][d];
}

static __device__ __forceinline__ void sample_delta_item(const Params& p, LAS unsigned char* lds, int it) {
    const int tid = threadIdx.x, b = it >> 2, h = it & 3;
    const bf16_t* PROJ = (const bf16_t*)(p.ws + OFF_PROJ); const float* betag = (const float*)(p.ws + OFF_BETAG); bf16_t* ACT = (bf16_t*)(p.ws + OFF_ACT);
    LAS float* qkv = (LAS float*)lds;
    LAS float* red = (LAS float*)(lds + 2048);
    LAS float* fin = (LAS float*)(lds + 2048 + 16384);
    LAS float* sc = (LAS float*)(lds + 2048 + 16384 + 1024);
    const size_t prow = (size_t)(NP + b) * PLD;
    __syncthreads();
    float yv = 0.f;
    if (tid < 384) { const int sec = tid >> 7, c = tid & 127, ch = sec * 512 + h * 128 + c;
        const float b0 = p.state_conv[(size_t)(b * 3 + 0) * 1536 + ch], b1 = p.state_conv[(size_t)(b * 3 + 1) * 1536 + ch], b2 = p.state_conv[(size_t)(b * 3 + 2) * 1536 + ch];
        const float xn = bf2f(PROJ[prow + ch]);
        float y = b0 * p.conv_w[ch] + b1 * p.conv_w[1536 + ch] + b2 * p.conv_w[3072 + ch] + xn * p.conv_w[4608 + ch];
        yv = siluf_(y);
        float* scs = p.out + O_SCS + (size_t)b * 4608;
        scs[ch] = b1; scs[1536 + ch] = b2; scs[3072 + ch] = xn;
    }
    {
        float ss = wave_sum(yv * yv);
        if ((tid & 63) == 0) sc[8 + (tid >> 6)] = ss;
    }
    __syncthreads();
    if (tid < 384) { const int sec = tid >> 7, c = tid & 127;
        float v = yv;
        if (sec == 0) v *= rsqrtf(sc[8] + sc[9] + EPS) * 0.08838834764831845f;
        else if (sec == 1) v *= rsqrtf(sc[10] + sc[11] + EPS);
        qkv[sec * 128 + c] = v; }
    __syncthreads();
    const int dvq = tid & 31, dkg = tid >> 5;
    const float* S0 = p.state_delta + (size_t)it * 16384;
    f32x4 s[8]; f32x4 pk = {0.f, 0.f, 0.f, 0.f}, pq = {0.f, 0.f, 0.f, 0.f};
#pragma unroll
    for (int j = 0; j < 8; ++j) { const int dk = dkg * 8 + j; s[j] = *(const f32x4*)(S0 + (size_t)dk * 128 + dvq * 4); pk += s[j] * qkv[128 + dk]; pq += s[j] * qkv[dk]; }
    *(LAS f32x4*)(red + dkg * 256 + dvq * 4) = pk; *(LAS f32x4*)(red + dkg * 256 + 128 + dvq * 4) = pq;
    {
        float qk = (tid < 128) ? qkv[tid] * qkv[128 + tid] : 0.f; qk = wave_sum(qk);
        if (tid < 128 && (tid & 63) == 0) sc[tid >> 6] = qk;
    }
    __syncthreads();
    const float beta = betag[(size_t)(NP + b) * 8 + h], a = __expf(betag[(size_t)(NP + b) * 8 + 4 + h]);
    if (tid < 128) { float sk = 0.f, sq = 0.f;
#pragma unroll
        for (int g = 0; g < 16; ++g) { sk += red[g * 256 + tid]; sq += red[g * 256 + 128 + tid]; }
        const float vn = beta * (qkv[256 + tid] - a * sk); const float o = a * sq + (sc[0] + sc[1]) * vn;
        fin[tid] = vn; fin[128 + tid] = o;
        const float oo = wave_sum(o * o); if ((tid & 63) == 0) sc[4 + (tid >> 6)] = oo; }
    __syncthreads();
    const f32x4 vn4 = *(const LAS f32x4*)(fin + dvq * 4);
    float* Sn = p.out + O_SDS + (size_t)it * 16384;
#pragma unroll
    for (int j = 0; j < 8; ++j) { const int dk = dkg * 8 + j; *(f32x4*)(Sn + (size_t)dk * 128 + dvq * 4) = s[j] * a + vn4 * qkv[128 + dk]; }
    if (tid < 128) { const float rstd = rsqrtf((sc[4] + sc[5]) * (1.f / 128.f) + EPS);
        const float gt = bf2f(PROJ[prow + C_AGATE + h * 128 + tid]);
        ACT[(size_t)(NP + b) * LDA + A_YA + h * 128 + tid] = f2bf(fin[128 + tid] * rstd * p.a_norm_g[tid] * siluf_(gt)); }
}

static __device__ __forceinline__ void sample_xattn_item(const Params& p, LAS unsigned char* lds, int it) {
    const int tid = threadIdx.x, lane = tid & 63, wave = tid >> 6, b = it >> 2, h = it & 3;
    const bf16_t* PROJ = (const bf16_t*)(p.ws + OFF_PROJ); bf16_t* ACT = (bf16_t*)(p.ws + OFF_ACT);
    LAS float* scr = (LAS float*)lds;
    LAS float* red = (LAS float*)(lds + 1024);
    const int half = lane >> 5, dl = lane & 31;
    const size_t prow = (size_t)(NP + b) * PLD;
    f32x4 q; { const bf16_t* qp = PROJ + prow + C_CQ + h * 128 + dl * 4; const u32x2 u = *(const u32x2*)qp; q = (f32x4){bflo(u[0]), bfhi(u[0]), bflo(u[1]), bfhi(u[1])}; }
    const float* Kp = p.cache_k + ((size_t)(b * 256) * 4 + h) * 128 + dl * 4; const float* Vp = p.cache_v + ((size_t)(b * 256) * 4 + h) * 128 + dl * 4;
    __syncthreads();
    f32x4 kv[16];
#pragma unroll
    for (int i = 0; i < 16; ++i) { const int m = wave * 32 + i * 2 + half; kv[i] = *(const f32x4*)(Kp + (size_t)m * 512); }
#pragma unroll
    for (int i = 0; i < 16; ++i) { float d = kv[i][0] * q[0] + kv[i][1] * q[1] + kv[i][2] * q[2] + kv[i][3] * q[3];
#pragma unroll
        for (int o = 16; o >= 1; o >>= 1) d += __shfl_xor(d, o);
        if (dl == 0) scr[wave * 32 + i * 2 + half] = d * 0.08838834764831845f; }
#pragma unroll
    for (int i = 0; i < 16; ++i) { const int m = wave * 32 + i * 2 + half; kv[i] = *(const f32x4*)(Vp + (size_t)m * 512); }
    __syncthreads();
    float mx = -3.0e38f;
#pragma unroll
    for (int i = 0; i < 4; ++i) mx = fmaxf(mx, scr[lane + 64 * i]);
#pragma unroll
    for (int o = 32; o >= 1; o >>= 1) mx = fmaxf(mx, __shfl_xor(mx, o));
    float sm = 0.f;
#pragma unroll
    for (int i = 0; i < 4; ++i) sm += __expf(scr[lane + 64 * i] - mx);
    sm = wave_sum(sm);
    const float inv = 1.f / sm;
    f32x4 o = {0.f, 0.f, 0.f, 0.f};
#pragma unroll
    for (int i = 0; i < 16; ++i) { const float pr = __expf(scr[wave * 32 + i * 2 + half] - mx) * inv; o += kv[i] * pr; }
    *(LAS f32x4*)(red + (wave * 2 + half) * 128 + dl * 4) = o;
    __syncthreads();
    if (tid < 128) { float s = 0.f;
#pragma unroll
        for (int g = 0; g < 16; ++g) s += red[g * 128 + tid];
        const float gt = bf2f(PROJ[prow + C_CGATE + h * 128 + tid]);
        ACT[(size_t)(NP + b) * LDA + A_YC + h * 128 + tid] = f2bf(s * siluf_(gt)); }
}

static __device__ __forceinline__ void sample_mlp_item(const Params& p, int it) {
    const int tid = threadIdx.x, lane = tid & 63, wave = tid >> 6, b = it * 8 + wave;
    const bf16_t* PROJ = (const bf16_t*)(p.ws + OFF_PROJ); bf16_t* ACT = (bf16_t*)(p.ws + OFF_ACT);
    const size_t prow = (size_t)(NP + b) * PLD; const int c0 = lane * 8;
    const u32x4 xv = *(const u32x4*)(PROJ + prow + C_BV + c0), xu = *(const u32x4*)(PROJ + prow + C_BU + c0), xg = *(const u32x4*)(PROJ + prow + C_BGATE + c0);
    float v[8], s1 = 0.f, s2 = 0.f;
#pragma unroll
    for (int e = 0; e < 4; ++e) { v[2 * e] = bflo(xv[e]); v[2 * e + 1] = bfhi(xv[e]); }
#pragma unroll
    for (int e = 0; e < 8; ++e) s1 += v[e];
    s1 = wave_sum(s1); const float mu = s1 * (1.f / 512.f);
#pragma unroll
    for (int e = 0; e < 8; ++e) { v[e] -= mu; s2 += v[e] * v[e]; }
    s2 = wave_sum(s2); const float rstd = rsqrtf(s2 * (1.f / 512.f) + EPS);
    const int g = c0 >> 7; const float w00 = p.w_spatial[(size_t)g * 16384], bs = p.b_spatial[g * 128];
    float* cvs = p.out + O_CVS + (size_t)b * 512 + c0;
    u32x4 o;
#pragma unroll
    for (int e = 0; e < 4; ++e) { float r[2];
#pragma unroll
        for (int z = 0; z < 2; ++z) { const int c = c0 + 2 * e + z; const float vn = v[2 * e + z] * rstd * p.ln_v_g[c] + p.ln_v_b[c]; cvs[2 * e + z] = vn;
            const float uu = z ? bfhi(xu[e]) : bflo(xu[e]), gg = z ? bfhi(xg[e]) : bflo(xg[e]); r[z] = uu * (w00 * vn + bs) * siluf_(gg); }
        o[e] = cvt_pk_bf16(r[0], r[1]); }
    *(u32x4*)(ACT + (size_t)(NP + b) * LDA + A_YB + c0) = o;
}

static __device__ __forceinline__ void mlp_item(const Params& p, LAS unsigned char* lds, int it) {
    const int tid = threadIdx.x, lane = tid & 63, wave = tid >> 6, l16 = lane & 15, quad = lane >> 4;
    const int row0 = (it >> 4) * 2048 + (it & 15) * 128;
    const bf16_t* PROJ = (const bf16_t*)(p.ws + OFF_PROJ); bf16_t* ACT = (bf16_t*)(p.ws + OFF_ACT);
    LAS bf16_t* vnT = (LAS bf16_t*)lds;
    LAS bf16_t* Wsm = (LAS bf16_t*)(lds + 34816);
    LAS float* st = (LAS float*)(lds + 69632);
    __syncthreads();
    { const int r = tid >> 2, part = tid & 3; const bf16_t* rp = PROJ + (size_t)(row0 + r) * PLD + C_BV + part * 128; float s1 = 0.f, s2 = 0.f;
#pragma unroll
      for (int i = 0; i < 16; ++i) { const u32x4 x = *(const u32x4*)(rp + i * 8);
#pragma unroll
          for (int e = 0; e < 4; ++e) { const float a = bflo(x[e]), c = bfhi(x[e]); s1 += a + c; s2 += a * a + c * c; } }
      s1 += __shfl_xor(s1, 1); s1 += __shfl_xor(s1, 2); s2 += __shfl_xor(s2, 1); s2 += __shfl_xor(s2, 2);
      const float mu = s1 * (1.f / 512.f); const float var = fmaxf(s2 * (1.f / 512.f) - mu * mu, 0.f);
      if (part == 0) { st[r * 2] = mu; st[r * 2 + 1] = rsqrtf(var + EPS); } }
    __syncthreads();
#pragma unroll 1
    for (int g = 0; g < 4; ++g) {
        { const int s = lane + 64 * (wave & 1), cq = (wave >> 1) * 32; const float mu = st[s * 2], rstd = st[s * 2 + 1];
          const bf16_t* rp = PROJ + (size_t)(row0 + s) * PLD + C_BV + g * 128 + cq;
#pragma unroll
          for (int i = 0; i < 4; ++i) { const u32x4 x = *(const u32x4*)(rp + i * 8);
#pragma unroll
              for (int e = 0; e < 4; ++e) { const int c = cq + i * 8 + 2 * e; const int gc = g * 128 + c;
                  vnT[c * 136 + s] = f2bf((bflo(x[e]) - mu) * rstd * p.ln_v_g[gc] + p.ln_v_b[gc]);
                  vnT[(c + 1) * 136 + s] = f2bf((bfhi(x[e]) - mu) * rstd * p.ln_v_g[gc + 1] + p.ln_v_b[gc + 1]); } }
          const int t = tid >> 2, sq = (tid & 3) * 32; const float* wp = p.w_spatial + ((size_t)g * 128 + t) * 128 + sq;
#pragma unroll
          for (int i = 0; i < 4; ++i) { const f32x4 w0 = *(const f32x4*)(wp + i * 8), w1 = *(const f32x4*)(wp + i * 8 + 4); const int s0 = sq + i * 8;
              f32x4 m0, m1;
#pragma unroll
              for (int e = 0; e < 4; ++e) { m0[e] = (s0 + e <= t) ? w0[e] : 0.f; m1[e] = (s0 + 4 + e <= t) ? w1[e] : 0.f; }
              *(LAS u32x4*)(Wsm + t * 136 + s0) = pack8(m0, m1); } }
        __syncthreads();
        f32x4 acc[8];
#pragma unroll
        for (int ct = 0; ct < 8; ++ct) acc[ct] = (f32x4){0.f, 0.f, 0.f, 0.f};
        const int nks = (wave >> 1) + 1;
        for (int ks = 0; ks < nks; ++ks) { const bf16x8 bw = lds8(lds, 34816 + ((wave * 16 + l16) * 136 + ks * 32 + quad * 8) * 2);
#pragma unroll
            for (int ct = 0; ct < 8; ++ct) acc[ct] = mfma16(lds8(lds, ((ct * 16 + l16) * 136 + ks * 32 + quad * 8) * 2), bw, acc[ct]); }
        const int t = wave * 16 + l16; const size_t prow = (size_t)(row0 + t) * PLD; const float bs = p.b_spatial[g * 128 + t];
#pragma unroll
        for (int ct = 0; ct < 8; ++ct) { const int col = g * 128 + ct * 16 + quad * 4;
            const u32x2 xu = *(const u32x2*)(PROJ + prow + C_BU + col), xg = *(const u32x2*)(PROJ + prow + C_BGATE + col);
            u32x2 o; o[0] = cvt_pk_bf16(bflo(xu[0]) * (acc[ct][0] + bs) * siluf_(bflo(xg[0])), bfhi(xu[0]) * (acc[ct][1] + bs) * siluf_(bfhi(xg[0])));
            o[1] = cvt_pk_bf16(bflo(xu[1]) * (acc[ct][2] + bs) * siluf_(bflo(xg[1])), bfhi(xu[1]) * (acc[ct][3] + bs) * siluf_(bfhi(xg[1])));
            *(u32x2*)(ACT + (size_t)(row0 + t) * LDA + A_YB + col) = o; }
        __syncthreads();
    }
}

static __device__ __forceinline__ void xattn_item(const Params& p, LAS unsigned char* lds, int it) {
    const int tid = threadIdx.x, lane = tid & 63, wave = tid >> 6, l16 = lane & 15, quad = lane >> 4;
    const int b = it >> 6, h = (it >> 4) & 3, qt = it & 15;
    const bf16_t* PROJ = (const bf16_t*)(p.ws + OFF_PROJ); bf16_t* ACT = (bf16_t*)(p.ws + OFF_ACT); const bf16_t* MKV = (const bf16_t*)(p.ws + OFF_MEMKV);
    LAS bf16_t* Ks = (LAS bf16_t*)lds;
    LAS bf16_t* Vt = (LAS bf16_t*)(lds + 69632);
    __syncthreads();
#pragma unroll
    for (int i = 0; i < 8; ++i) { const int idx = wave * 8 + i, m = (idx & 3) * 64 + lane, dc = (idx >> 2) * 8; const bf16_t* sp = MKV + (size_t)(b * 256 + m) * 1024 + h * 128 + dc;
        *(LAS u32x4*)(Ks + m * 136 + dc) = *(const u32x4*)sp;
        const u32x4 v = *(const u32x4*)(sp + 512);
#pragma unroll
        for (int e = 0; e < 4; ++e) { Vt[(dc + 2 * e) * 264 + m] = (bf16_t)(v[e] & 0xffffu); Vt[(dc + 2 * e + 1) * 264 + m] = (bf16_t)(v[e] >> 16); } }
    const int q0 = b * 2048 + qt * 128 + wave * 16; const size_t prow = (size_t)(q0 + l16) * PLD;
    bf16x8 qf[4];
#pragma unroll
    for (int ks = 0; ks < 4; ++ks) qf[ks] = ldg8(PROJ + prow + C_CQ + h * 128 + ks * 32 + quad * 8);
    __syncthreads();
    f32x4 s[16];
#pragma unroll
    for (int mt = 0; mt < 16; ++mt) { s[mt] = (f32x4){0.f, 0.f, 0.f, 0.f};
#pragma unroll
        for (int ks = 0; ks < 4; ++ks) s[mt] = mfma16(lds8(lds, ((mt * 16 + l16) * 136 + ks * 32 + quad * 8) * 2), qf[ks], s[mt]); }
    float mx = -3.0e38f;
#pragma unroll
    for (int mt = 0; mt < 16; ++mt)
#pragma unroll
        for (int r = 0; r < 4; ++r) mx = fmaxf(mx, s[mt][r]);
    mx = fmaxf(mx, __shfl_xor(mx, 16)); mx = fmaxf(mx, __shfl_xor(mx, 32));
    const float sc = 0.08838834764831845f * 1.4426950408889634f; float sm = 0.f;
#pragma unroll
    for (int mt = 0; mt < 16; ++mt)
#pragma unroll
        for (int r = 0; r < 4; ++r) { s[mt][r] = exp2f((s[mt][r] - mx) * sc); sm += s[mt][r]; }
    sm += __shfl_xor(sm, 16); sm += __shfl_xor(sm, 32);
    const float inv = 1.f / sm;
    bf16x8 pb[8];
#pragma unroll
    for (int ss = 0; ss < 8; ++ss) { const u32x4 pu = pack8(s[2 * ss], s[2 * ss + 1]); pb[ss] = __builtin_bit_cast(bf16x8, pu); }
#pragma unroll 1
    for (int dt = 0; dt < 8; ++dt) {
        f32x4 o = {0.f, 0.f, 0.f, 0.f};
#pragma unroll
        for (int ss = 0; ss < 8; ++ss) { const bf16x4 v0 = *(const LAS bf16x4*)(Vt + (dt * 16 + l16) * 264 + ss * 32 + quad * 4), v1 = *(const LAS bf16x4*)(Vt + (dt * 16 + l16) * 264 + ss * 32 + 16 + quad * 4);
            o = mfma16(__builtin_shufflevector(v0, v1, 0, 1, 2, 3, 4, 5, 6, 7), pb[ss], o); }
        const int col = h * 128 + dt * 16 + quad * 4; const u32x2 xg = *(const u32x2*)(PROJ + prow + C_CGATE + col);
        u32x2 w; w[0] = cvt_pk_bf16(o[0] * inv * siluf_(bflo(xg[0])), o[1] * inv * siluf_(bfhi(xg[0])));
        w[1] = cvt_pk_bf16(o[2] * inv * siluf_(bflo(xg[1])), o[3] * inv * siluf_(bfhi(xg[1])));
        *(u32x2*)(ACT + (size_t)(q0 + l16) * LDA + A_YC + col) = w;
        __builtin_amdgcn_sched_barrier(0); }
}

static __device__ __forceinline__ void phase_mixers(const Params& p, LAS unsigned char* lds) {
    const int wg = blockIdx.x, G = gridDim.x, tid = threadIdx.x;
    if (p.mask & 1) for (int w = wg; w < 64; w += G) { const int xcd = w & 7, sl = w >> 3; scan_unit(p, lds, ((xcd * 4 + (sl >> 1)) << 1) | (sl & 1)); }
    if (G > 64) { for (int it = wg - 64; it >= 0 && it < 128; it += G - 64) mlp_item(p, lds, it); }
    else { for (int it = wg; it < 128; it += G) mlp_item(p, lds, it); }
    unsigned* cnt = (unsigned*)(p.ws + OFF_CNT);
    LAS unsigned* slot = (LAS unsigned*)(lds + LDS_ITEM);
    for (;;) {
        __syncthreads();
        if (tid == 0) *slot = atomicAdd(cnt, 1u);
        __syncthreads();
        const int it = (int)*slot;
        if (it >= 1552) break;
        if (it < 512) xattn_item(p, lds, it);
        else if (it < 1024) sample_delta_item(p, lds, it - 512);
        else if (it < 1536) sample_xattn_item(p, lds, it - 1024);
        else sample_mlp_item(p, it - 1536);
    }
}

static __device__ __forceinline__ void phase_ya(const Params& p) {
    const int tid = threadIdx.x, lane = tid & 63, wave = tid >> 6;
    const bf16_t* PROJ = (const bf16_t*)(p.ws + OFF_PROJ); bf16_t* ACT = (bf16_t*)(p.ws + OFF_ACT);
    const int c0 = lane * 8, d0 = c0 & 127, nw = gridDim.x * 8;
    f32x4 ng0 = *(const f32x4*)(p.a_norm_g + d0), ng1 = *(const f32x4*)(p.a_norm_g + d0 + 4);
    for (int row0 = blockIdx.x * 8 + wave; row0 < NP; row0 += nw * 4) {
        u32x4 xo[4], xg[4];
#pragma unroll
        for (int k = 0; k < 4; ++k) { const int row = row0 + k * nw; if (row < NP) { const size_t prow = (size_t)row * PLD; xo[k] = *(const u32x4*)(PROJ + prow + C_AQ + c0); xg[k] = *(const u32x4*)(PROJ + prow + C_AGATE + c0); } }
#pragma unroll
        for (int k = 0; k < 4; ++k) { const int row = row0 + k * nw; if (row < NP) {
            float v[8], ss = 0.f;
#pragma unroll
            for (int e = 0; e < 4; ++e) { v[2 * e] = bflo(xo[k][e]); v[2 * e + 1] = bfhi(xo[k][e]); ss += v[2 * e] * v[2 * e] + v[2 * e + 1] * v[2 * e + 1]; }
            ss += __shfl_xor(ss, 1); ss += __shfl_xor(ss, 2); ss += __shfl_xor(ss, 4); ss += __shfl_xor(ss, 8);
            const float rstd = rsqrtf(ss * (1.f / 128.f) + EPS);
            u32x4 o;
#pragma unroll
            for (int e = 0; e < 4; ++e) { const float g0 = e < 2 ? ng0[2 * e] : ng1[2 * e - 4], g1 = e < 2 ? ng0[2 * e + 1] : ng1[2 * e - 3];
                o[e] = cvt_pk_bf16(v[2 * e] * rstd * g0 * siluf_(bflo(xg[k][e])), v[2 * e + 1] * rstd * g1 * siluf_(bfhi(xg[k][e]))); }
            *(u32x4*)(ACT + (size_t)row * LDA + A_YA + c0) = o; } }
    }
}

template <int NKS> __device__ __forceinline__ f32x4 small_gemm(const bf16_t* Wt, const bf16_t* A) {
    bf16x8 wv[NKS], av[NKS];
#pragma unroll
    for (int ks = 0; ks < NKS; ++ks) { wv[ks] = ldg8(Wt + ks * 32); av[ks] = ldg8(A + ks * 32); }
    f32x4 acc = {0.f, 0.f, 0.f, 0.f};
#pragma unroll
    for (int ks = 0; ks < NKS; ++ks) acc = mfma16(wv[ks], av[ks], acc);
    return acc;
}
static __device__ __forceinline__ void sample_g3(const Params& p, LAS unsigned char* lds) {
    const int tid = threadIdx.x, lane = tid & 63, wave = tid >> 6, l16 = lane & 15, quad = lane >> 4, c = blockIdx.x;
    const int ct = c >> 2, rt = 2 * (c & 3) + (wave >> 2), kp = wave & 3;
    const bf16_t* ACT = (const bf16_t*)(p.ws + OFF_ACT); const bf16_t* WG3 = (const bf16_t*)(p.ws + OFF_WG3); bf16_t* MERGED = (bf16_t*)(p.ws + OFF_MERGED);
    const int r = NP + rt * 16 + l16 + opaque_zero(), n0 = ct * 16;
    LAS f32x4* red = (LAS f32x4*)lds;
#pragma unroll
    for (int br = 0; br < 3; ++br) {
        const bf16_t* wrow = WG3 + ((size_t)br * 1024 + n0 + l16) * 1536 + quad * 8; const bf16_t* arow = ACT + (size_t)r * LDA + quad * 8;
        red[(wave * 6 + 2 * br) * 64 + lane] = small_gemm<8>(wrow + kp * 256, arow + kp * 256);
        red[(wave * 6 + 2 * br + 1) * 64 + lane] = small_gemm<4>(wrow + 1024 + kp * 128, arow + A_YA + br * 512 + kp * 128);
    }
    __syncthreads();
    if (kp == 0) {
        f32x4 m = {0.f, 0.f, 0.f, 0.f};
#pragma unroll
        for (int br = 0; br < 3; ++br) {
            f32x4 ag = {0.f, 0.f, 0.f, 0.f}, at = {0.f, 0.f, 0.f, 0.f};
#pragma unroll
            for (int k = 0; k < 4; ++k) { ag += red[((wave + k) * 6 + 2 * br) * 64 + lane]; at += red[((wave + k) * 6 + 2 * br + 1) * 64 + lane]; }
            const f32x4 bg = *(const f32x4*)(p.b_gate + br * 1024 + n0 + quad * 4);
#pragma unroll
            for (int e = 0; e < 4; ++e) m[e] += sigmoidf_(ag[e] + bg[e]) * at[e];
        }
        u32x2 o; o[0] = cvt_pk_bf16(m[0], m[1]); o[1] = cvt_pk_bf16(m[2], m[3]);
        *(u32x2*)(MERGED + (size_t)r * 1024 + n0 + quad * 4) = o;
    }
}
static __device__ __forceinline__ void sample_g4(const Params& p, LAS unsigned char* lds) {
    const int tid = threadIdx.x, lane = tid & 63, wave = tid >> 6, l16 = lane & 15, quad = lane >> 4, c = blockIdx.x;
    const int ct = c >> 2, rt = 2 * (c & 3) + (wave >> 2), kp = wave & 3;
    const bf16_t* WOUT = (const bf16_t*)(p.ws + OFF_WOUT); const bf16_t* MERGED = (const bf16_t*)(p.ws + OFF_MERGED); float* rowsq = (float*)(p.ws + OFF_ROWSQ);
    const int rs = rt * 16 + l16 + opaque_zero(), n0 = ct * 16;
    LAS f32x4* red = (LAS f32x4*)lds;
    red[wave * 64 + lane] = small_gemm<8>(WOUT + (size_t)(n0 + l16) * 1024 + quad * 8 + kp * 256, MERGED + (size_t)(NP + rs) * 1024 + quad * 8 + kp * 256);
    __syncthreads();
    if (kp == 0) {
        f32x4 a = red[wave * 64 + lane] + red[(wave + 1) * 64 + lane] + red[(wave + 2) * 64 + lane] + red[(wave + 3) * 64 + lane];
        const f32x4 v = *(const f32x4*)(p.x_sample + (size_t)rs * 1024 + n0 + quad * 4) + a;
        *(f32x4*)(p.out + O_YS + (size_t)rs * 1024 + n0 + quad * 4) = v;
        float ss = v[0] * v[0] + v[1] * v[1] + v[2] * v[2] + v[3] * v[3];
        ss += __shfl_xor(ss, 16); ss += __shfl_xor(ss, 32);
        if (quad == 0) unsafeAtomicAdd(rowsq + NP + rs, ss);
    }
}

static __device__ __forceinline__ void sample_g4_finish(const Params& p) {
    const int tid = threadIdx.x, lane = tid & 63, wave = tid >> 6, l16 = lane & 15, quad = lane >> 4, c = blockIdx.x;
    const int ct = c >> 2, rt = 2 * (c & 3) + (wave >> 2), kp = wave & 3;
    const float* rowsq = (const float*)(p.ws + OFF_ROWSQ);
    if (kp == 0) { const int rs = rt * 16 + l16, n0 = ct * 16; float* op = p.out + O_YS + (size_t)rs * 1024 + n0 + quad * 4;
        const float r = rsqrtf(__hip_atomic_load(rowsq + NP + rs, __ATOMIC_RELAXED, __HIP_MEMORY_SCOPE_AGENT) * (1.f / 1024.f) + EPS);
        *(f32x4*)op = *(const f32x4*)op * r * *(const f32x4*)(p.final_norm_g + n0 + quad * 4); }
}
static __device__ __forceinline__ void phase_final(const Params& p) {
    const float* rowsq = (const float*)(p.ws + OFF_ROWSQ);
    const int total4 = (NP + NS) * 256, stride = gridDim.x * 512;
    for (int base = blockIdx.x * 512 + threadIdx.x; base < total4; base += stride * 8) {
        f32x4 v[8]; float rs[8];
#pragma unroll
        for (int k = 0; k < 8; ++k) { const int i = base + k * stride; if (i < total4) { v[k] = *(const f32x4*)(p.out + (size_t)i * 4); rs[k] = rowsq[i >> 8]; } }
#pragma unroll
        for (int k = 0; k < 8; ++k) { const int i = base + k * stride; if (i < total4) { const f32x4 g = *(const f32x4*)(p.final_norm_g + (i & 255) * 4);
            *(f32x4*)(p.out + (size_t)i * 4) = v[k] * rsqrtf(rs[k] * (1.f / 1024.f) + EPS) * g; } }
    }
}

__global__ void __launch_bounds__(512, 2) fwd_megakernel(Params p) {
    extern __shared__ __attribute__((aligned(16))) unsigned char shm[];
    LAS unsigned char* lds = (LAS unsigned char*)shm;
    cg::grid_group grid = cg::this_grid();
    const int G = gridDim.x, c = blockIdx.x;
    unsigned* bar = (unsigned*)(p.ws + OFF_BAR); unsigned ep = 0u;
#define PH_BEGIN(k) if (p.ph_lo <= (k) && (k) < p.ph_hi) { if ((k) > p.ph_lo) { if ((k) == 1) grid_sync_all(grid); else fast_sync(bar, ++ep); }
#define PH_END }
#if !defined(ONLY_PH) || ONLY_PH == 0
    PH_BEGIN(0) phase_prep(p, lds); PH_END
#endif
#if !defined(ONLY_PH) || ONLY_PH == 1
    PH_BEGIN(1) { SchedG1 S{(const char*)(p.ws + OFF_ACT), (const char*)(p.ws + OFF_W1T), G, c};
                  EpiG1 E{(bf16_t*)(p.ws + OFF_PROJ), (bf16_t*)(p.ws + OFF_MEMKV), p.out};
                  pg8::gemm_phase(lds, LDA, 1024, S, E); } PH_END
#endif
#if !defined(ONLY_PH) || ONLY_PH == 2
    PH_BEGIN(2) phase_delta_pre(p, lds); PH_END
#endif
#if !defined(ONLY_PH) || ONLY_PH == 3
    PH_BEGIN(3) phase_mixers(p, lds); PH_END
#endif
#if !defined(ONLY_PH) || ONLY_PH == 4
    PH_BEGIN(4) phase_ya(p); PH_END
#endif
#if !defined(ONLY_PH) || ONLY_PH == 5
    PH_BEGIN(5) { SchedG3 S{(const char*)(p.ws + OFF_ACT), (const char*)(p.ws + OFF_WG3), G, c};
                  EpiG3 E{p.ws + OFF_PROJ + (size_t)c * SCR_PER_WG, (bf16_t*)(p.ws + OFF_MERGED), p.b_gate};
                  pg8::gemm_phase(lds, LDA, 1536, S, E);
                  sample_g3(p, lds); } PH_END
#endif
#if !defined(ONLY_PH) || ONLY_PH == 6
    PH_BEGIN(6) { sample_g4(p, lds); __syncthreads();
                  SchedG4 S{(const char*)(p.ws + OFF_MERGED), (const char*)(p.ws + OFF_WOUT), G, c};
                  EpiG4 E{p.x_prompt, p.out, (float*)(p.ws + OFF_ROWSQ), p.final_norm_g, bar, ep + 1u};
                  pg8::gemm_phase(lds, 1024, 1024, S, E);
                  sample_g4_finish(p); } PH_END
#endif
#if !defined(ONLY_PH) || ONLY_PH == 7
#endif
}

extern "C" void kernel_launch(void* const* d_in, const int* in_sizes, int n_in, void* d_out, int out_size, void* d_ws, size_t ws_size, hipStream_t stream) {
    static int grid_blocks = 0;
    if (grid_blocks == 0) {
        if (n_in != 25 || ws_size < WS_END) { fprintf(stderr, "kernel_launch: unexpected n_in %d / ws_size %zu (need %zu)\n", n_in, ws_size, (size_t)WS_END); grid_blocks = -1; return; }
        int dev = 0, cus = 0, per_cu = 0;
        hipGetDevice(&dev);
        hipDeviceGetAttribute(&cus, hipDeviceAttributeMultiprocessorCount, dev);
        if (hipFuncSetAttribute((const void*)fwd_megakernel, hipFuncAttributeMaxDynamicSharedMemorySize, LDS_BYTES) != hipSuccess) { fprintf(stderr, "kernel_launch: hipFuncSetAttribute failed\n"); }
        if (hipOccupancyMaxActiveBlocksPerMultiprocessor(&per_cu, fwd_megakernel, 512, LDS_BYTES) != hipSuccess || per_cu < 1) { fprintf(stderr, "kernel_launch: occupancy query gave %d\n", per_cu); per_cu = 1; }
        (void)hipGetLastError();
        grid_blocks = cus * per_cu; if (grid_blocks > 256) grid_blocks = 256;
        if (grid_blocks != 256) { fprintf(stderr, "kernel_launch: this build needs exactly 256 co-resident workgroups (one output tile each in the fused out-projection epilogue); got %d\n", grid_blocks); grid_blocks = -1; return; }
    }
    if (grid_blocks < 0) return;
    Params p{};
    const float** f = (const float**)&p;
    for (int i = 0; i < 25; ++i) f[i] = (const float*)d_in[i];
    p.out = (float*)d_out; p.ws = (unsigned char*)d_ws; p.ph_lo = 0; p.ph_hi = 8; p.mask = 0xff;
    void* args[] = {&p};
    hipError_t e = hipLaunchCooperativeKernel((const void*)fwd_megakernel, dim3(grid_blocks), dim3(512), args, LDS_BYTES, stream);
    if (e != hipSuccess) fprintf(stderr, "cooperative launch failed: %s (grid %d)\n", hipGetErrorString(e), grid_blocks);
}
```
